# Optimizing an MI355X kernel written in HIP

```python
import math
import jax, jax.numpy as jnp
from jax import lax
import numpy as np

D_MODEL = 2048
BATCH = 4
SEQ = 2048
DEPTH = 1
DEC_BATCH = 128
DEC_SEQ = 4
PAST_LEN = 16384
PAGE_SIZE = 128

MIX_WIDTH = D_MODEL
POOL_WIDTH = MIX_WIDTH // 2
SSM_WIDTH = MIX_WIDTH - POOL_WIDTH
POOL_WINDOWS = (2, 4, 8, 16)
N_POOL_GROUPS = len(POOL_WINDOWS)
POOL_GROUP = POOL_WIDTH // N_POOL_GROUPS
POOL_BUF = max(POOL_WINDOWS) - 1
SSM_GROUP = 16
N_SSM_GROUPS = SSM_WIDTH // SSM_GROUP
SSM_STATE = 64
N_MEM = 256
N_XHEADS = 4
XHEAD_DIM = D_MODEL // N_XHEADS
D_FF = -(-8 * D_MODEL // (3 * 256)) * 256
EPS = 1e-6
DT_MIN = 1e-3
DT_MAX = 1e-1

kernel_name = "hymba_pool_s5_xattn_step"


def _normal(k, shape, scale):
    return scale * jax.random.normal(k, shape, jnp.float32)


def _rmsnorm(x, g):
    xf = x.astype(jnp.float32)
    r = lax.rsqrt(jnp.mean(xf * xf, axis=-1, keepdims=True) + EPS)
    return (xf * r * g.astype(jnp.float32)).astype(x.dtype)


def _pool_mixer(u, buf, pos0, w_pool, pool_scale):
    f32 = jnp.float32
    bsz, t, c = u.shape
    z = jnp.concatenate([buf.astype(f32), u.astype(f32)], axis=1)
    cs = jnp.concatenate([jnp.zeros((bsz, 1, c), f32), jnp.cumsum(z, axis=1)], axis=1)
    end = cs[:, POOL_BUF + 1:]
    pos = pos0 + jnp.arange(t)
    means = []
    for g, w in enumerate(POOL_WINDOWS):
        sl = slice(g * POOL_GROUP, (g + 1) * POOL_GROUP)
        start = cs[:, POOL_BUF + 1 - w:POOL_BUF + 1 - w + t, sl]
        cnt = jnp.minimum(pos + 1, w).astype(f32)[None, :, None]
        means.append((end[..., sl] - start) / cnt)
    pooled = (jnp.concatenate(means, axis=-1) - u.astype(f32)).reshape(bsz, t, N_POOL_GROUPS, POOL_GROUP)
    out = jnp.einsum('btgc,gcd->btgd', pooled, w_pool.astype(f32)).reshape(bsz, t, POOL_WIDTH)
    out = out * pool_scale.astype(f32)
    new_buf = z[:, -POOL_BUF:].astype(u.dtype)
    return out.astype(u.dtype), new_buf


def _ssm_combine(e1, e2):
    a1, b1 = e1
    a2, b2 = e2
    return a1 * a2, a2 * b1 + b2


def _s5_mixer(u, h_re, h_im, lam_re, lam_im, log_step, b_re, b_im, c_re, c_im, d_skip, w_glu, b_glu):
    f32 = jnp.float32
    bsz, t, _ = u.shape
    uf = u.astype(f32).reshape(bsz, t, N_SSM_GROUPS, SSM_GROUP)
    lam = lax.complex(lam_re.astype(f32), lam_im.astype(f32))
    delta = jnp.exp(log_step.astype(f32))[:, None]
    a_bar = jnp.exp(lam * delta)
    b_bar = ((a_bar - 1.0) / lam)[..., None] * lax.complex(b_re.astype(f32), b_im.astype(f32))
    bu = jnp.einsum('gpc,btgc->btgp', b_bar, uf.astype(jnp.complex64))
    h0 = lax.complex(h_re.astype(f32), h_im.astype(f32))
    bu = bu.at[:, 0].add(a_bar * h0)
    a = jnp.broadcast_to(a_bar, bu.shape)
    _, s = lax.associative_scan(_ssm_combine, (a, bu), axis=1)
    y = (jnp.einsum('gcp,btgp->btgc', c_re.astype(f32), jnp.real(s))
         - jnp.einsum('gcp,btgp->btgc', c_im.astype(f32), jnp.imag(s)))
    y = (y + d_skip.astype(f32).reshape(N_SSM_GROUPS, SSM_GROUP) * uf).reshape(bsz, t, SSM_WIDTH)
    g = jax.nn.gelu(y)
    out = g * jax.nn.sigmoid(g @ w_glu.astype(f32) + b_glu.astype(f32))
    h_last = s[:, -1]
    return out.astype(u.dtype), jnp.real(h_last).astype(h_re.dtype), jnp.imag(h_last).astype(h_im.dtype)


def _memory_kv(mem, g_mem, w_k, w_v):
    bsz, m, _ = mem.shape
    mn = _rmsnorm(mem, g_mem)
    k = (mn @ w_k).reshape(bsz, m, N_XHEADS, XHEAD_DIM)
    v = (mn @ w_v).reshape(bsz, m, N_XHEADS, XHEAD_DIM)
    return k, v


def _cross_attn(h, mem_k, mem_v, w_q, w_o):
    f32 = jnp.float32
    bsz, t, _ = h.shape
    q = (h @ w_q).reshape(bsz, t, N_XHEADS, XHEAD_DIM)
    sc = jnp.einsum('bthd,bmhd->bhtm', q.astype(f32), mem_k.astype(f32)) * (XHEAD_DIM ** -0.5)
    p = jax.nn.softmax(sc, axis=-1)
    o = jnp.einsum('bhtm,bmhd->bthd', p, mem_v.astype(f32)).astype(h.dtype).reshape(bsz, t, D_MODEL)
    return o @ w_o


def _layer(x, pool_buf, h_re, h_im, mem_k, mem_v, pos0, lw):
    h = _rmsnorm(x, lw['g_mix'])
    p = h @ lw['w_in']
    u_pool, u_ssm = p[..., :POOL_WIDTH], p[..., POOL_WIDTH:]
    pool_out, new_buf = _pool_mixer(u_pool, pool_buf, pos0, lw['w_pool'], lw['pool_scale'])
    ssm_out, new_re, new_im = _s5_mixer(u_ssm, h_re, h_im, lw['lam_re'], lw['lam_im'], lw['log_step'],
                                        lw['b_re'], lw['b_im'], lw['c_re'], lw['c_im'], lw['d'],
                                        lw['w_glu'], lw['b_glu'])
    x = x + jnp.concatenate([pool_out, ssm_out], axis=-1) @ lw['w_out']
    x = x + _cross_attn(_rmsnorm(x, lw['g_cross']), mem_k, mem_v, lw['w_q'], lw['w_o'])
    h = _rmsnorm(x, lw['g_ffn'])
    x = x + (jax.nn.silu(h @ lw['w_gate']) * (h @ lw['w_up'])) @ lw['w_down']
    return x, new_buf, new_re, new_im


def setup_inputs(seed: int = 0) -> dict:
    key = jax.random.key(seed)
    k = jax.random.split(key, 34)
    f32 = jnp.float32
    G, P = N_SSM_GROUPS, SSM_STATE
    lam_im = jnp.broadcast_to(jnp.pi * jnp.arange(P, dtype=f32), (DEPTH, G, P))
    return {
        'x_prompt': _normal(k[0], (BATCH, SEQ, D_MODEL), 1.0),
        'x_sample': _normal(k[1], (DEC_BATCH, DEC_SEQ, D_MODEL), 1.0),
        'mem_prompt': _normal(k[2], (BATCH, N_MEM, D_MODEL), 1.0),
        'state_pool_buf': _normal(k[3], (DEPTH, DEC_BATCH, POOL_BUF, POOL_WIDTH), 1.0),
        'state_ssm_re': _normal(k[4], (DEPTH, DEC_BATCH, G, P), 0.1),
        'state_ssm_im': _normal(k[5], (DEPTH, DEC_BATCH, G, P), 0.1),
        'cache_mem_k': _normal(k[6], (DEPTH, DEC_BATCH, N_MEM, N_XHEADS, XHEAD_DIM), 1.0),
        'cache_mem_v': _normal(k[7], (DEPTH, DEC_BATCH, N_MEM, N_XHEADS, XHEAD_DIM), 1.0),
        'g_mix': 1.0 + _normal(k[8], (DEPTH, D_MODEL), 0.02),
        'w_in': _normal(k[9], (DEPTH, D_MODEL, MIX_WIDTH), D_MODEL ** -0.5),
        'w_pool': _normal(k[10], (DEPTH, N_POOL_GROUPS, POOL_GROUP, POOL_GROUP), POOL_GROUP ** -0.5),
        'pool_scale': 1.0 + _normal(k[11], (DEPTH, POOL_WIDTH), 0.02),
        'ssm_lam_re': -0.5 + _normal(k[12], (DEPTH, G, P), 0.01),
        'ssm_lam_im': lam_im,
        'ssm_log_step': jax.random.uniform(k[13], (DEPTH, G), f32, math.log(DT_MIN), math.log(DT_MAX)),
        'ssm_b_re': _normal(k[14], (DEPTH, G, P, SSM_GROUP), (2 * SSM_GROUP) ** -0.5),
        'ssm_b_im': _normal(k[15], (DEPTH, G, P, SSM_GROUP), (2 * SSM_GROUP) ** -0.5),
        'ssm_c_re': _normal(k[16], (DEPTH, G, SSM_GROUP, P), P ** -0.5),
        'ssm_c_im': _normal(k[17], (DEPTH, G, SSM_GROUP, P), P ** -0.5),
        'ssm_d': _normal(k[18], (DEPTH, SSM_WIDTH), 1.0),
        'w_glu': _normal(k[19], (DEPTH, SSM_WIDTH, SSM_WIDTH), SSM_WIDTH ** -0.5),
        'b_glu': _normal(k[20], (DEPTH, SSM_WIDTH), 0.01),
        'w_out': _normal(k[21], (DEPTH, MIX_WIDTH, D_MODEL), MIX_WIDTH ** -0.5),
        'g_cross': 1.0 + _normal(k[22], (DEPTH, D_MODEL), 0.02),
        'g_mem': 1.0 + _normal(k[23], (DEPTH, D_MODEL), 0.02),
        'w_q': _normal(k[24], (DEPTH, D_MODEL, D_MODEL), D_MODEL ** -0.5),
        'w_k': _normal(k[25], (DEPTH, D_MODEL, D_MODEL), D_MODEL ** -0.5),
        'w_v': _normal(k[26], (DEPTH, D_MODEL, D_MODEL), D_MODEL ** -0.5),
        'w_o': _normal(k[27], (DEPTH, D_MODEL, D_MODEL), D_MODEL ** -0.5),
        'g_ffn': 1.0 + _normal(k[28], (DEPTH, D_MODEL), 0.02),
        'w_gate': _normal(k[29], (DEPTH, D_MODEL, D_FF), D_MODEL ** -0.5),
        'w_up': _normal(k[30], (DEPTH, D_MODEL, D_FF), D_MODEL ** -0.5),
        'w_down': _normal(k[31], (DEPTH, D_FF, D_MODEL), D_FF ** -0.5),
        'g_final': 1.0 + _normal(k[32], (D_MODEL,), 0.02),
    }


def reference(x_prompt, x_sample, mem_prompt, state_pool_buf, state_ssm_re, state_ssm_im,
              cache_mem_k, cache_mem_v, g_mix, w_in, w_pool, pool_scale, ssm_lam_re, ssm_lam_im,
              ssm_log_step, ssm_b_re, ssm_b_im, ssm_c_re, ssm_c_im, ssm_d, w_glu, b_glu, w_out,
              g_cross, g_mem, w_q, w_k, w_v, w_o, g_ffn, w_gate, w_up, w_down, g_final):
    bsz = x_prompt.shape[0]
    yp, ys = x_prompt, x_sample
    pb_p, re_p, im_p, mk_p, mv_p, pb_s, re_s, im_s = [], [], [], [], [], [], [], []
    for l in range(DEPTH):
        lw = {
            'g_mix': g_mix[l], 'w_in': w_in[l], 'w_pool': w_pool[l], 'pool_scale': pool_scale[l],
            'lam_re': ssm_lam_re[l], 'lam_im': ssm_lam_im[l], 'log_step': ssm_log_step[l],
            'b_re': ssm_b_re[l], 'b_im': ssm_b_im[l], 'c_re': ssm_c_re[l], 'c_im': ssm_c_im[l],
            'd': ssm_d[l], 'w_glu': w_glu[l], 'b_glu': b_glu[l], 'w_out': w_out[l],
            'g_cross': g_cross[l], 'w_q': w_q[l], 'w_o': w_o[l],
            'g_ffn': g_ffn[l], 'w_gate': w_gate[l], 'w_up': w_up[l], 'w_down': w_down[l],
        }
        mk, mv = _memory_kv(mem_prompt, g_mem[l], w_k[l], w_v[l])
        zero_buf = jnp.zeros((bsz, POOL_BUF, POOL_WIDTH), x_prompt.dtype)
        zero_h = jnp.zeros((bsz, N_SSM_GROUPS, SSM_STATE), state_ssm_re.dtype)
        yp, nb, nr, ni = _layer(yp, zero_buf, zero_h, zero_h, mk, mv, 0, lw)
        pb_p.append(nb); re_p.append(nr); im_p.append(ni); mk_p.append(mk); mv_p.append(mv)
        ys, nb, nr, ni = _layer(ys, state_pool_buf[l], state_ssm_re[l], state_ssm_im[l],
                                cache_mem_k[l], cache_mem_v[l], PAST_LEN, lw)
        pb_s.append(nb); re_s.append(nr); im_s.append(ni)
    y_prompt = _rmsnorm(yp, g_final)
    y_sample = _rmsnorm(ys, g_final)
    return (y_prompt, y_sample, jnp.stack(pb_p), jnp.stack(re_p), jnp.stack(im_p), jnp.stack(mk_p),
            jnp.stack(mv_p), jnp.stack(pb_s), jnp.stack(re_s), jnp.stack(im_s))
```

```cpp
#include <hip/hip_runtime.h>
#include <hip/hip_cooperative_groups.h>
#include <cstdio>
#include <cstdint>
namespace cg = cooperative_groups;

#define LAS __attribute__((address_space(3)))
typedef unsigned short bf16_t;
typedef short bf16x8 __attribute__((ext_vector_type(8)));
typedef float f32x4 __attribute__((ext_vector_type(4)));
typedef float f32x16 __attribute__((ext_vector_type(16)));
typedef unsigned u32x4 __attribute__((ext_vector_type(4)));
typedef unsigned u32x2 __attribute__((ext_vector_type(2)));

constexpr int D = 2048, SEQ = 2048, NB = 4, MP = NB * SEQ, DB = 128, DS = 4, MS = DB * DS, M = MP + MS;
constexpr int PW = 1024, NG = 64, NMEM = 256, NH = 4, HD = 512, FF = 5632, PBUF = 15;
constexpr float EPS = 1e-6f;

constexpr size_t OUT_Y = 0;
constexpr size_t OUT_PBP = (size_t)M * D;
constexpr size_t OUT_REP = OUT_PBP + (size_t)NB * PBUF * PW;
constexpr size_t OUT_IMP = OUT_REP + (size_t)NB * NG * 64;
constexpr size_t OUT_MK = OUT_IMP + (size_t)NB * NG * 64;
constexpr size_t OUT_MV = OUT_MK + (size_t)NB * NMEM * D;
constexpr size_t OUT_PBS = OUT_MV + (size_t)NB * NMEM * D;
constexpr size_t OUT_RES = OUT_PBS + (size_t)DB * PBUF * PW;
constexpr size_t OUT_IMS = OUT_RES + (size_t)DB * NG * 64;

constexpr size_t CTL_BYTES = 256 * 1024;
constexpr size_t O_SS1 = 0, O_SS2 = 64 * 1024, O_SS3 = 128 * 1024, O_BAR = 192 * 1024, O_PCNT = 248 * 1024;
constexpr size_t O_WIN = 1 << 20;
constexpr size_t O_WKV = O_WIN + (size_t)D * D * 2;
constexpr size_t O_WPOOL = O_WKV + (size_t)2 * D * D * 2;
constexpr size_t O_WGLU = O_WPOOL + (size_t)4 * 256 * 256 * 2;
constexpr size_t O_WOUT = O_WGLU + (size_t)1024 * 1024 * 2;
constexpr size_t O_WQ = O_WOUT + (size_t)D * D * 2;
constexpr size_t O_WO = O_WQ + (size_t)D * D * 2;
constexpr size_t O_WGU = O_WO + (size_t)D * D * 2;
constexpr size_t O_WDN = O_WGU + (size_t)2 * FF * D * 2;
constexpr size_t O_TAB = O_WDN + (size_t)D * FF * 2;
constexpr size_t O_ABAR = O_TAB, O_BB = O_ABAR + 64 * 64 * 16, O_CM = O_BB + 64 * 4096;
constexpr size_t O_HMIX = O_CM + 64 * 4096;
constexpr size_t O_MN = O_HMIX + (size_t)M * D * 2;
constexpr size_t O_P = O_MN + (size_t)1024 * D * 2;
constexpr size_t O_POOLED = O_P + (size_t)M * D * 2;
constexpr size_t O_G = O_POOLED + (size_t)M * 1024 * 2;
constexpr size_t O_MIX = O_G + (size_t)M * 1024 * 2;
constexpr size_t O_X1 = O_MIX + (size_t)M * D * 2;
constexpr size_t O_XB = O_X1 + (size_t)M * D * 4;
constexpr size_t O_Q = O_XB + (size_t)M * D * 2;
constexpr size_t O_KB = O_Q + (size_t)M * D * 2;
constexpr size_t O_VT = O_KB + (size_t)1024 * D * 2;
constexpr size_t O_PR = O_VT + (size_t)D * 1024 * 2;
constexpr size_t O_ATT = O_PR + (size_t)16 * 2048 * 256 * 2;
constexpr size_t O_H = O_ATT + (size_t)M * D * 2;
constexpr size_t WS_END = O_H + (size_t)M * FF * 2;

constexpr int RING_BYTES = 131072, LDS_BYTES = 147456;

__device__ __forceinline__ unsigned cvt_pk_bf16(float lo, float hi) { unsigned r; asm volatile("v_cvt_pk_bf16_f32 %0, %1, %2" : "=v"(r) : "v"(lo), "v"(hi)); return r; }
__device__ __forceinline__ float bf_lo(unsigned w) { return __uint_as_float(w << 16); }
__device__ __forceinline__ float bf_hi(unsigned w) { return __uint_as_float(w & 0xffff0000u); }
__device__ __forceinline__ float wave_sum(float v) {
#pragma unroll
    for (int o = 1; o < 64; o <<= 1) v += __shfl_xor(v, o);
    return v;
}
__device__ __forceinline__ float wave_max(float v) {
#pragma unroll
    for (int o = 1; o < 64; o <<= 1) v = fmaxf(v, __shfl_xor(v, o));
    return v;
}
__device__ __forceinline__ float fast_sigmoid(float x) { return __builtin_amdgcn_rcpf(1.0f + __expf(-x)); }
__device__ __forceinline__ float gelu_tanh(float y) { const float t = 1.5957691216f * (y + 0.044715f * y * y * y); return y * fast_sigmoid(t); }
#define LDS_WAIT() asm volatile("s_waitcnt lgkmcnt(0)" ::: "memory")
__device__ __forceinline__ int opaque_tid(int wv) { int t; asm volatile("v_mbcnt_lo_u32_b32 %0, -1, 0\n\tv_mbcnt_hi_u32_b32 %0, -1, %0\n\tv_lshl_add_u32 %0, %1, 6, %0" : "=&v"(t) : "s"(wv)); return t; }

namespace pg8 {
constexpr int BM = 256, BK = 64, HALF = 128, HTB = HALF * BK * 2;
__device__ __forceinline__ int lds_byte(int r, int c) { const int st = (r >> 4) * 2 + (c >> 5), rr = r & 15, cc = c & 31, ob = rr * 64 + cc * 2; return st * 1024 + (ob ^ (((ob >> 9) & 1) << 5)); }
__device__ __forceinline__ void stage_rc(int b, int& R, int& C) { const int st = b / 1024, sb = b % 1024, swz = sb ^ (((sb >> 9) & 1) << 5); R = (st >> 1) * 16 + swz / 64; C = (st & 1) * 32 + (swz % 64) / 2; }
__device__ __forceinline__ int perm32(int rho) { const int n = rho >> 4, i = rho & 15; return 8 * (i >> 2) + 4 * n + (i & 3); }

struct Unit { const char* a; const char* b; const char* s; int pm, pn, job, srow; };
struct Dims { int lda, ldb, K; };

constexpr int SBUF_OFF = 131072;
template <class Epi, class Sched, bool ALIGN_EPI, bool STRIP>
__device__ __forceinline__ void gemm_phase(LAS unsigned char* lds, const Dims g, const Sched& S, const Epi& E, const int wv) {
    const int tid = opaque_tid(wv), wid = __builtin_amdgcn_readfirstlane(tid >> 6), lane = tid & 63, wr = wid >> 2, wc = wid & 3, fr = lane & 15, fq = lane >> 4;
    int nt = g.K / BK; asm volatile("" : "+s"(nt));
    unsigned voffA[2], voffB[2];
#pragma unroll
    for (int i = 0; i < 2; ++i) { int R, C; stage_rc(tid * 16 + i * 8192, R, C); const int Rb = (R & ~31) + perm32(R & 31);
        voffA[i] = (unsigned)(R * g.lda + C) * 2u; voffB[i] = (unsigned)(Rb * g.ldb + C) * 2u; }
    const unsigned voffS = (unsigned)((2 * wid + (lane >> 5)) * g.lda * 2 + (((((lane & 31) >> 2) ^ wid) & 7) * 16) + (lane & 3) * 4);
    const int soff = fr * 128 + ((fq ^ ((fr >> 1) & 7)) * 16);
    const size_t kstep = (size_t)(BK * 2);
    const size_t hstepA = (size_t)HALF * g.lda * 2, hstepB = (size_t)HALF * g.ldb * 2;
    const unsigned ldsw = (unsigned)wid * 1024u;
    const int aoff = lds_byte(wr * 64 + fr, fq * 8), boff = lds_byte(wc * 32 + fr, fq * 8);
#define PG8_SA(b, h) (((b) * 2 + (h)) * HTB)
#define PG8_SB(b, h) ((4 + (b) * 2 + (h)) * HTB)
#define PG8_STAGE(bufoff, gbase, voff) do { _Pragma("unroll") for (int _i = 0; _i < 2; ++_i) \
        __builtin_amdgcn_global_load_lds((const unsigned*)((const char*)(gbase) + (voff)[_i]), (LAS unsigned*)(lds + (bufoff) + ldsw + _i * 8192), 16, 0, 0); } while (0)
#define PG8_STAGE_S(b, gbase) do { if constexpr (STRIP) __builtin_amdgcn_global_load_lds((const unsigned*)((const char*)(gbase) + voffS), (LAS unsigned*)(lds + SBUF_OFF + (b) * 2048 + wid * 256), 4, 0, 0); } while (0)
#define PG8_LDS_S(b) do { if constexpr (STRIP) { As[0] = *(const LAS bf16x8*)(lds + SBUF_OFF + (b) * 2048 + soff); As[1] = *(const LAS bf16x8*)(lds + SBUF_OFF + (b) * 2048 + (soff ^ 64)); } } while (0)
#define PG8_LDA(dst, b, h) do { _Pragma("unroll") for (int m = 0; m < 4; ++m) _Pragma("unroll") for (int k = 0; k < 2; ++k) dst[m][k] = *(const LAS bf16x8*)(lds + PG8_SA(b, h) + aoff + m * 2048 + k * 1024); } while (0)
#define PG8_LDB(dst, b, h) do { _Pragma("unroll") for (int n = 0; n < 2; ++n) _Pragma("unroll") for (int k = 0; k < 2; ++k) dst[n][k] = *(const LAS bf16x8*)(lds + PG8_SB(b, h) + boff + n * 2048 + k * 1024); } while (0)
#define PG8_MMA(ai, bj, At, Bt) do { __builtin_amdgcn_s_setprio(1); _Pragma("unroll") for (int m = 0; m < 4; ++m) _Pragma("unroll") for (int n = 0; n < 2; ++n) _Pragma("unroll") for (int k = 0; k < 2; ++k) \
        acc[ai][bj][m][n] = __builtin_amdgcn_mfma_f32_16x16x32_bf16(Bt[n][k], At[m][k], acc[ai][bj][m][n], 0, 0, 0); __builtin_amdgcn_s_setprio(0); } while (0)
#define PG8_MMA_S() do { if constexpr (STRIP) { __builtin_amdgcn_s_setprio(1); \
        if (wr == 0) { _Pragma("unroll") for (int k = 0; k < 2; ++k) { sacc[0] = __builtin_amdgcn_mfma_f32_16x16x32_bf16(B0[0][k], As[k], sacc[0], 0, 0, 0); sacc[1] = __builtin_amdgcn_mfma_f32_16x16x32_bf16(B1[0][k], As[k], sacc[1], 0, 0, 0); } } \
        else         { _Pragma("unroll") for (int k = 0; k < 2; ++k) { sacc[0] = __builtin_amdgcn_mfma_f32_16x16x32_bf16(B0[1][k], As[k], sacc[0], 0, 0, 0); sacc[1] = __builtin_amdgcn_mfma_f32_16x16x32_bf16(B1[1][k], As[k], sacc[1], 0, 0, 0); } } \
        __builtin_amdgcn_s_setprio(0); } } while (0)
#define PG8_WAIT_V(n) asm volatile("s_waitcnt vmcnt(" #n ")" ::: "memory")
#define PG8_WAIT_VL() do { if constexpr (STRIP) PG8_WAIT_V(9); else PG8_WAIT_V(8); } while (0)
#define PG8_WAIT_L(n) asm volatile("s_waitcnt lgkmcnt(" #n ")" ::: "memory")
#define PG8_BAR __builtin_amdgcn_s_barrier()
#define PG8_SCHED __builtin_amdgcn_sched_barrier(0)
    Unit cur, nxt; int ui = 0;
    if (!S.next(0, cur)) return;
    f32x4 acc[2][2][4][2];
#pragma unroll
    for (int a = 0; a < 2; ++a)
#pragma unroll
        for (int b = 0; b < 2; ++b)
#pragma unroll
            for (int m = 0; m < 4; ++m)
#pragma unroll
                for (int n = 0; n < 2; ++n) acc[a][b][m][n] = (f32x4){0.f, 0.f, 0.f, 0.f};
    f32x4 sacc[2]; sacc[0] = (f32x4){0.f, 0.f, 0.f, 0.f}; sacc[1] = (f32x4){0.f, 0.f, 0.f, 0.f};
    bf16x8 At[4][2], B0[2][2], B1[2][2], As[2];
    const char* cA = cur.a; const char* cB = cur.b; const char* cS = cur.s;
    PG8_STAGE(PG8_SB(0, 0), cB, voffB); PG8_STAGE(PG8_SB(0, 1), cB + hstepB, voffB); PG8_STAGE(PG8_SA(0, 0), cA, voffA); PG8_STAGE_S(0, cS); PG8_STAGE(PG8_SA(0, 1), cA + hstepA, voffA);
    if (wr == 1) PG8_BAR;
    PG8_WAIT_V(2); PG8_BAR;
    PG8_STAGE(PG8_SB(1, 0), cB + kstep, voffB); PG8_STAGE(PG8_SA(1, 0), cA + kstep, voffA); PG8_STAGE(PG8_SB(1, 1), cB + hstepB + kstep, voffB); PG8_STAGE_S(1, cS + kstep);
    if constexpr (STRIP) PG8_WAIT_V(7); else PG8_WAIT_V(6);
    PG8_BAR;
    for (;;) {
        const bool has_next = S.next(ui + 1, nxt);
        const char* nA = has_next ? nxt.a : cA; const char* nB = has_next ? nxt.b : cB; const char* nS = has_next ? nxt.s : cS;
        for (int t = 0; t < nt; t += 2) {
            const bool last = (t == nt - 2);
            const char* a1 = cA + (size_t)(t + 1) * kstep;
            const char* a2 = last ? nA : cA + (size_t)(t + 2) * kstep; const char* b2 = last ? nB : cB + (size_t)(t + 2) * kstep; const char* s2 = last ? nS : cS + (size_t)(t + 2) * kstep;
            const char* a3 = a2 + kstep; const char* b3 = b2 + kstep; const char* s3 = s2 + kstep;
            PG8_LDB(B0, 0, 0); PG8_LDB(B1, 0, 1); PG8_SCHED; PG8_LDA(At, 0, 0); PG8_LDS_S(0); PG8_STAGE(PG8_SA(1, 1), a1 + hstepA, voffA);
            PG8_WAIT_VL(); PG8_WAIT_L(0); PG8_BAR; PG8_MMA(0, 0, At, B0); PG8_MMA(0, 1, At, B1); PG8_MMA_S(); PG8_BAR; PG8_SCHED;
            PG8_LDA(At, 0, 1); PG8_STAGE(PG8_SB(0, 0), b2, voffB); PG8_STAGE(PG8_SB(0, 1), b2 + hstepB, voffB); PG8_STAGE(PG8_SA(0, 0), a2, voffA); PG8_STAGE_S(0, s2);
            PG8_WAIT_VL(); PG8_WAIT_L(0); PG8_BAR; PG8_MMA(1, 0, At, B0); PG8_MMA(1, 1, At, B1); PG8_BAR; PG8_SCHED;
            PG8_LDB(B0, 1, 0); PG8_LDB(B1, 1, 1); PG8_SCHED; PG8_LDA(At, 1, 0); PG8_LDS_S(1); PG8_STAGE(PG8_SA(0, 1), a2 + hstepA, voffA);
            PG8_WAIT_VL(); PG8_WAIT_L(0); PG8_BAR; PG8_MMA(0, 0, At, B0); PG8_MMA(0, 1, At, B1); PG8_MMA_S(); PG8_BAR; PG8_SCHED;
            PG8_LDA(At, 1, 1); PG8_STAGE(PG8_SB(1, 0), b3, voffB); PG8_STAGE(PG8_SB(1, 1), b3 + hstepB, voffB); PG8_STAGE(PG8_SA(1, 0), a3, voffA); PG8_STAGE_S(1, s3);
            PG8_WAIT_VL(); PG8_WAIT_L(0); PG8_BAR; PG8_MMA(1, 0, At, B0); PG8_MMA(1, 1, At, B1); PG8_BAR; PG8_SCHED;
        }
        if constexpr (ALIGN_EPI) { if (wr == 0) PG8_BAR; }
        if constexpr (!Epi::AFTER_DRAIN) { E(acc, cur, wr, wc, fr, fq); if constexpr (STRIP) { if (cur.srow >= 0) E.strip(sacc, cur, wr, wc, fr, fq); } }
        if (!has_next) break;
#pragma unroll
        for (int a = 0; a < 2; ++a)
#pragma unroll
            for (int b = 0; b < 2; ++b)
#pragma unroll
                for (int m = 0; m < 4; ++m)
#pragma unroll
                    for (int n = 0; n < 2; ++n) acc[a][b][m][n] = (f32x4){0.f, 0.f, 0.f, 0.f};
        sacc[0] = (f32x4){0.f, 0.f, 0.f, 0.f}; sacc[1] = (f32x4){0.f, 0.f, 0.f, 0.f};
        cur = nxt; cA = nA; cB = nB; cS = nS; ++ui;
        if constexpr (ALIGN_EPI) { if (wr == 1) PG8_BAR; }
    }
    PG8_WAIT_V(0);
    if constexpr (!ALIGN_EPI) { if (wr == 0) PG8_BAR; }
    PG8_BAR;
    if constexpr (Epi::AFTER_DRAIN) { E.fused(acc, sacc, cur, wr, wc, fr, fq, lds, wid, lane); }
#undef PG8_SA
#undef PG8_SB
#undef PG8_STAGE
#undef PG8_STAGE_S
#undef PG8_LDS_S
#undef PG8_LDA
#undef PG8_LDB
#undef PG8_MMA
#undef PG8_MMA_S
#undef PG8_WAIT_V
#undef PG8_WAIT_VL
#undef PG8_WAIT_L
#undef PG8_BAR
#undef PG8_SCHED
}
typedef f32x4 Acc[2][2][4][2];

__device__ __forceinline__ void st_bf16x8(bf16_t* p, f32x4 v0, f32x4 v1) {
    u32x4 w; w.x = cvt_pk_bf16(v0[0], v0[1]); w.y = cvt_pk_bf16(v0[2], v0[3]); w.z = cvt_pk_bf16(v1[0], v1[1]); w.w = cvt_pk_bf16(v1[2], v1[3]); *(u32x4*)p = w;
}
__device__ __forceinline__ void st_bf16x4(bf16_t* p, f32x4 v) { u32x2 w; w.x = cvt_pk_bf16(v[0], v[1]); w.y = cvt_pk_bf16(v[2], v[3]); *(u32x2*)p = w; }
typedef f32x4 SAcc[2];
struct EpiInKv {
    static constexpr bool AFTER_DRAIN = false;
    bf16_t* P; float* out; bf16_t* KB; bf16_t* VT;
    __device__ __forceinline__ void operator()(const Acc& acc, const Unit& u, int wr, int wc, int fr, int fq) const {
        if (u.job == 0) {
#pragma unroll
            for (int ai = 0; ai < 2; ++ai)
#pragma unroll
                for (int m = 0; m < 4; ++m) {
                    const int row = u.pm * 256 + ai * 128 + wr * 64 + m * 16 + fr;
                    float* pbp = nullptr;
                    if (u.pn < 4) {
                        if (row < MP) { const int t = row & (SEQ - 1); if (t >= SEQ - PBUF) pbp = out + OUT_PBP + ((size_t)(row >> 11) * PBUF + (t - (SEQ - PBUF))) * PW; }
                        else { const int rs = row - MP; pbp = out + OUT_PBS + ((size_t)(rs >> 2) * PBUF + 11 + (rs & 3)) * PW; }
                    }
#pragma unroll
                    for (int bj = 0; bj < 2; ++bj) {
                        const int col = u.pn * 256 + bj * 128 + wc * 32 + 8 * fq;
                        const f32x4 v0 = acc[ai][bj][m][0], v1 = acc[ai][bj][m][1];
                        st_bf16x8(P + (size_t)row * D + col, v0, v1);
                        if (pbp) { *(f32x4*)(pbp + col) = v0; *(f32x4*)(pbp + col + 4) = v1; }
                    }
                }
        } else {
#pragma unroll
            for (int ai = 0; ai < 2; ++ai)
#pragma unroll
                for (int m = 0; m < 4; ++m) {
                    const int row = u.pm * 256 + ai * 128 + wr * 64 + m * 16 + fr;
#pragma unroll
                    for (int bj = 0; bj < 2; ++bj) {
                        const int col = u.pn * 256 + bj * 128 + wc * 32 + 8 * fq;
                        const f32x4 v0 = acc[ai][bj][m][0], v1 = acc[ai][bj][m][1];
                        if (col < D) {
                            float* o = out + OUT_MK + (size_t)row * D + col; *(f32x4*)o = v0; *(f32x4*)(o + 4) = v1;
                            st_bf16x8(KB + (size_t)row * D + col, v0, v1);
                        } else {
                            const int c = col - D;
                            float* o = out + OUT_MV + (size_t)row * D + c; *(f32x4*)o = v0; *(f32x4*)(o + 4) = v1;
#pragma unroll
                            for (int i = 0; i < 4; ++i) { VT[(size_t)(c + i) * 1024 + row] = (bf16_t)(cvt_pk_bf16(v0[i], 0.f) & 0xffffu); VT[(size_t)(c + 4 + i) * 1024 + row] = (bf16_t)(cvt_pk_bf16(v1[i], 0.f) & 0xffffu); }
                        }
                    }
                }
        }
    }
    __device__ __forceinline__ void strip(const SAcc& sacc, const Unit& u, int wr, int wc, int fr, int fq) const {
        const int row = u.srow + fr, rs = row - MP;
        float* pbp = (u.pn < 4) ? out + OUT_PBS + ((size_t)(rs >> 2) * PBUF + 11 + (rs & 3)) * PW : nullptr;
#pragma unroll
        for (int bj = 0; bj < 2; ++bj) {
            const int col = u.pn * 256 + bj * 128 + wc * 32 + 8 * fq + 4 * wr;
            st_bf16x4(P + (size_t)row * D + col, sacc[bj]);
            if (pbp) *(f32x4*)(pbp + col) = sacc[bj];
        }
    }
};
struct EpiPool {
    static constexpr bool AFTER_DRAIN = false;
    bf16_t* MIX; const float* scale;
    __device__ __forceinline__ void operator()(const Acc& acc, const Unit& u, int wr, int wc, int fr, int fq) const {
#pragma unroll
        for (int bj = 0; bj < 2; ++bj) {
            const int col = u.pn * 256 + bj * 128 + wc * 32 + 8 * fq;
            const f32x4 s0 = *(const f32x4*)(scale + col), s1 = *(const f32x4*)(scale + col + 4);
#pragma unroll
            for (int ai = 0; ai < 2; ++ai)
#pragma unroll
                for (int m = 0; m < 4; ++m) {
                    const int row = u.pm * 256 + ai * 128 + wr * 64 + m * 16 + fr;
                    st_bf16x8(MIX + (size_t)row * D + col, acc[ai][bj][m][0] * s0, acc[ai][bj][m][1] * s1);
                }
        }
    }
    __device__ __forceinline__ void strip(const SAcc& sacc, const Unit& u, int wr, int wc, int fr, int fq) const {
        const int row = u.srow + fr;
#pragma unroll
        for (int bj = 0; bj < 2; ++bj) {
            const int col = u.pn * 256 + bj * 128 + wc * 32 + 8 * fq + 4 * wr;
            st_bf16x4(MIX + (size_t)row * D + col, sacc[bj] * *(const f32x4*)(scale + col));
        }
    }
};
struct EpiGlu {
    static constexpr bool AFTER_DRAIN = false;
    bf16_t* MIX; const bf16_t* G; const float* bias;
    __device__ __forceinline__ void operator()(const Acc& acc, const Unit& u, int wr, int wc, int fr, int fq) const {
#pragma unroll
        for (int bj = 0; bj < 2; ++bj) {
            const int col = u.pn * 256 + bj * 128 + wc * 32 + 8 * fq;
            const f32x4 b0 = *(const f32x4*)(bias + col), b1 = *(const f32x4*)(bias + col + 4);
#pragma unroll
            for (int ai = 0; ai < 2; ++ai)
#pragma unroll
                for (int m = 0; m < 4; ++m) {
                    const int row = u.pm * 256 + ai * 128 + wr * 64 + m * 16 + fr;
                    const u32x4 gw = *(const u32x4*)(G + (size_t)row * 1024 + col);
                    const f32x4 x0 = acc[ai][bj][m][0] + b0, x1 = acc[ai][bj][m][1] + b1;
                    f32x4 o0, o1;
                    o0[0] = bf_lo(gw.x) * fast_sigmoid(x0[0]); o0[1] = bf_hi(gw.x) * fast_sigmoid(x0[1]); o0[2] = bf_lo(gw.y) * fast_sigmoid(x0[2]); o0[3] = bf_hi(gw.y) * fast_sigmoid(x0[3]);
                    o1[0] = bf_lo(gw.z) * fast_sigmoid(x1[0]); o1[1] = bf_hi(gw.z) * fast_sigmoid(x1[1]); o1[2] = bf_lo(gw.w) * fast_sigmoid(x1[2]); o1[3] = bf_hi(gw.w) * fast_sigmoid(x1[3]);
                    st_bf16x8(MIX + (size_t)row * D + 1024 + col, o0, o1);
                }
        }
    }
    __device__ __forceinline__ void strip(const SAcc& sacc, const Unit& u, int wr, int wc, int fr, int fq) const {
        const int row = u.srow + fr;
#pragma unroll
        for (int bj = 0; bj < 2; ++bj) {
            const int col = u.pn * 256 + bj * 128 + wc * 32 + 8 * fq + 4 * wr;
            const u32x2 gw = *(const u32x2*)(G + (size_t)row * 1024 + col);
            const f32x4 x = sacc[bj] + *(const f32x4*)(bias + col);
            f32x4 o; o[0] = bf_lo(gw.x) * fast_sigmoid(x[0]); o[1] = bf_hi(gw.x) * fast_sigmoid(x[1]); o[2] = bf_lo(gw.y) * fast_sigmoid(x[2]); o[3] = bf_hi(gw.y) * fast_sigmoid(x[3]);
            st_bf16x4(MIX + (size_t)row * D + 1024 + col, o);
        }
    }
};
__device__ __forceinline__ void ld_res8(const float* p, f32x4& a, f32x4& b) { a = *(const f32x4*)p; b = *(const f32x4*)(p + 4); }
__device__ __forceinline__ void ld_res8(const bf16_t* p, f32x4& a, f32x4& b) { const u32x4 w = *(const u32x4*)p; a = (f32x4){bf_lo(w.x), bf_hi(w.x), bf_lo(w.y), bf_hi(w.y)}; b = (f32x4){bf_lo(w.z), bf_hi(w.z), bf_lo(w.w), bf_hi(w.w)}; }
__device__ __forceinline__ f32x4 ld_res4(const float* p) { return *(const f32x4*)p; }
__device__ __forceinline__ f32x4 ld_res4(const bf16_t* p) { const u32x2 w = *(const u32x2*)p; return (f32x4){bf_lo(w.x), bf_hi(w.x), bf_lo(w.y), bf_hi(w.y)}; }
template <class RT>
struct EpiRes {
    static constexpr bool AFTER_DRAIN = false;
    const RT* xin_p; const RT* xin_s; float* xo; bf16_t* xb; float* ss;
    __device__ __forceinline__ void operator()(const Acc& acc, const Unit& u, int wr, int wc, int fr, int fq) const {
        const RT* xin = xin_p;
#pragma unroll
        for (int ai = 0; ai < 2; ++ai)
#pragma unroll
            for (int m = 0; m < 4; ++m) {
                const int row = u.pm * 256 + ai * 128 + wr * 64 + m * 16 + fr;
                float sq = 0.f;
#pragma unroll
                for (int bj = 0; bj < 2; ++bj) {
                    const int col = u.pn * 256 + bj * 128 + wc * 32 + 8 * fq;
                    const size_t off = (size_t)row * D + col;
                    f32x4 r0, r1; ld_res8(xin + off, r0, r1);
                    const f32x4 v0 = acc[ai][bj][m][0] + r0, v1 = acc[ai][bj][m][1] + r1;
                    if (xo) { *(f32x4*)(xo + off) = v0; *(f32x4*)(xo + off + 4) = v1; }
                    if (xb) st_bf16x8(xb + off, v0, v1);
                    sq += (v0[0] * v0[0] + v0[1] * v0[1]) + (v0[2] * v0[2] + v0[3] * v0[3]) + (v1[0] * v1[0] + v1[1] * v1[1]) + (v1[2] * v1[2] + v1[3] * v1[3]);
                }
                sq += __shfl_xor(sq, 16); sq += __shfl_xor(sq, 32);
                if (fq == 0) atomicAdd(ss + row, sq);
            }
    }
    __device__ __forceinline__ void strip(const SAcc& sacc, const Unit& u, int wr, int wc, int fr, int fq) const {
        const int row = u.srow + fr; const RT* xin = xin_s - (size_t)MP * D;
        float sq = 0.f;
#pragma unroll
        for (int bj = 0; bj < 2; ++bj) {
            const int col = u.pn * 256 + bj * 128 + wc * 32 + 8 * fq + 4 * wr;
            const size_t off = (size_t)row * D + col;
            const f32x4 v = sacc[bj] + ld_res4(xin + off);
            if (xo) *(f32x4*)(xo + off) = v;
            if (xb) st_bf16x4(xb + off, v);
            sq += (v[0] * v[0] + v[1] * v[1]) + (v[2] * v[2] + v[3] * v[3]);
        }
        sq += __shfl_xor(sq, 16); sq += __shfl_xor(sq, 32);
        if (fq == 0) atomicAdd(ss + row, sq);
    }
};
struct EpiFinal {
    static constexpr bool AFTER_DRAIN = true;
    const bf16_t* xin; float* out; float* ss; unsigned* cnt; const float* gf;
    __device__ __forceinline__ void operator()(const Acc&, const Unit&, int, int, int, int) const {}
    __device__ __forceinline__ void fused(Acc& acc, f32x4 (&sacc)[2], const Unit& u, int wr, int wc, int fr, int fq, LAS unsigned char* lds, int wid, int lane) const {
#pragma unroll
        for (int ai = 0; ai < 2; ++ai)
#pragma unroll
            for (int m = 0; m < 4; ++m) {
                const int row = u.pm * 256 + ai * 128 + wr * 64 + m * 16 + fr;
                float sq = 0.f;
#pragma unroll
                for (int bj = 0; bj < 2; ++bj) {
                    const size_t off = (size_t)row * D + u.pn * 256 + bj * 128 + wc * 32 + 8 * fq;
                    f32x4 r0, r1; ld_res8(xin + off, r0, r1);
                    const f32x4 v0 = acc[ai][bj][m][0] + r0, v1 = acc[ai][bj][m][1] + r1; acc[ai][bj][m][0] = v0; acc[ai][bj][m][1] = v1;
                    sq += (v0[0] * v0[0] + v0[1] * v0[1]) + (v0[2] * v0[2] + v0[3] * v0[3]) + (v1[0] * v1[0] + v1[1] * v1[1]) + (v1[2] * v1[2] + v1[3] * v1[3]);
                }
                sq += __shfl_xor(sq, 16); sq += __shfl_xor(sq, 32);
                if (fq == 0) { const float old = atomicAdd(ss + row, sq); asm volatile("" :: "v"(old)); }
            }
        const int srow = u.srow + fr;
        {
            float sq = 0.f;
#pragma unroll
            for (int bj = 0; bj < 2; ++bj) {
                const size_t off = (size_t)srow * D + u.pn * 256 + bj * 128 + wc * 32 + 8 * fq + 4 * wr;
                const f32x4 v = sacc[bj] + ld_res4(xin + off); sacc[bj] = v;
                sq += (v[0] * v[0] + v[1] * v[1]) + (v[2] * v[2] + v[3] * v[3]);
            }
            sq += __shfl_xor(sq, 16); sq += __shfl_xor(sq, 32);
            if (fq == 0) { const float old = atomicAdd(ss + srow, sq); asm volatile("" :: "v"(old)); }
        }
        asm volatile("s_waitcnt vmcnt(0)" ::: "memory");
        __builtin_amdgcn_s_barrier();
        if (wid == 0 && lane == 0) {
            unsigned* cw = cnt + 64 * u.pm;
            __hip_atomic_fetch_add(cw, 1u, __ATOMIC_RELEASE, __HIP_MEMORY_SCOPE_AGENT);
            unsigned sp = 0;
            while (__hip_atomic_load(cw, __ATOMIC_RELAXED, __HIP_MEMORY_SCOPE_AGENT) < 8u) { __builtin_amdgcn_s_sleep(1); if (++sp > (1u << 22)) break; }
            __builtin_amdgcn_fence(__ATOMIC_ACQUIRE, "agent");
            asm volatile("s_waitcnt vmcnt(0)" ::: "memory");
        }
        __builtin_amdgcn_s_barrier(); asm volatile("" ::: "memory");
        f32x4 g0[2], g1[2];
#pragma unroll
        for (int bj = 0; bj < 2; ++bj) { const int col = u.pn * 256 + bj * 128 + wc * 32 + 8 * fq; g0[bj] = *(const f32x4*)(gf + col); g1[bj] = *(const f32x4*)(gf + col + 4); }
#pragma unroll
        for (int ai = 0; ai < 2; ++ai)
#pragma unroll
            for (int m = 0; m < 4; ++m) {
                const int row = u.pm * 256 + ai * 128 + wr * 64 + m * 16 + fr;
                const float rs = rsqrtf(__hip_atomic_load(ss + row, __ATOMIC_RELAXED, __HIP_MEMORY_SCOPE_AGENT) * (1.0f / D) + EPS);
#pragma unroll
                for (int bj = 0; bj < 2; ++bj) {
                    const size_t off = (size_t)row * D + u.pn * 256 + bj * 128 + wc * 32 + 8 * fq;
                    *(f32x4*)(out + off) = acc[ai][bj][m][0] * rs * g0[bj]; *(f32x4*)(out + off + 4) = acc[ai][bj][m][1] * rs * g1[bj];
                }
            }
        {
            const float rs = rsqrtf(__hip_atomic_load(ss + srow, __ATOMIC_RELAXED, __HIP_MEMORY_SCOPE_AGENT) * (1.0f / D) + EPS);
#pragma unroll
            for (int bj = 0; bj < 2; ++bj) {
                const int col = u.pn * 256 + bj * 128 + wc * 32 + 8 * fq + 4 * wr;
                *(f32x4*)(out + (size_t)srow * D + col) = sacc[bj] * rs * *(const f32x4*)(gf + col);
            }
        }
    }
};
struct EpiQ {
    static constexpr bool AFTER_DRAIN = false;
    bf16_t* Q; const float* ss;
    __device__ __forceinline__ void operator()(const Acc& acc, const Unit& u, int wr, int wc, int fr, int fq) const {
#pragma unroll
        for (int ai = 0; ai < 2; ++ai)
#pragma unroll
            for (int m = 0; m < 4; ++m) {
                const int row = u.pm * 256 + ai * 128 + wr * 64 + m * 16 + fr;
                const float rs = rsqrtf(ss[row] * (1.0f / D) + EPS);
#pragma unroll
                for (int bj = 0; bj < 2; ++bj) {
                    const int col = u.pn * 256 + bj * 128 + wc * 32 + 8 * fq;
                    st_bf16x8(Q + (size_t)row * D + col, acc[ai][bj][m][0] * rs, acc[ai][bj][m][1] * rs);
                }
            }
    }
    __device__ __forceinline__ void strip(const SAcc& sacc, const Unit& u, int wr, int wc, int fr, int fq) const {
        const int row = u.srow + fr; const float rs = rsqrtf(ss[row] * (1.0f / D) + EPS);
#pragma unroll
        for (int bj = 0; bj < 2; ++bj) st_bf16x4(Q + (size_t)row * D + u.pn * 256 + bj * 128 + wc * 32 + 8 * fq + 4 * wr, sacc[bj] * rs);
    }
};
struct EpiGateUp {
    static constexpr bool AFTER_DRAIN = false;
    bf16_t* H; const float* ss;
    __device__ __forceinline__ void operator()(const Acc& acc, const Unit& u, int wr, int wc, int fr, int fq) const {
        const int col = u.pn * 128 + wc * 32 + 8 * fq;
#pragma unroll
        for (int ai = 0; ai < 2; ++ai)
#pragma unroll
            for (int m = 0; m < 4; ++m) {
                const int row = u.pm * 256 + ai * 128 + wr * 64 + m * 16 + fr;
                const float rs = rsqrtf(ss[row] * (1.0f / D) + EPS);
                f32x4 o[2];
#pragma unroll
                for (int n = 0; n < 2; ++n)
#pragma unroll
                    for (int j = 0; j < 4; ++j) { const float gt = acc[ai][0][m][n][j] * rs, up = acc[ai][1][m][n][j] * rs; o[n][j] = gt * fast_sigmoid(gt) * up; }
                st_bf16x8(H + (size_t)row * FF + col, o[0], o[1]);
            }
    }
    __device__ __forceinline__ void strip(const SAcc& sacc, const Unit& u, int wr, int wc, int fr, int fq) const {
        const int row = u.srow + fr; const float rs = rsqrtf(ss[row] * (1.0f / D) + EPS);
        f32x4 o;
#pragma unroll
        for (int j = 0; j < 4; ++j) { const float gt = sacc[0][j] * rs, up = sacc[1][j] * rs; o[j] = gt * fast_sigmoid(gt) * up; }
        st_bf16x4(H + (size_t)row * FF + u.pn * 128 + wc * 32 + 8 * fq + 4 * wr, o);
    }
};
struct EpiPV {
    static constexpr bool AFTER_DRAIN = false;
    bf16_t* ATT;
    __device__ __forceinline__ void operator()(const Acc& acc, const Unit& u, int wr, int wc, int fr, int fq) const {
#pragma unroll
        for (int ai = 0; ai < 2; ++ai)
#pragma unroll
            for (int m = 0; m < 4; ++m) {
                const int row = u.pm * 256 + ai * 128 + wr * 64 + m * 16 + fr;
#pragma unroll
                for (int bj = 0; bj < 2; ++bj) {
                    const int col = u.pn * 256 + bj * 128 + wc * 32 + 8 * fq;
                    st_bf16x8(ATT + (size_t)row * D + col, acc[ai][bj][m][0], acc[ai][bj][m][1]);
                }
            }
    }
};
struct EpiSoftmax {
    static constexpr bool AFTER_DRAIN = true;
    bf16_t* PR;
    __device__ __forceinline__ void operator()(const Acc&, const Unit&, int, int, int, int) const {}
    __device__ __forceinline__ void fused(Acc& acc, f32x4 (&)[2], const Unit& u, int wr, int wc, int fr, int fq, LAS unsigned char* lds, int wid, int lane) const {
        LAS float* MX = (LAS float*)lds;
        LAS float* SM = (LAS float*)(lds + 4096);
#pragma unroll
        for (int ai = 0; ai < 2; ++ai)
#pragma unroll
            for (int m = 0; m < 4; ++m) {
                float mx = -3.0e38f;
#pragma unroll
                for (int bj = 0; bj < 2; ++bj)
#pragma unroll
                    for (int n = 0; n < 2; ++n)
#pragma unroll
                        for (int j = 0; j < 4; ++j) mx = fmaxf(mx, acc[ai][bj][m][n][j]);
                mx = fmaxf(mx, __shfl_xor(mx, 16)); mx = fmaxf(mx, __shfl_xor(mx, 32));
                if (fq == 0) MX[(ai * 128 + wr * 64 + m * 16 + fr) * 4 + wc] = mx;
            }
        LDS_WAIT(); __builtin_amdgcn_s_barrier(); asm volatile("" ::: "memory");
#pragma unroll
        for (int ai = 0; ai < 2; ++ai)
#pragma unroll
            for (int m = 0; m < 4; ++m) {
                const int r = ai * 128 + wr * 64 + m * 16 + fr;
                const f32x4 mv = *(const LAS f32x4*)(MX + r * 4);
                const float mx = fmaxf(fmaxf(mv[0], mv[1]), fmaxf(mv[2], mv[3]));
                float sm = 0.f;
#pragma unroll
                for (int bj = 0; bj < 2; ++bj)
#pragma unroll
                    for (int n = 0; n < 2; ++n)
#pragma unroll
                        for (int j = 0; j < 4; ++j) { const float e = __expf(acc[ai][bj][m][n][j] - mx); acc[ai][bj][m][n][j] = e; sm += e; }
                sm += __shfl_xor(sm, 16); sm += __shfl_xor(sm, 32);
                if (fq == 0) SM[r * 4 + wc] = sm;
            }
        LDS_WAIT(); __builtin_amdgcn_s_barrier(); asm volatile("" ::: "memory");
#pragma unroll
        for (int ai = 0; ai < 2; ++ai)
#pragma unroll
            for (int m = 0; m < 4; ++m) {
                const int r = ai * 128 + wr * 64 + m * 16 + fr;
                const f32x4 sv = *(const LAS f32x4*)(SM + r * 4);
                const float inv = __builtin_amdgcn_rcpf((sv[0] + sv[1]) + (sv[2] + sv[3]));
#pragma unroll
                for (int bj = 0; bj < 2; ++bj) {
                    const int col = bj * 128 + wc * 32 + 8 * fq;
                    st_bf16x8(PR + ((size_t)u.job * SEQ + u.pm * 256 + r) * 256 + col, acc[ai][bj][m][0] * inv, acc[ai][bj][m][1] * inv);
                }
            }
        LDS_WAIT(); __builtin_amdgcn_s_barrier(); asm volatile("" ::: "memory");
    }
};
}
using pg8::Unit;

enum { I_XP = 0, I_XS = 1, I_MEM = 2, I_PBUF = 3, I_SRE = 4, I_SIM = 5, I_CK = 6, I_CV = 7, I_GMIX = 8, I_WIN = 9, I_WPOOL = 10, I_PSCALE = 11,
       I_LRE = 12, I_LIM = 13, I_LSTEP = 14, I_BRE = 15, I_BIM = 16, I_CRE = 17, I_CIM = 18, I_SSMD = 19, I_WGLU = 20, I_BGLU = 21, I_WOUT = 22,
       I_GCROSS = 23, I_GMEM = 24, I_WQ = 25, I_WK = 26, I_WV = 27, I_WO = 28, I_GFFN = 29, I_WGATE = 30, I_WUP = 31, I_WDOWN = 32, I_GFINAL = 33 };
struct Args {
    const float* in[34];
    float* out; unsigned char* ws;
};

struct CvItem { const float* src; bf16_t* dst; const float* gk; float sc; int N, ldt; };
__device__ __forceinline__ void cv_load(const CvItem& it, f32x4 (&v)[8], float (&g)[8], int lane) {
#pragma unroll
    for (int i = 0; i < 8; ++i) { const int kk = (lane >> 3) + 8 * i; v[i] = *(const f32x4*)(it.src + (size_t)kk * it.N + 4 * (lane & 7)); g[i] = it.gk ? it.gk[kk] : 1.0f; }
}
__device__ __forceinline__ void cv_finish(const CvItem& it, const f32x4 (&v)[8], const float (&g)[8], LAS float* scr, int lane) {
#pragma unroll
    for (int i = 0; i < 8; ++i) { const int kk = (lane >> 3) + 8 * i; const float m = g[i] * it.sc; LAS float* d = scr + kk * 33 + 4 * (lane & 7);
        d[0] = v[i][0] * m; d[1] = v[i][1] * m; d[2] = v[i][2] * m; d[3] = v[i][3] * m; }
    LDS_WAIT(); __builtin_amdgcn_wave_barrier();
    const int c = lane & 7;
#pragma unroll
    for (int j = 0; j < 4; ++j) { const int n = (lane >> 3) + 8 * j; const LAS float* q = scr + (8 * c) * 33 + n;
        u32x4 o; o.x = cvt_pk_bf16(q[0 * 33], q[1 * 33]); o.y = cvt_pk_bf16(q[2 * 33], q[3 * 33]); o.z = cvt_pk_bf16(q[4 * 33], q[5 * 33]); o.w = cvt_pk_bf16(q[6 * 33], q[7 * 33]);
        *(u32x4*)(it.dst + (size_t)n * it.ldt + 8 * c) = o; }
    LDS_WAIT(); __builtin_amdgcn_wave_barrier();
}
__device__ __forceinline__ void rms_row_to_bf16(const float* xrow, const float* g, bf16_t* orow, int lane) {
    const f32x4* xr = (const f32x4*)xrow + lane; const f32x4* gr = (const f32x4*)g + lane;
    f32x4 v[8]; float s = 0.f;
#pragma unroll
    for (int j = 0; j < 8; ++j) { v[j] = xr[64 * j]; s += (v[j][0] * v[j][0] + v[j][1] * v[j][1]) + (v[j][2] * v[j][2] + v[j][3] * v[j][3]); }
    const float rstd = rsqrtf(wave_sum(s) * (1.0f / D) + EPS);
    u32x2* o8 = (u32x2*)orow + lane;
#pragma unroll
    for (int j = 0; j < 8; ++j) { const f32x4 gg = gr[64 * j]; u32x2 w; w.x = cvt_pk_bf16(v[j][0] * rstd * gg[0], v[j][1] * rstd * gg[1]); w.y = cvt_pk_bf16(v[j][2] * rstd * gg[2], v[j][3] * rstd * gg[3]); o8[64 * j] = w; }
}
__device__ __forceinline__ void cmul(float ar, float ai, float br, float bi, float& cr, float& ci) { cr = ar * br - ai * bi; ci = ar * bi + ai * br; }

__device__ __forceinline__ void ssm_chan(const float* lam_re, const float* lam_im, float delta, int g, int ch, float& ar, float& ai, float& kr, float& ki) {
    const float lr = lam_re[g * 64 + ch], li = lam_im[g * 64 + ch];
    const float mag = expf(lr * delta);
    double rev = (double)li * (double)delta * 0.15915494309189535; rev -= __builtin_rint(rev);
    const float rv = (float)rev;
    ar = mag * __builtin_amdgcn_cosf(rv); ai = mag * __builtin_amdgcn_sinf(rv);
    const float nr = ar - 1.0f, ni = ai, den = 1.0f / (lr * lr + li * li);
    kr = (nr * lr + ni * li) * den; ki = (ni * lr - nr * li) * den;
}

__device__ __forceinline__ void ssm_tables(const Args& A, int g, int lane) {
    const float* lam_re = A.in[I_LRE]; const float* lam_im = A.in[I_LIM]; const float* log_step = A.in[I_LSTEP];
    const float* b_re = A.in[I_BRE]; const float* b_im = A.in[I_BIM]; const float* c_re = A.in[I_CRE]; const float* c_im = A.in[I_CIM];
    float* ABAR = (float*)(A.ws + O_ABAR); bf16_t* BB = (bf16_t*)(A.ws + O_BB); bf16_t* CM = (bf16_t*)(A.ws + O_CM);
    const float delta = expf(log_step[g]);
    {
        float ar, ai, kr, ki; ssm_chan(lam_re, lam_im, delta, g, lane, ar, ai, kr, ki);
        float pr = ar, pi = ai;
#pragma unroll
        for (int s = 0; s < 7; ++s) { float tr, ti; cmul(pr, pi, pr, pi, tr, ti); pr = tr; pi = ti; }
        *(f32x4*)(ABAR + ((size_t)g * 64 + lane) * 4) = (f32x4){ar, ai, pr, pi};
    }
    {
        const int j = lane & 31, hi = lane >> 5;
#pragma unroll
        for (int half = 0; half < 2; ++half) {
            const int ch = j + 32 * half; float ar, ai, kr, ki; ssm_chan(lam_re, lam_im, delta, g, ch, ar, ai, kr, ki);
            float vr[8], vi[8];
#pragma unroll
            for (int i = 0; i < 8; ++i) { const int c = 8 * hi + i; const float br = b_re[((size_t)g * 64 + ch) * 16 + c], bi = b_im[((size_t)g * 64 + ch) * 16 + c]; cmul(kr, ki, br, bi, vr[i], vi[i]); }
            u32x4 wr_, wi_;
            wr_.x = cvt_pk_bf16(vr[0], vr[1]); wr_.y = cvt_pk_bf16(vr[2], vr[3]); wr_.z = cvt_pk_bf16(vr[4], vr[5]); wr_.w = cvt_pk_bf16(vr[6], vr[7]);
            wi_.x = cvt_pk_bf16(vi[0], vi[1]); wi_.y = cvt_pk_bf16(vi[2], vi[3]); wi_.z = cvt_pk_bf16(vi[4], vi[5]); wi_.w = cvt_pk_bf16(vi[6], vi[7]);
            *(u32x4*)(BB + (((size_t)g * 4 + half) * 64 + lane) * 8) = wr_;
            *(u32x4*)(BB + (((size_t)g * 4 + 2 + half) * 64 + lane) * 8) = wi_;
        }
    }
    {
        const int c = lane & 15, fq = lane >> 4;
#pragma unroll
        for (int ks = 0; ks < 4; ++ks) {
            float v[8];
#pragma unroll
            for (int i = 0; i < 8; ++i) { const int k = 32 * ks + 8 * fq + i, jj = k >> 2, sel = k & 3, ch = jj + 32 * (sel >> 1);
                v[i] = (sel & 1) ? -c_im[((size_t)g * 16 + c) * 64 + ch] : c_re[((size_t)g * 16 + c) * 64 + ch]; }
            u32x4 w; w.x = cvt_pk_bf16(v[0], v[1]); w.y = cvt_pk_bf16(v[2], v[3]); w.z = cvt_pk_bf16(v[4], v[5]); w.w = cvt_pk_bf16(v[6], v[7]);
            *(u32x4*)(CM + (((size_t)g * 4 + ks) * 64 + lane) * 8) = w;
        }
    }
}

constexpr int I_SQ = (D / 64) * (D / 32);
constexpr int I_POOL = 4 * (256 / 64) * (256 / 32);
constexpr int I_GLU = (1024 / 64) * (1024 / 32);
constexpr int I_FF = (D / 64) * (FF / 32);
constexpr int I_DN = (FF / 64) * (D / 32);
constexpr int NITEMS = 6 * I_SQ + I_POOL + I_GLU + 2 * I_FF + I_DN, NEARLY = 3 * I_SQ;
__device__ __forceinline__ CvItem cv_decode(const Args& A, int r) {
    unsigned char* ws = A.ws; CvItem it; it.gk = nullptr; it.sc = 1.f;
    const float* W; bf16_t* WT; int N, ldt, k0, n0, row0; const float* gkb = nullptr;
    if (r < 6 * I_SQ) {
        const int mtx = r / I_SQ; r -= mtx * I_SQ; const int kb = r / (D / 32), nb = r % (D / 32);
        N = D; ldt = D; k0 = 64 * kb; n0 = 32 * nb; row0 = n0;
        switch (mtx) {
            case 0: W = A.in[I_WIN]; WT = (bf16_t*)(ws + O_WIN); break;
            case 1: W = A.in[I_WK]; WT = (bf16_t*)(ws + O_WKV); break;
            case 2: W = A.in[I_WV]; WT = (bf16_t*)(ws + O_WKV); row0 += D; break;
            case 3: W = A.in[I_WOUT]; WT = (bf16_t*)(ws + O_WOUT); break;
            case 4: W = A.in[I_WQ]; WT = (bf16_t*)(ws + O_WQ); gkb = A.in[I_GCROSS]; it.sc = 0.04419417382415922f; break;
            default: W = A.in[I_WO]; WT = (bf16_t*)(ws + O_WO); break;
        }
    } else if ((r -= 6 * I_SQ) < I_POOL) {
        const int gg = r / 32, q = r % 32, kb = q / 8, nb = q % 8;
        W = A.in[I_WPOOL] + (size_t)gg * 65536; WT = (bf16_t*)(ws + O_WPOOL); N = 256; ldt = 256; k0 = 64 * kb; n0 = 32 * nb; row0 = gg * 256 + n0;
    } else if ((r -= I_POOL) < I_GLU) {
        const int kb = r / 32, nb = r % 32; W = A.in[I_WGLU]; WT = (bf16_t*)(ws + O_WGLU); N = 1024; ldt = 1024; k0 = 64 * kb; n0 = 32 * nb; row0 = n0;
    } else if ((r -= I_GLU) < 2 * I_FF) {
        const int up = r / I_FF; r -= up * I_FF; const int kb = r / (FF / 32), nb = r % (FF / 32);
        W = up ? A.in[I_WUP] : A.in[I_WGATE]; WT = (bf16_t*)(ws + O_WGU); N = FF; ldt = D; k0 = 64 * kb; n0 = 32 * nb; row0 = (n0 >> 7) * 256 + up * 128 + (n0 & 127); gkb = A.in[I_GFFN];
    } else {
        r -= 2 * I_FF; const int kb = r / (D / 32), nb = r % (D / 32);
        W = A.in[I_WDOWN]; WT = (bf16_t*)(ws + O_WDN); N = D; ldt = FF; k0 = 64 * kb; n0 = 32 * nb; row0 = n0;
    }
    it.src = W + (size_t)k0 * N + n0; it.dst = WT + (size_t)row0 * ldt + k0; it.gk = gkb ? gkb + k0 : nullptr; it.N = N; it.ldt = ldt;
    return it;
}
__device__ __forceinline__ void convert_weights(const Args& A, LAS unsigned char* lds, int lo, int hi, int gw, int NGW, const int wv) {
    const int tid = opaque_tid(wv), lane = tid & 63, wave = __builtin_amdgcn_readfirstlane(tid >> 6);
    LAS float* scr = (LAS float*)(lds + wave * 16384);
    if (gw < 0) return;
    int it = lo + gw; if (it >= hi) return;
    CvItem cur = cv_decode(A, it); f32x4 va[8]; float ga[8]; cv_load(cur, va, ga, lane);
    for (;;) {
        const int nit = it + NGW; const bool hn = nit < hi;
        CvItem nx = cur; f32x4 vb[8]; float gb[8];
        if (hn) { nx = cv_decode(A, nit); cv_load(nx, vb, gb, lane); }
        cv_finish(cur, va, ga, scr, lane);
        if (!hn) break;
        cur = nx; it = nit;
#pragma unroll
        for (int i = 0; i < 8; ++i) { va[i] = vb[i]; ga[i] = gb[i]; }
    }
}
__device__ __forceinline__ void phase0_rest(const Args& A, int G, const int wv) {
    const int tid = opaque_tid(wv), lane = tid & 63, wave = __builtin_amdgcn_readfirstlane(tid >> 6);
    const int gw = blockIdx.x * 8 + wave, NGW = G * 8;
    unsigned char* ws = A.ws;
    for (int m = gw; m < M + 1024; m += NGW) {
        if (m < MP) rms_row_to_bf16(A.in[I_XP] + (size_t)m * D, A.in[I_GMIX], (bf16_t*)(ws + O_HMIX) + (size_t)m * D, lane);
        else if (m < M) rms_row_to_bf16(A.in[I_XS] + (size_t)(m - MP) * D, A.in[I_GMIX], (bf16_t*)(ws + O_HMIX) + (size_t)m * D, lane);
        else rms_row_to_bf16(A.in[I_MEM] + (size_t)(m - M) * D, A.in[I_GMEM], (bf16_t*)(ws + O_MN) + (size_t)(m - M) * D, lane);
    }
    for (int g = gw; g < NG; g += NGW) ssm_tables(A, g, lane);
    {
        const f32x4* src = (const f32x4*)A.in[I_PBUF]; f32x4* dst = (f32x4*)(A.out + OUT_PBS);
        const int total = DB * 11 * (PW / 4);
        for (int i = blockIdx.x * 512 + tid; i < total; i += G * 512) { const int b = i / (11 * 256), r = i % (11 * 256); dst[(size_t)b * (15 * 256) + r] = src[(size_t)b * (15 * 256) + 4 * 256 + r]; }
    }
}

__device__ __forceinline__ void acc8(float (&s)[8], u32x4 w) {
    s[0] += bf_lo(w.x); s[1] += bf_hi(w.x); s[2] += bf_lo(w.y); s[3] += bf_hi(w.y); s[4] += bf_lo(w.z); s[5] += bf_hi(w.z); s[6] += bf_lo(w.w); s[7] += bf_hi(w.w);
}
template <int W>
__device__ __forceinline__ void pooled_prompt_item(const bf16_t* P, bf16_t* PO, int row0, int col) {
    const int t0 = row0 & (SEQ - 1);
    u32x4 z[W + 7];
#pragma unroll
    for (int i = 0; i < W + 7; ++i) {
        const int t = t0 - (W - 1) + i;
        z[i] = (u32x4){0u, 0u, 0u, 0u};
        if (t >= 0) z[i] = *(const u32x4*)(P + (size_t)(row0 - (W - 1) + i) * D + col);
    }
    float s[8] = {0.f, 0.f, 0.f, 0.f, 0.f, 0.f, 0.f, 0.f};
#pragma unroll
    for (int i = 0; i < W - 1; ++i) acc8(s, z[i]);
#pragma unroll
    for (int o = 0; o < 8; ++o) {
        const u32x4 uw = z[o + W - 1];
        acc8(s, uw);
        const int n = (t0 + o + 1 < W) ? t0 + o + 1 : W; const float ic = 1.0f / (float)n;
        u32x4 ow;
        ow.x = cvt_pk_bf16(s[0] * ic - bf_lo(uw.x), s[1] * ic - bf_hi(uw.x)); ow.y = cvt_pk_bf16(s[2] * ic - bf_lo(uw.y), s[3] * ic - bf_hi(uw.y));
        ow.z = cvt_pk_bf16(s[4] * ic - bf_lo(uw.z), s[5] * ic - bf_hi(uw.z)); ow.w = cvt_pk_bf16(s[6] * ic - bf_lo(uw.w), s[7] * ic - bf_hi(uw.w));
        *(u32x4*)(PO + (size_t)(row0 + o) * 1024 + col) = ow;
        const u32x4 zo = z[o];
        s[0] -= bf_lo(zo.x); s[1] -= bf_hi(zo.x); s[2] -= bf_lo(zo.y); s[3] -= bf_hi(zo.y); s[4] -= bf_lo(zo.z); s[5] -= bf_hi(zo.z); s[6] -= bf_lo(zo.w); s[7] -= bf_hi(zo.w);
    }
}
template <int W>
__device__ __forceinline__ void pooled_sample_item(const bf16_t* P, bf16_t* PO, const float* sbuf, int b, int col) {
    float h[W - 1][8];
#pragma unroll
    for (int i = 0; i < W - 1; ++i) { const float* q = sbuf + ((size_t)b * PBUF + (PBUF - (W - 1) + i)) * PW + col; const f32x4 a = *(const f32x4*)q, c = *(const f32x4*)(q + 4);
        h[i][0] = a[0]; h[i][1] = a[1]; h[i][2] = a[2]; h[i][3] = a[3]; h[i][4] = c[0]; h[i][5] = c[1]; h[i][6] = c[2]; h[i][7] = c[3]; }
    u32x4 z[4];
#pragma unroll
    for (int t = 0; t < 4; ++t) z[t] = *(const u32x4*)(P + ((size_t)MP + b * 4 + t) * D + col);
    float s[8] = {0.f, 0.f, 0.f, 0.f, 0.f, 0.f, 0.f, 0.f};
#pragma unroll
    for (int i = 0; i < W - 1; ++i)
#pragma unroll
        for (int j = 0; j < 8; ++j) s[j] += h[i][j];
    const float ic = 1.0f / (float)W;
#pragma unroll
    for (int t = 0; t < 4; ++t) {
        const u32x4 uw = z[t];
        acc8(s, uw);
        u32x4 o;
        o.x = cvt_pk_bf16(s[0] * ic - bf_lo(uw.x), s[1] * ic - bf_hi(uw.x)); o.y = cvt_pk_bf16(s[2] * ic - bf_lo(uw.y), s[3] * ic - bf_hi(uw.y));
        o.z = cvt_pk_bf16(s[4] * ic - bf_lo(uw.z), s[5] * ic - bf_hi(uw.z)); o.w = cvt_pk_bf16(s[6] * ic - bf_lo(uw.w), s[7] * ic - bf_hi(uw.w));
        *(u32x4*)(PO + ((size_t)MP + b * 4 + t) * 1024 + col) = o;
        if (t < W - 1) {
#pragma unroll
            for (int j = 0; j < 8; ++j) s[j] -= h[t < W - 1 ? t : 0][j];
        } else {
            const u32x4 zo = z[t - (W - 1) >= 0 ? t - (W - 1) : 0];
            s[0] -= bf_lo(zo.x); s[1] -= bf_hi(zo.x); s[2] -= bf_lo(zo.y); s[3] -= bf_hi(zo.y); s[4] -= bf_lo(zo.z); s[5] -= bf_hi(zo.z); s[6] -= bf_lo(zo.w); s[7] -= bf_hi(zo.w);
        }
    }
}
__device__ __forceinline__ void pooled_phase(const Args& A, int G, const int wv) {
    const bf16_t* P = (const bf16_t*)(A.ws + O_P); bf16_t* PO = (bf16_t*)(A.ws + O_POOLED); const float* sbuf = A.in[I_PBUF];
    const int tid0 = blockIdx.x * 512 + opaque_tid(wv);
    for (int it = tid0; it < 4 * 1024 * 32; it += G * 512) {
        const int g = it >> 15, rb = (it >> 5) & 1023, col = g * 256 + (it & 31) * 8, row0 = rb * 8;
        if (g == 0) pooled_prompt_item<2>(P, PO, row0, col); else if (g == 1) pooled_prompt_item<4>(P, PO, row0, col);
        else if (g == 2) pooled_prompt_item<8>(P, PO, row0, col); else pooled_prompt_item<16>(P, PO, row0, col);
    }
    for (int it = tid0; it < 4 * DB * 32; it += G * 512) {
        const int g = it >> 12, b = (it >> 5) & (DB - 1), col = g * 256 + (it & 31) * 8;
        if (g == 0) pooled_sample_item<2>(P, PO, sbuf, b, col); else if (g == 1) pooled_sample_item<4>(P, PO, sbuf, b, col);
        else if (g == 2) pooled_sample_item<8>(P, PO, sbuf, b, col); else pooled_sample_item<16>(P, PO, sbuf, b, col);
    }
}

struct SsmCtx {
    bf16x8 BB[4], CMf[4];
    float a[4];
    float dsk[4];
    float s[4];
};
template <int MODE>
__device__ __forceinline__ void ssm_sub(SsmCtx& cx, const bf16_t* P, bf16_t* Gout, int g, const bf16x8 af  ,
                                        const size_t (&yrow)[2]  , LAS unsigned char* tile, int lane,
                                        const float* h_re, const float* h_im, float* o_re, float* o_im, int sbatch0  ) {
    const int j = lane & 31, hi = lane >> 5, fr = lane & 15, fq = lane >> 4;
    u32x2 uwp[2] = {(u32x2){0u, 0u}, (u32x2){0u, 0u}};
    if (MODE != 0) { uwp[0] = *(const u32x2*)(P + yrow[0] * D + 1024 + 16 * g + 4 * fq); uwp[1] = *(const u32x2*)(P + yrow[1] * D + 1024 + 16 * g + 4 * fq); }
    const f32x16 z = {0.f, 0.f, 0.f, 0.f, 0.f, 0.f, 0.f, 0.f, 0.f, 0.f, 0.f, 0.f, 0.f, 0.f, 0.f, 0.f};
    const f32x16 r0 = __builtin_amdgcn_mfma_f32_32x32x16_bf16(af, cx.BB[0], z, 0, 0, 0);
    const f32x16 r1 = __builtin_amdgcn_mfma_f32_32x32x16_bf16(af, cx.BB[1], z, 0, 0, 0);
    const f32x16 i0 = __builtin_amdgcn_mfma_f32_32x32x16_bf16(af, cx.BB[2], z, 0, 0, 0);
    const f32x16 i1 = __builtin_amdgcn_mfma_f32_32x32x16_bf16(af, cx.BB[3], z, 0, 0, 0);
    float sr0 = cx.s[0], si0 = cx.s[1], sr1 = cx.s[2], si1 = cx.s[3];
    const float ar0 = cx.a[0], ai0 = cx.a[1], ar1 = cx.a[2], ai1 = cx.a[3];
#pragma unroll
    for (int r = 0; r < 16; ++r) {
        if (MODE == 2 && (r & 3) == 0) {
            const size_t o = ((size_t)(sbatch0 + (r >> 2)) * NG + g) * 64 + j;
            sr0 = h_re[o]; si0 = h_im[o]; sr1 = h_re[o + 32]; si1 = h_im[o + 32];
        }
        const float nr0 = fmaf(ar0, sr0, fmaf(-ai0, si0, r0[r])), ni0 = fmaf(ar0, si0, fmaf(ai0, sr0, i0[r]));
        const float nr1 = fmaf(ar1, sr1, fmaf(-ai1, si1, r1[r])), ni1 = fmaf(ar1, si1, fmaf(ai1, sr1, i1[r]));
        sr0 = nr0; si0 = ni0; sr1 = nr1; si1 = ni1;
        if (MODE != 0) { u32x2 w; w.x = cvt_pk_bf16(sr0, si0); w.y = cvt_pk_bf16(sr1, si1); *(LAS u32x2*)(tile + (16 * hi + r) * 272 + 8 * j) = w; }
        if (MODE == 2 && (r & 3) == 3) {
            const size_t o = ((size_t)(sbatch0 + (r >> 2)) * NG + g) * 64 + j;
            o_re[o] = sr0; o_im[o] = si0; o_re[o + 32] = sr1; o_im[o + 32] = si1;
        }
    }
    cx.s[0] = sr0; cx.s[1] = si0; cx.s[2] = sr1; cx.s[3] = si1;
    if (MODE != 0) {
        LDS_WAIT(); __builtin_amdgcn_wave_barrier();
#pragma unroll
        for (int tg = 0; tg < 2; ++tg) {
            f32x4 y = {0.f, 0.f, 0.f, 0.f};
#pragma unroll
            for (int ks = 0; ks < 4; ++ks) {
                const bf16x8 sf = *(const LAS bf16x8*)(tile + (16 * tg + fr) * 272 + (32 * ks + 8 * fq) * 2);
                y = __builtin_amdgcn_mfma_f32_16x16x32_bf16(cx.CMf[ks], sf, y, 0, 0, 0);
            }
            const u32x2 uw = uwp[tg];
            const float y0 = gelu_tanh(y[0] + cx.dsk[0] * bf_lo(uw.x)), y1 = gelu_tanh(y[1] + cx.dsk[1] * bf_hi(uw.x));
            const float y2 = gelu_tanh(y[2] + cx.dsk[2] * bf_lo(uw.y)), y3 = gelu_tanh(y[3] + cx.dsk[3] * bf_hi(uw.y));
            u32x2 o; o.x = cvt_pk_bf16(y0, y1); o.y = cvt_pk_bf16(y2, y3);
            *(u32x2*)(Gout + yrow[tg] * 1024 + 16 * g + 4 * fq) = o;
        }
    }
}

__device__ __forceinline__ void ssm_load_ctx(SsmCtx& cx, const Args& A, int g, int lane) {
    const bf16_t* BB = (const bf16_t*)(A.ws + O_BB); const bf16_t* CM = (const bf16_t*)(A.ws + O_CM); const float* ABAR = (const float*)(A.ws + O_ABAR);
    const int j = lane & 31, fq = lane >> 4;
#pragma unroll
    for (int i = 0; i < 4; ++i) { cx.BB[i] = *(const bf16x8*)(BB + (((size_t)g * 4 + i) * 64 + lane) * 8); cx.CMf[i] = *(const bf16x8*)(CM + (((size_t)g * 4 + i) * 64 + lane) * 8); }
    const f32x4 a0 = *(const f32x4*)(ABAR + ((size_t)g * 64 + j) * 4), a1 = *(const f32x4*)(ABAR + ((size_t)g * 64 + j + 32) * 4);
    cx.a[0] = a0[0]; cx.a[1] = a0[1]; cx.a[2] = a1[0]; cx.a[3] = a1[1];
    const f32x4 dv = *(const f32x4*)(A.in[I_SSMD] + 16 * g + 4 * fq);
    cx.dsk[0] = dv[0]; cx.dsk[1] = dv[1]; cx.dsk[2] = dv[2]; cx.dsk[3] = dv[3];
}

__device__ __forceinline__ void ssm_phase(const Args& A, LAS unsigned char* lds, int G, const int wv) {
    const int tid = opaque_tid(wv), lane = tid & 63, w = __builtin_amdgcn_readfirstlane(tid >> 6);
    const int j = lane & 31, hi = lane >> 5, fr = lane & 15;
    const bf16_t* P = (const bf16_t*)(A.ws + O_P); bf16_t* Gout = (bf16_t*)(A.ws + O_G);
    const float* ABAR = (const float*)(A.ws + O_ABAR);
    LAS unsigned char* tile = lds + w * 8704;
    LAS f32x4* EL = (LAS f32x4*)(lds + 8 * 8704);
    const int arow_i = lane & 31, own = (arow_i >> 2) & 1, rloc = 4 * (arow_i >> 3) + (arow_i & 3);
    for (int un = blockIdx.x; un < NB * NG; un += G) {
        const int b = un >> 6, g = un & 63;
        SsmCtx cx; ssm_load_ctx(cx, A, g, lane);
        const f32x4 p0 = *(const f32x4*)(ABAR + ((size_t)g * 64 + j) * 4), p1 = *(const f32x4*)(ABAR + ((size_t)g * 64 + j + 32) * 4);
        const size_t rowb = (size_t)b * SEQ;
        size_t yrow[2];
        cx.s[0] = cx.s[1] = cx.s[2] = cx.s[3] = 0.f;
        const bf16_t* abase = P + (rowb + (2 * w + own) * 128 + rloc) * D + 1024 + 16 * g + 8 * hi;
        bf16x8 af = *(const bf16x8*)abase;
        for (int k = 0; k < 8; ++k) {
            const bf16x8 afn = *(const bf16x8*)(abase + (size_t)(16 * ((k + 1) & 7)) * D);
            yrow[0] = 0; yrow[1] = 0;
            ssm_sub<0>(cx, P, Gout, g, af, yrow, tile, lane, nullptr, nullptr, nullptr, nullptr, 0);
            af = afn;
        }
        EL[(2 * w + hi) * 32 + j] = (f32x4){cx.s[0], cx.s[1], cx.s[2], cx.s[3]};
        LDS_WAIT(); __syncthreads();
        {
            float sr0 = 0.f, si0 = 0.f, sr1 = 0.f, si1 = 0.f; const int wk = 2 * w + hi;
            for (int q = 0; q < 15; ++q) {
                if (q < wk) { const f32x4 e = EL[q * 32 + j]; float tr, ti;
                    cmul(p0[2], p0[3], sr0, si0, tr, ti); sr0 = tr + e[0]; si0 = ti + e[1];
                    cmul(p1[2], p1[3], sr1, si1, tr, ti); sr1 = tr + e[2]; si1 = ti + e[3]; }
            }
            cx.s[0] = sr0; cx.s[1] = si0; cx.s[2] = sr1; cx.s[3] = si1;
        }
        for (int k = 0; k < 8; ++k) {
            const bf16x8 afn = *(const bf16x8*)(abase + (size_t)(16 * ((k + 1) & 7)) * D);
            yrow[0] = rowb + (2 * w) * 128 + 16 * k + fr; yrow[1] = rowb + (2 * w + 1) * 128 + 16 * k + fr;
            ssm_sub<1>(cx, P, Gout, g, af, yrow, tile, lane, nullptr, nullptr, nullptr, nullptr, 0);
            af = afn;
        }
        if (w == 7 && hi == 1) {
            const size_t o = ((size_t)b * NG + g) * 64 + j;
            A.out[OUT_REP + o] = cx.s[0]; A.out[OUT_IMP + o] = cx.s[1]; A.out[OUT_REP + o + 32] = cx.s[2]; A.out[OUT_IMP + o + 32] = cx.s[3];
        }
        LDS_WAIT(); __syncthreads();
    }
    for (int un = (int)blockIdx.x; un < 2 * NG; un += G) {
        const int g = un >> 1, bh = un & 1;
        SsmCtx cx; ssm_load_ctx(cx, A, g, lane);
        cx.s[0] = cx.s[1] = cx.s[2] = cx.s[3] = 0.f;
        const int bbase = bh * 64 + w * 8;
        const size_t arow = (size_t)MP + (size_t)(bbase + own * 4 + (arow_i >> 3)) * 4 + (arow_i & 3);
        size_t yrow[2];
        yrow[0] = (size_t)MP + (size_t)(bbase + (fr >> 2)) * 4 + (fr & 3); yrow[1] = (size_t)MP + (size_t)(bbase + 4 + (fr >> 2)) * 4 + (fr & 3);
        const bf16x8 af = *(const bf16x8*)(P + arow * D + 1024 + 16 * g + 8 * hi);
        ssm_sub<2>(cx, P, Gout, g, af, yrow, tile, lane, A.in[I_SRE], A.in[I_SIM], A.out + OUT_RES, A.out + OUT_IMS, bbase + hi * 4);
    }
}

template <int WPU>
__device__ __forceinline__ void sample_attn_units(const Args& A, LAS unsigned char* lds, int su0, const int wv) {
    constexpr int KPW = 256 / WPU, NB = KPW / 8, NKG = KPW / 16;
    const int tid = opaque_tid(wv), lane = tid & 63, w = __builtin_amdgcn_readfirstlane(tid >> 6), fr = lane & 15, fq = lane >> 4;
    const int su = su0 + (WPU == 4 ? (w >> 2) : 0), b = su >> 2, h = su & 3, kq = (WPU == 4) ? (w & 3) : w;
    const bf16_t* Q = (const bf16_t*)(A.ws + O_Q); bf16_t* ATT = (bf16_t*)(A.ws + O_ATT);
    const float* Kc = A.in[I_CK] + (((size_t)b * NMEM + KPW * kq) * NH + h) * HD;
    const float* Vc = A.in[I_CV] + (((size_t)b * NMEM + KPW * kq) * NH + h) * HD;
    LAS bf16_t* QSw = (LAS bf16_t*)(lds + w * 4096);
    LAS float* PLw = (LAS float*)(lds + 32768 + w * 1024);
    LAS float* ML = (LAS float*)(lds + 40960);
    LAS float* RED = (LAS float*)(lds + 49152);
#pragma unroll
    for (int t = 0; t < 4; ++t) *(LAS u32x4*)(QSw + t * 512 + lane * 8) = *(const u32x4*)(Q + ((size_t)MP + b * 4 + t) * D + h * HD + lane * 8);
    f32x4 ra[16], rb[16];
#define KLOAD(dst, bi) do { const float* kp_ = Kc + (size_t)(16 * ((bi) >> 1) + fr) * (NH * HD) + 4 * fq + 256 * ((bi) & 1); \
        _Pragma("unroll") for (int i = 0; i < 8; ++i) { dst[2 * i] = *(const f32x4*)(kp_ + 32 * i); dst[2 * i + 1] = *(const f32x4*)(kp_ + 32 * i + 16); } } while (0)
#define KUSE(src, bi) do { _Pragma("unroll") for (int i = 0; i < 8; ++i) { const int kd = 8 * ((bi) & 1) + i; const f32x4 k0 = src[2 * i], k1 = src[2 * i + 1]; \
        u32x4 kw; kw.x = cvt_pk_bf16(k0[0], k0[1]); kw.y = cvt_pk_bf16(k0[2], k0[3]); kw.z = cvt_pk_bf16(k1[0], k1[1]); kw.w = cvt_pk_bf16(k1[2], k1[3]); \
        u32x4 qw = {0u, 0u, 0u, 0u}; \
        if (fr < 4) { const u32x2 qa = *(const LAS u32x2*)(QSw + fr * 512 + 32 * kd + 4 * fq), qb = *(const LAS u32x2*)(QSw + fr * 512 + 32 * kd + 16 + 4 * fq); qw.x = qa.x; qw.y = qa.y; qw.z = qb.x; qw.w = qb.y; } \
        sc[(bi) >> 1] = __builtin_amdgcn_mfma_f32_16x16x32_bf16(__builtin_bit_cast(bf16x8, kw), __builtin_bit_cast(bf16x8, qw), sc[(bi) >> 1], 0, 0, 0); } } while (0)
#define VLOAD(dst, vb) do { const float* vp_ = Vc + (size_t)(8 * (vb)) * (NH * HD) + 4 * lane; \
        _Pragma("unroll") for (int k = 0; k < 8; ++k) { dst[2 * k] = __builtin_nontemporal_load((const f32x4*)(vp_ + (size_t)k * (NH * HD))); dst[2 * k + 1] = __builtin_nontemporal_load((const f32x4*)(vp_ + (size_t)k * (NH * HD) + 256)); } } while (0)
#define VUSE(src, vb) do { _Pragma("unroll") for (int k = 0; k < 8; ++k) { const f32x4 p = *(const LAS f32x4*)(PLw + (8 * (vb) + k) * 4); \
        _Pragma("unroll") for (int t = 0; t < 4; ++t) { o[t][0] += src[2 * k] * p[t]; o[t][1] += src[2 * k + 1] * p[t]; } } } while (0)
#define SB() __builtin_amdgcn_sched_barrier(0)
    KLOAD(ra, 0); KLOAD(rb, 1);
    LDS_WAIT(); __builtin_amdgcn_wave_barrier();
    f32x4 sc[NKG];
#pragma unroll
    for (int i = 0; i < NKG; ++i) sc[i] = (f32x4){0.f, 0.f, 0.f, 0.f};
    SB(); KUSE(ra, 0); SB(); KLOAD(ra, 2); SB(); KUSE(rb, 1); SB(); KLOAD(rb, 3); SB();
    if constexpr (NB == 8) {
        KUSE(ra, 2); SB(); KLOAD(ra, 4); SB(); KUSE(rb, 3); SB(); KLOAD(rb, 5); SB();
        KUSE(ra, 4); SB(); KLOAD(ra, 6); SB(); KUSE(rb, 5); SB(); KLOAD(rb, 7); SB();
        KUSE(ra, 6); SB(); VLOAD(ra, 0); SB(); KUSE(rb, 7); SB(); VLOAD(rb, 1); SB();
    } else {
        KUSE(ra, 2); SB(); VLOAD(ra, 0); SB(); KUSE(rb, 3); SB(); VLOAD(rb, 1); SB();
    }
    float mt = -3.0e38f;
#pragma unroll
    for (int kg = 0; kg < NKG; ++kg) mt = fmaxf(mt, fmaxf(fmaxf(sc[kg][0], sc[kg][1]), fmaxf(sc[kg][2], sc[kg][3])));
    mt = fmaxf(mt, __shfl_xor(mt, 16)); mt = fmaxf(mt, __shfl_xor(mt, 32));
    float lt = 0.f;
#pragma unroll
    for (int kg = 0; kg < NKG; ++kg)
#pragma unroll
        for (int r = 0; r < 4; ++r) { const float e = __expf(sc[kg][r] - mt); lt += e; if (fr < 4) PLw[(16 * kg + 4 * fq + r) * 4 + fr] = e; }
    lt += __shfl_xor(lt, 16); lt += __shfl_xor(lt, 32);
    if (fr < 4 && fq == 0) { ML[(w * 4 + fr) * 2] = mt; ML[(w * 4 + fr) * 2 + 1] = lt; }
    LDS_WAIT(); __builtin_amdgcn_wave_barrier();
    f32x4 o[4][2];
#pragma unroll
    for (int t = 0; t < 4; ++t) { o[t][0] = (f32x4){0.f, 0.f, 0.f, 0.f}; o[t][1] = (f32x4){0.f, 0.f, 0.f, 0.f}; }
    SB(); VUSE(ra, 0); SB(); VLOAD(ra, 2); SB(); VUSE(rb, 1); SB(); VLOAD(rb, 3); SB();
    if constexpr (NB == 8) {
        VUSE(ra, 2); SB(); VLOAD(ra, 4); SB(); VUSE(rb, 3); SB(); VLOAD(rb, 5); SB();
        VUSE(ra, 4); SB(); VLOAD(ra, 6); SB(); VUSE(rb, 5); SB(); VLOAD(rb, 7); SB();
        VUSE(ra, 6); SB(); VUSE(rb, 7);
    } else {
        VUSE(ra, 2); SB(); VUSE(rb, 3);
    }
#undef KLOAD
#undef KUSE
#undef VLOAD
#undef VUSE
#undef SB
#pragma unroll
    for (int t = 0; t < 4; ++t) { *(LAS f32x4*)(RED + (w * 4 + t) * 512 + 4 * lane) = o[t][0]; *(LAS f32x4*)(RED + (w * 4 + t) * 512 + 256 + 4 * lane) = o[t][1]; }
    LDS_WAIT(); __syncthreads();
    if constexpr (WPU == 4) {
        const int uh = tid >> 8, t = (tid >> 6) & 3, c = (tid & 63) * 8;
        float m4[4], l4[4], Mx = -3.0e38f;
#pragma unroll
        for (int q = 0; q < 4; ++q) { m4[q] = ML[((uh * 4 + q) * 4 + t) * 2]; l4[q] = ML[((uh * 4 + q) * 4 + t) * 2 + 1]; Mx = fmaxf(Mx, m4[q]); }
        f32x4 s0 = {0.f, 0.f, 0.f, 0.f}, s1 = {0.f, 0.f, 0.f, 0.f}; float L = 0.f;
#pragma unroll
        for (int q = 0; q < 4; ++q) { const float f = __expf(m4[q] - Mx); L += l4[q] * f;
            s0 += *(const LAS f32x4*)(RED + ((uh * 4 + q) * 4 + t) * 512 + c) * f; s1 += *(const LAS f32x4*)(RED + ((uh * 4 + q) * 4 + t) * 512 + c + 4) * f; }
        const float iv = 1.0f / L; const int su2 = su0 + uh, b2 = su2 >> 2, h2 = su2 & 3;
        pg8::st_bf16x8(ATT + ((size_t)MP + b2 * 4 + t) * D + h2 * HD + c, s0 * iv, s1 * iv);
    } else {
        const int t = tid >> 7, c = (tid & 127) * 4;
        float m8[8], l8[8], Mx = -3.0e38f;
#pragma unroll
        for (int q = 0; q < 8; ++q) { m8[q] = ML[(q * 4 + t) * 2]; l8[q] = ML[(q * 4 + t) * 2 + 1]; Mx = fmaxf(Mx, m8[q]); }
        f32x4 s0 = {0.f, 0.f, 0.f, 0.f}; float L = 0.f;
#pragma unroll
        for (int q = 0; q < 8; ++q) { const float f = __expf(m8[q] - Mx); L += l8[q] * f; s0 += *(const LAS f32x4*)(RED + (q * 4 + t) * 512 + c) * f; }
        const float iv = 1.0f / L; const int b2 = su0 >> 2, h2 = su0 & 3;
        pg8::st_bf16x4(ATT + ((size_t)MP + b2 * 4 + t) * D + h2 * HD + c, s0 * iv);
    }
    LDS_WAIT(); __syncthreads();
}

constexpr int MTP = MP / 256;
struct SchedGrid {
    int G, c, nM, nN; const char* A; const char* B; size_t ta, tb; const char* Sb; size_t ts;
    __device__ __forceinline__ bool next(int i, Unit& u) const {
        const int L = i * G + c; if (L >= nM * nN) return false;
        u.pm = L % nM; u.pn = L / nM; u.job = 0; u.a = A + (size_t)u.pm * ta; u.b = B + (size_t)u.pn * tb; u.s = Sb + (size_t)u.pm * ts; u.srow = MP + 16 * u.pm; return true;
    }
};
struct Sched1 {
    int G, c; const char* hmix; const char* win; const char* mn; const char* wkv;
    __device__ __forceinline__ bool next(int i, Unit& u) const {
        int L = i * G + c;
        if (L < MTP * 8) { u.job = 0; u.pm = L % MTP; u.pn = L / MTP; u.a = hmix + (size_t)u.pm * 256 * D * 2; u.b = win + (size_t)u.pn * 256 * D * 2;
            u.s = hmix + ((size_t)MP + 16 * u.pm) * D * 2; u.srow = MP + 16 * u.pm; return true; }
        L -= MTP * 8;
        if (L < 64) { u.job = 1; u.pm = L & 3; u.pn = L >> 2; u.a = mn + (size_t)u.pm * 256 * D * 2; u.b = wkv + (size_t)u.pn * 256 * D * 2; u.s = u.a; u.srow = -1; return true; }
        return false;
    }
};
struct SchedPool {
    int G, c; const char* pooled; const char* wp;
    __device__ __forceinline__ bool next(int i, Unit& u) const {
        const int L = i * G + c; if (L >= MTP * 4) return false;
        u.job = 0; u.pm = L % MTP; u.pn = L / MTP; u.a = pooled + ((size_t)u.pm * 256 * 1024 + u.pn * 256) * 2; u.b = wp + (size_t)u.pn * 256 * 256 * 2;
        u.s = pooled + (((size_t)MP + 16 * u.pm) * 1024 + u.pn * 256) * 2; u.srow = MP + 16 * u.pm; return true;
    }
};
struct SchedScores {
    int c; const char* Q; const char* KB;
    __device__ __forceinline__ bool next(int i, Unit& u) const {
        if (i > 0 || c >= 128) return false;
        const int bh = c >> 3, qb = c & 7, b = bh >> 2, h = bh & 3;
        u.job = bh; u.pm = qb; u.pn = 0; u.a = Q + (((size_t)b * SEQ + qb * 256) * D + h * HD) * 2; u.b = KB + ((size_t)b * NMEM * D + h * HD) * 2; u.s = u.a; u.srow = -1; return true;
    }
};
struct SchedPVown {
    int c; const char* PR; const char* VT;
    __device__ __forceinline__ bool next(int i, Unit& u) const {
        if (i > 1 || c >= 128) return false;
        const int bh = c >> 3, qb = c & 7, pn = i, b = bh >> 2, h = bh & 3;
        u.job = 0; u.pm = b * 8 + qb; u.pn = h * 2 + pn;
        u.a = PR + ((size_t)bh * SEQ + qb * 256) * 256 * 2; u.b = VT + (((size_t)h * HD + pn * 256) * 1024 + b * 256) * 2; u.s = u.a; u.srow = -1; return true;
    }
};
struct SchedPV {
    int G, c; const char* PR; const char* VT;
    __device__ __forceinline__ bool next(int i, Unit& u) const {
        const int L = i * G + c; if (L >= 256) return false;
        const int bh = L >> 4, rem = L & 15, qb = rem >> 1, pn = rem & 1, b = bh >> 2, h = bh & 3;
        u.job = 0; u.pm = b * 8 + qb; u.pn = h * 2 + pn;
        u.a = PR + ((size_t)bh * SEQ + qb * 256) * 256 * 2; u.b = VT + (((size_t)h * HD + pn * 256) * 1024 + b * 256) * 2; u.s = u.a; u.srow = -1; return true;
    }
};


#define XB_TMO      128
#define XB_XCNT(j)  (256  + 64 * (j))
#define XB_XSUB(j)  (1280 + 64 * (j))
#define XB_XGEN(j)  (2304 + 64 * (j))
#define XB_TOP      3328
#define XB_TOPGEN   3392
#define XCD_BAR_WORDS 3456
#define XB_SPIN_CAP (1u << 18)
__device__ __forceinline__ unsigned xb_ld(unsigned* p)              { return __hip_atomic_load(p, __ATOMIC_RELAXED, __HIP_MEMORY_SCOPE_AGENT); }
__device__ __forceinline__ unsigned xb_add(unsigned* p, unsigned v) { return __hip_atomic_fetch_add(p, v, __ATOMIC_RELAXED, __HIP_MEMORY_SCOPE_AGENT); }
__device__ __forceinline__ unsigned xb_xcc_id() { return (unsigned)__builtin_amdgcn_s_getreg((3 << 11) | 20) & 0xFu; }
#define XB_SPIN(cond, bar) do { unsigned _sp = 0; while (cond) { __builtin_amdgcn_s_sleep(1); \
    if ((++_sp & 255u) == 0u) { if (xb_ld(&(bar)[XB_TMO])) break; if (_sp > XB_SPIN_CAP) { atomicAdd(&(bar)[XB_TMO], 1u); break; } } } } while (0)
struct XcdBarrier { unsigned* bar; unsigned x; volatile LAS unsigned* st; };
__device__ __forceinline__ XcdBarrier xcd_barrier_post(unsigned* bar, volatile LAS unsigned* st) {
    XcdBarrier b; b.bar = bar; b.x = xb_xcc_id(); b.st = st;
    if (threadIdx.x == 0) (void)xb_add(&bar[XB_XCNT(b.x)], 1u);
    return b;
}
__device__ __forceinline__ void xcd_barrier_complete(unsigned* bar, unsigned x, unsigned& nloc, unsigned& nx) {
    const unsigned G = gridDim.x * gridDim.y * gridDim.z;
    unsigned sum, cnt, mine, sp = 0u;
    for (;;) {
        sum = 0u; cnt = 0u; mine = 0u;
#pragma unroll
        for (unsigned j = 0; j < 16; ++j) { const unsigned c = xb_ld(&bar[XB_XCNT(j)]); sum += c; cnt += (c > 0u) ? 1u : 0u; mine = (j == x) ? c : mine; }
        if (sum == G) break;
        __builtin_amdgcn_s_sleep(1);
        if ((++sp & 255u) == 0u) { if (xb_ld(&bar[XB_TMO])) break; if (sp > XB_SPIN_CAP) { atomicAdd(&bar[XB_TMO], 1u); break; } }
    }
    nloc = mine > 0u ? mine : 1u; nx = cnt > 0u ? cnt : 1u;
}
__device__ __forceinline__ void xcd_barrier(const XcdBarrier& b, const int wv) {
    asm volatile("s_waitcnt vmcnt(0)" ::: "memory");
    __syncthreads();
    if (opaque_tid(wv) == 0) {
        unsigned* bar = b.bar;
        __builtin_amdgcn_s_waitcnt(0);
        unsigned nloc = b.st[0], nx = b.st[1];
        if (nloc == 0u) { xcd_barrier_complete(bar, b.x, nloc, nx); b.st[0] = nloc; b.st[1] = nx; }
        const unsigned old = xb_add(&bar[XB_XSUB(b.x)], 1u);
        const unsigned gen = old / nloc;
        if (old + 1u == (gen + 1u) * nloc) {
            __builtin_amdgcn_fence(__ATOMIC_RELEASE, "agent");
            asm volatile("s_waitcnt vmcnt(0)" ::: "memory");
            __builtin_amdgcn_fence(__ATOMIC_RELEASE, "agent");
            asm volatile("s_waitcnt vmcnt(0)" ::: "memory");
            const unsigned og = xb_add(&bar[XB_TOP], 1u);
            const unsigned tg = og / nx;
            if (og + 1u == (tg + 1u) * nx) xb_add(&bar[XB_TOPGEN], 1u);
            else XB_SPIN(xb_ld(&bar[XB_TOPGEN]) == tg, bar);
            __builtin_amdgcn_fence(__ATOMIC_ACQUIRE, "agent");
            xb_add(&bar[XB_XGEN(b.x)], 1u);
            asm volatile("s_waitcnt vmcnt(0)" ::: "memory");
        } else {
            XB_SPIN(xb_ld(&bar[XB_XGEN(b.x)]) == gen, bar);
            __builtin_amdgcn_fence(__ATOMIC_ACQUIRE, "agent");
            asm volatile("s_waitcnt vmcnt(0)" ::: "memory");
        }
    }
    __syncthreads();
}

#ifndef REP_PHASE
#define REP_PHASE -1
#endif
#define REPEAT(k) for (int rep_ = 0; rep_ < ((REP_PHASE == (k)) ? 2 : 1); ++rep_)
__global__ void __launch_bounds__(512, 2) hymba_fwd(Args A) {
    extern __shared__ __attribute__((aligned(16))) unsigned char lds_raw[];
    LAS unsigned char* lds = (LAS unsigned char*)lds_raw;
    cg::grid_group grid = cg::this_grid();
    const int G = gridDim.x, c = blockIdx.x, wv = __builtin_amdgcn_readfirstlane((int)threadIdx.x >> 6);
    unsigned char* ws = A.ws;
    float* SS1 = (float*)(ws + O_SS1); float* SS2 = (float*)(ws + O_SS2); float* SS3 = (float*)(ws + O_SS3); float* SSD = (float*)(ws + O_BAR + 16384);
    volatile LAS unsigned* bst = (volatile LAS unsigned*)(lds + RING_BYTES + 8192);
    if (threadIdx.x < 4) bst[threadIdx.x] = 0u;
    __syncthreads();
    const XcdBarrier xbar = xcd_barrier_post((unsigned*)(ws + O_BAR), bst);
#define SEAM() xcd_barrier(xbar, wv)

    REPEAT(0) {
    {
        convert_weights(A, lds, 0, NEARLY, c * 8 + wv, G * 8, wv);
        phase0_rest(A, G, wv);
    }
    if (A.ws == nullptr) grid.sync();
    SEAM();
    }
    REPEAT(1) {
    {
        Sched1 S{G, c, (const char*)(ws + O_HMIX), (const char*)(ws + O_WIN), (const char*)(ws + O_MN), (const char*)(ws + O_WKV)};
        pg8::EpiInKv E{(bf16_t*)(ws + O_P), A.out, (bf16_t*)(ws + O_KB), (bf16_t*)(ws + O_VT)};
        pg8::gemm_phase<pg8::EpiInKv, Sched1, true, true>(lds, pg8::Dims{D, D, D}, S, E, wv);
        __syncthreads();
        const int skip = (G > 128) ? 64 : 0;
        convert_weights(A, lds, NEARLY, NITEMS, (c >= skip) ? (c - skip) * 8 + wv : -1, (G - skip) * 8, wv);
    }
    SEAM();
    }
    REPEAT(2) {
    ssm_phase(A, lds, G, wv);
    pooled_phase(A, G, wv);
    SEAM();
    }
    REPEAT(3) {
    {
        SchedPool S{G, c, (const char*)(ws + O_POOLED), (const char*)(ws + O_WPOOL)};
        pg8::EpiPool E{(bf16_t*)(ws + O_MIX), A.in[I_PSCALE]};
        pg8::gemm_phase<pg8::EpiPool, SchedPool, true, true>(lds, pg8::Dims{1024, 256, 256}, S, E, wv);
        SchedGrid S2{G, G - 1 - c, MTP, 4, (const char*)(ws + O_G), (const char*)(ws + O_WGLU), (size_t)256 * 1024 * 2, (size_t)256 * 1024 * 2, (const char*)(ws + O_G) + (size_t)MP * 1024 * 2, (size_t)16 * 1024 * 2};
        pg8::EpiGlu E2{(bf16_t*)(ws + O_MIX), (const bf16_t*)(ws + O_G), A.in[I_BGLU]};
        pg8::gemm_phase<pg8::EpiGlu, SchedGrid, true, true>(lds, pg8::Dims{1024, 1024, 1024}, S2, E2, wv);
    }
    SEAM();
    }
    REPEAT(4) {
    {
        SchedGrid S{G, c, MTP, 8, (const char*)(ws + O_MIX), (const char*)(ws + O_WOUT), (size_t)256 * D * 2, (size_t)256 * D * 2, (const char*)(ws + O_MIX) + (size_t)MP * D * 2, (size_t)16 * D * 2};
        pg8::EpiRes<float> E{A.in[I_XP], A.in[I_XS], nullptr, (bf16_t*)(ws + O_XB), rep_ ? SSD : SS1};
        pg8::gemm_phase<pg8::EpiRes<float>, SchedGrid, true, true>(lds, pg8::Dims{D, D, D}, S, E, wv);
    }
    SEAM();
    }
    REPEAT(5) {
    {
        SchedGrid S{G, c, MTP, 8, (const char*)(ws + O_XB), (const char*)(ws + O_WQ), (size_t)256 * D * 2, (size_t)256 * D * 2, (const char*)(ws + O_XB) + (size_t)MP * D * 2, (size_t)16 * D * 2};
        pg8::EpiQ E{(bf16_t*)(ws + O_Q), SS1};
        pg8::gemm_phase<pg8::EpiQ, SchedGrid, true, true>(lds, pg8::Dims{D, D, D}, S, E, wv);
    }
    SEAM();
    }
    REPEAT(6) {
    {
        if (G == 256) {
            if (c < 128) {
                { SchedScores S{c, (const char*)(ws + O_Q), (const char*)(ws + O_KB)};
                  pg8::EpiSoftmax E{(bf16_t*)(ws + O_PR)};
                  pg8::gemm_phase<pg8::EpiSoftmax, SchedScores, false, false>(lds, pg8::Dims{D, D, HD}, S, E, wv); }
                asm volatile("s_waitcnt vmcnt(0)" ::: "memory"); __syncthreads();
                { SchedPVown S{c, (const char*)(ws + O_PR), (const char*)(ws + O_VT)};
                  pg8::EpiPV E{(bf16_t*)(ws + O_ATT)};
                  pg8::gemm_phase<pg8::EpiPV, SchedPVown, true, false>(lds, pg8::Dims{256, 1024, 256}, S, E, wv); }
                __syncthreads();
                sample_attn_units<8>(A, lds, c, wv);
            } else {
                sample_attn_units<4>(A, lds, 128 + 2 * (c - 128), wv);
                sample_attn_units<8>(A, lds, 384 + (c - 128), wv);
            }
        } else {
            for (int base = 0; base < 128; base += G) {
                SchedScores S{c + base, (const char*)(ws + O_Q), (const char*)(ws + O_KB)};
                pg8::EpiSoftmax E{(bf16_t*)(ws + O_PR)};
                pg8::gemm_phase<pg8::EpiSoftmax, SchedScores, false, false>(lds, pg8::Dims{D, D, HD}, S, E, wv);
            }
            __syncthreads();
            for (int du = c; du < 256; du += G) sample_attn_units<4>(A, lds, 2 * du, wv);
        }
    }
    SEAM();
    }
    if (G != 256) {
        SchedPV S{G, c, (const char*)(ws + O_PR), (const char*)(ws + O_VT)};
        pg8::EpiPV E{(bf16_t*)(ws + O_ATT)};
        pg8::gemm_phase<pg8::EpiPV, SchedPV, true, false>(lds, pg8::Dims{256, 1024, 256}, S, E, wv);
        SEAM();
    }
    REPEAT(8) {
    {
        SchedGrid S{G, c, MTP, 8, (const char*)(ws + O_ATT), (const char*)(ws + O_WO), (size_t)256 * D * 2, (size_t)256 * D * 2, (const char*)(ws + O_ATT) + (size_t)MP * D * 2, (size_t)16 * D * 2};
        pg8::EpiRes<bf16_t> E{(const bf16_t*)(ws + O_XB), (const bf16_t*)(ws + O_XB) + (size_t)MP * D, nullptr, (bf16_t*)(ws + O_XB), SS2};
        pg8::gemm_phase<pg8::EpiRes<bf16_t>, SchedGrid, true, true>(lds, pg8::Dims{D, D, D}, S, E, wv);
    }
    SEAM();
    }
    REPEAT(9) {
    {
        SchedGrid S{G, c, MTP, 44, (const char*)(ws + O_XB), (const char*)(ws + O_WGU), (size_t)256 * D * 2, (size_t)256 * D * 2, (const char*)(ws + O_XB) + (size_t)MP * D * 2, (size_t)16 * D * 2};
        pg8::EpiGateUp E{(bf16_t*)(ws + O_H), SS2};
        pg8::gemm_phase<pg8::EpiGateUp, SchedGrid, true, true>(lds, pg8::Dims{D, D, D}, S, E, wv);
    }
    SEAM();
    }
    if (G == 256) {
        SchedGrid S{G, c, MTP, 8, (const char*)(ws + O_H), (const char*)(ws + O_WDN), (size_t)256 * FF * 2, (size_t)256 * FF * 2, (const char*)(ws + O_H) + (size_t)MP * FF * 2, (size_t)16 * FF * 2};
        pg8::EpiFinal E{(const bf16_t*)(ws + O_XB), A.out + OUT_Y, SS3, (unsigned*)(ws + O_PCNT), A.in[I_GFINAL]};
        pg8::gemm_phase<pg8::EpiFinal, SchedGrid, false, true>(lds, pg8::Dims{FF, FF, FF}, S, E, wv);
    } else {
        {
            SchedGrid S{G, c, MTP, 8, (const char*)(ws + O_H), (const char*)(ws + O_WDN), (size_t)256 * FF * 2, (size_t)256 * FF * 2, (const char*)(ws + O_H) + (size_t)MP * FF * 2, (size_t)16 * FF * 2};
            pg8::EpiRes<bf16_t> E{(const bf16_t*)(ws + O_XB), (const bf16_t*)(ws + O_XB) + (size_t)MP * D, A.out + OUT_Y, nullptr, SS3};
            pg8::gemm_phase<pg8::EpiRes<bf16_t>, SchedGrid, true, true>(lds, pg8::Dims{FF, FF, FF}, S, E, wv);
        }
        SEAM();
        const float* gf = A.in[I_GFINAL]; const int tid = opaque_tid(wv), lane = tid & 63, wave = wv;
        for (int m = c * 8 + wave; m < M; m += G * 8) {
            const float rs = rsqrtf(SS3[m] * (1.0f / D) + EPS);
            f32x4* row = (f32x4*)(A.out + OUT_Y + (size_t)m * D) + lane; const f32x4* gr = (const f32x4*)gf + lane;
#pragma unroll
            for (int jj = 0; jj < 8; ++jj) row[64 * jj] = row[64 * jj] * rs * gr[64 * jj];
        }
    }
}

extern "C" void kernel_launch(void* const* d_in, const int* in_sizes, int n_in, void* d_out, int out_size, void* d_ws, size_t ws_size, hipStream_t stream) {
    static int grid = 0;
    if (grid == 0) {
        if (n_in != 34 || ws_size < WS_END) { fprintf(stderr, "kernel_launch: unexpected inputs (n_in %d, ws %zu, need %zu)\n", n_in, ws_size, (size_t)WS_END); grid = -1; return; }
        int dev = 0, cus = 0, per_cu = 0;
        hipGetDevice(&dev);
        hipDeviceGetAttribute(&cus, hipDeviceAttributeMultiprocessorCount, dev);
        if (hipFuncSetAttribute((const void*)hymba_fwd, hipFuncAttributeMaxDynamicSharedMemorySize, LDS_BYTES) != hipSuccess) { fprintf(stderr, "kernel_launch: hipFuncSetAttribute failed\n"); grid = -1; return; }
        if (hipOccupancyMaxActiveBlocksPerMultiprocessor(&per_cu, (const void*)hymba_fwd, 512, LDS_BYTES) != hipSuccess || per_cu < 1) { fprintf(stderr, "kernel_launch: occupancy query failed (%d)\n", per_cu); per_cu = 1; }
        (void)hipGetLastError();
        grid = cus * per_cu;
    }
    if (grid < 0) return;
    hipMemsetAsync(d_ws, 0, CTL_BYTES, stream);
    Args a{};
    for (int i = 0; i < 34; ++i) a.in[i] = (const float*)d_in[i];
    a.out = (float*)d_out; a.ws = (unsigned char*)d_ws;
    void* args[] = {&a};
    hipError_t e = hipLaunchCooperativeKernel((const void*)hymba_fwd, dim3(grid), dim3(512), args, LDS_BYTES, stream);
    if (e != hipSuccess) fprintf(stderr, "cooperative launch failed: %s (grid %d)\n", hipGetErrorString(e), grid);
}
```

```cpp
#include <hip/hip_runtime.h>
#include <hip/hip_cooperative_groups.h>
#include <cstdio>
#include <cstdint>
namespace cg = cooperative_groups;

#define LAS __attribute__((address_space(3)))
typedef unsigned short bf16_t;
typedef short bf16x8 __attribute__((ext_vector_type(8)));
typedef float f32x4 __attribute__((ext_vector_type(4)));
typedef float f32x16 __attribute__((ext_vector_type(16)));
typedef unsigned u32x4 __attribute__((ext_vector_type(4)));
typedef unsigned u32x2 __attribute__((ext_vector_type(2)));

constexpr int D = 2048, SEQ = 2048, NB = 4, MP = NB * SEQ, DB = 128, DS = 4, MS = DB * DS, M = MP + MS;
constexpr int PW = 1024, NG = 64, NMEM = 256, NH = 4, HD = 512, FF = 5632, PBUF = 15;
constexpr float EPS = 1e-6f;

constexpr size_t OUT_Y = 0;
constexpr size_t OUT_PBP = (size_t)M * D;
constexpr size_t OUT_REP = OUT_PBP + (size_t)NB * PBUF * PW;
constexpr size_t OUT_IMP = OUT_REP + (size_t)NB * NG * 64;
constexpr size_t OUT_MK = OUT_IMP + (size_t)NB * NG * 64;
constexpr size_t OUT_MV = OUT_MK + (size_t)NB * NMEM * D;
constexpr size_t OUT_PBS = OUT_MV + (size_t)NB * NMEM * D;
constexpr size_t OUT_RES = OUT_PBS + (size_t)DB * PBUF * PW;
constexpr size_t OUT_IMS = OUT_RES + (size_t)DB * NG * 64;

constexpr size_t CTL_BYTES = 256 * 1024;
constexpr size_t O_SS1 = 0, O_SS2 = 64 * 1024, O_SS3 = 128 * 1024, O_BAR = 192 * 1024, O_PCNT = 248 * 1024;
constexpr size_t O_WIN = 1 << 20;
constexpr size_t O_WKV = O_WIN + (size_t)D * D * 2;
constexpr size_t O_WPOOL = O_WKV + (size_t)2 * D * D * 2;
constexpr size_t O_WGLU = O_WPOOL + (size_t)4 * 256 * 256 * 2;
constexpr size_t O_WOUT = O_WGLU + (size_t)1024 * 1024 * 2;
constexpr size_t O_WQ = O_WOUT + (size_t)D * D * 2;
constexpr size_t O_WO = O_WQ + (size_t)D * D * 2;
constexpr size_t O_WGU = O_WO + (size_t)D * D * 2;
constexpr size_t O_WDN = O_WGU + (size_t)2 * FF * D * 2;
constexpr size_t O_TAB = O_WDN + (size_t)D * FF * 2;
constexpr size_t O_ABAR = O_TAB, O_BB = O_ABAR + 64 * 64 * 16, O_CM = O_BB + 64 * 4096;
constexpr size_t O_HMIX = O_CM + 64 * 4096;
constexpr size_t O_MN = O_HMIX + (size_t)M * D * 2;
constexpr size_t O_P = O_MN + (size_t)1024 * D * 2;
constexpr size_t O_POOLED = O_P + (size_t)M * D * 2;
constexpr size_t O_G = O_POOLED + (size_t)M * 1024 * 2;
constexpr size_t O_MIX = O_G + (size_t)M * 1024 * 2;
constexpr size_t O_X1 = O_MIX + (size_t)M * D * 2;
constexpr size_t O_XB = O_X1 + (size_t)M * D * 4;
constexpr size_t O_Q = O_XB + (size_t)M * D * 2;
constexpr size_t O_KB = O_Q + (size_t)M * D * 2;
constexpr size_t O_VT = O_KB + (size_t)1024 * D * 2;
constexpr size_t O_PR = O_VT + (size_t)D * 1024 * 2;
constexpr size_t O_ATT = O_PR + (size_t)16 * 2048 * 256 * 2;
constexpr size_t O_H = O_ATT + (size_t)M * D * 2;
constexpr size_t WS_END = O_H + (size_t)M * FF * 2;

constexpr int RING_BYTES = 131072, LDS_BYTES = 147456;

__device__ __forceinline__ unsigned cvt_pk_bf16(float lo, float hi) { unsigned r; asm volatile("v_cvt_pk_bf16_f32 %0, %1, %2" : "=v"(r) : "v"(lo), "v"(hi)); return r; }
__device__ __forceinline__ float bf_lo(unsigned w) { return __uint_as_float(w << 16); }
__device__ __forceinline__ float bf_hi(unsigned w) { return __uint_as_float(w & 0xffff0000u); }
__device__ __forceinline__ float wave_sum(float v) {
#pragma unroll
    for (int o = 1; o < 64; o <<= 1) v += __shfl_xor(v, o);
    return v;
}
__device__ __forceinline__ float wave_max(float v) {
#pragma unroll
    for (int o = 1; o < 64; o <<= 1) v = fmaxf(v, __shfl_xor(v, o));
    return v;
}
__device__ __forceinline__ float fast_sigmoid(float x) { return __builtin_amdgcn_rcpf(1.0f + __expf(-x)); }
__device__ __forceinline__ float gelu_tanh(float y) { const float t = 1.5957691216f * (y + 0.044715f * y * y * y); return y * fast_sigmoid(t); }
#define LDS_WAIT() asm volatile("s_waitcnt lgkmcnt(0)" ::: "memory")
__device__ __forceinline__ int opaque_tid(int wv) { int t; asm volatile("v_mbcnt_lo_u32_b32 %0, -1, 0\n\tv_mbcnt_hi_u32_b32 %0, -1, %0\n\tv_lshl_add_u32 %0, %1, 6, %0" : "=&v"(t) : "s"(wv)); return t; }

namespace pg8 {
constexpr int BM = 256, BK = 64, HALF = 128, HTB = HALF * BK * 2;
__device__ __forceinline__ int lds_byte(int r, int c) { const int st = (r >> 4) * 2 + (c >> 5), rr = r & 15, cc = c & 31, ob = rr * 64 + cc * 2; return st * 1024 + (ob ^ (((ob >> 9) & 1) << 5)); }
__device__ __forceinline__ void stage_rc(int b, int& R, int& C) { const int st = b / 1024, sb = b % 1024, swz = sb ^ (((sb >> 9) & 1) << 5); R = (st >> 1) * 16 + swz / 64; C = (st & 1) * 32 + (swz % 64) / 2; }
__device__ __forceinline__ int perm32(int rho) { const int n = rho >> 4, i = rho & 15; return 8 * (i >> 2) + 4 * n + (i & 3); }

struct Unit { const char* a; const char* b; const char* s; int pm, pn, job, srow; };
struct Dims { int lda, ldb, K; };

constexpr int SBUF_OFF = 131072;
template <class Epi, class Sched, bool ALIGN_EPI, bool STRIP>
__device__ __forceinline__ void gemm_phase(LAS unsigned char* lds, const Dims g, const Sched& S, const Epi& E, const int wv) {
    const int tid = opaque_tid(wv), wid = __builtin_amdgcn_readfirstlane(tid >> 6), lane = tid & 63, wr = wid >> 2, wc = wid & 3, fr = lane & 15, fq = lane >> 4;
    int nt = g.K / BK; asm volatile("" : "+s"(nt));
    unsigned voffA[2], voffB[2];
#pragma unroll
    for (int i = 0; i < 2; ++i) { int R, C; stage_rc(tid * 16 + i * 8192, R, C); const int Rb = (R & ~31) + perm32(R & 31);
        voffA[i] = (unsigned)(R * g.lda + C) * 2u; voffB[i] = (unsigned)(Rb * g.ldb + C) * 2u; }
    const unsigned voffS = (unsigned)((2 * wid + (lane >> 5)) * g.lda * 2 + (((((lane & 31) >> 2) ^ wid) & 7) * 16) + (lane & 3) * 4);
    const int soff = fr * 128 + ((fq ^ ((fr >> 1) & 7)) * 16);
    const size_t kstep = (size_t)(BK * 2);
    const size_t hstepA = (size_t)HALF * g.lda * 2, hstepB = (size_t)HALF * g.ldb * 2;
    const unsigned ldsw = (unsigned)wid * 1024u;
    const int aoff = lds_byte(wr * 64 + fr, fq * 8), boff = lds_byte(wc * 32 + fr, fq * 8);
#define PG8_SA(b, h) (((b) * 2 + (h)) * HTB)
#define PG8_SB(b, h) ((4 + (b) * 2 + (h)) * HTB)
#define PG8_STAGE(bufoff, gbase, voff) do { _Pragma("unroll") for (int _i = 0; _i < 2; ++_i) \
        __builtin_amdgcn_global_load_lds((const unsigned*)((const char*)(gbase) + (voff)[_i]), (LAS unsigned*)(lds + (bufoff) + ldsw + _i * 8192), 16, 0, 0); } while (0)
#define PG8_STAGE_S(b, gbase) do { if constexpr (STRIP) __builtin_amdgcn_global_load_lds((const unsigned*)((const char*)(gbase) + voffS), (LAS unsigned*)(lds + SBUF_OFF + (b) * 2048 + wid * 256), 4, 0, 0); } while (0)
#define PG8_LDS_S(b) do { if constexpr (STRIP) { As[0] = *(const LAS bf16x8*)(lds + SBUF_OFF + (b) * 2048 + soff); As[1] = *(const LAS bf16x8*)(lds + SBUF_OFF + (b) * 2048 + (soff ^ 64)); } } while (0)
#define PG8_LDA(dst, b, h) do { _Pragma("unroll") for (int m = 0; m < 4; ++m) _Pragma("unroll") for (int k = 0; k < 2; ++k) dst[m][k] = *(const LAS bf16x8*)(lds + PG8_SA(b, h) + aoff + m * 2048 + k * 1024); } while (0)
#define PG8_LDB(dst, b, h) do { _Pragma("unroll") for (int n = 0; n < 2; ++n) _Pragma("unroll") for (int k = 0; k < 2; ++k) dst[n][k] = *(const LAS bf16x8*)(lds + PG8_SB(b, h) + boff + n * 2048 + k * 1024); } while (0)
#define PG8_MMA(ai, bj, At, Bt) do { __builtin_amdgcn_s_setprio(1); _Pragma("unroll") for (int m = 0; m < 4; ++m) _Pragma("unroll") for (int n = 0; n < 2; ++n) _Pragma("unroll") for (int k = 0; k < 2; ++k) \
        acc[ai][bj][m][n] = __builtin_amdgcn_mfma_f32_16x16x32_bf16(Bt[n][k], At[m][k], acc[ai][bj][m][n], 0, 0, 0); __builtin_amdgcn_s_setprio(0); } while (0)
#define PG8_MMA_S() do { if constexpr (STRIP) { __builtin_amdgcn_s_setprio(1); \
        if (wr == 0) { _Pragma("unroll") for (int k = 0; k < 2; ++k) { sacc[0] = __builtin_amdgcn_mfma_f32_16x16x32_bf16(B0[0][k], As[k], sacc[0], 0, 0, 0); sacc[1] = __builtin_amdgcn_mfma_f32_16x16x32_bf16(B1[0][k], As[k], sacc[1], 0, 0, 0); } } \
        else         { _Pragma("unroll") for (int k = 0; k < 2; ++k) { sacc[0] = __builtin_amdgcn_mfma_f32_16x16x32_bf16(B0[1][k], As[k], sacc[0], 0, 0, 0); sacc[1] = __builtin_amdgcn_mfma_f32_16x16x32_bf16(B1[1][k], As[k], sacc[1], 0, 0, 0); } } \
        __builtin_amdgcn_s_setprio(0); } } while (0)
#define PG8_WAIT_V(n) asm volatile("s_waitcnt vmcnt(" #n ")" ::: "memory")
#define PG8_WAIT_VL() do { if constexpr (STRIP) PG8_WAIT_V(9); else PG8_WAIT_V(8); } while (0)
#define PG8_WAIT_L(n) asm volatile("s_waitcnt lgkmcnt(" #n ")" ::: "memory")
#define PG8_BAR __builtin_amdgcn_s_barrier()
#define PG8_SCHED __builtin_amdgcn_sched_barrier(0)
    Unit cur, nxt; int ui = 0;
    if (!S.next(0, cur)) return;
    f32x4 acc[2][2][4][2];
#pragma unroll
    for (int a = 0; a < 2; ++a)
#pragma unroll
        for (int b = 0; b < 2; ++b)
#pragma unroll
            for (int m = 0; m < 4; ++m)
#pragma unroll
                for (int n = 0; n < 2; ++n) acc[a][b][m][n] = (f32x4){0.f, 0.f, 0.f, 0.f};
    f32x4 sacc[2]; sacc[0] = (f32x4){0.f, 0.f, 0.f, 0.f}; sacc[1] = (f32x4){0.f, 0.f, 0.f, 0.f};
    bf16x8 At[4][2], B0[2][2], B1[2][2], As[2];
    const char* cA = cur.a; const char* cB = cur.b; const char* cS = cur.s;
    PG8_STAGE(PG8_SB(0, 0), cB, voffB); PG8_STAGE(PG8_SB(0, 1), cB + hstepB, voffB); PG8_STAGE(PG8_SA(0, 0), cA, voffA); PG8_STAGE_S(0, cS); PG8_STAGE(PG8_SA(0, 1), cA + hstepA, voffA);
    if (wr == 1) PG8_BAR;
    PG8_WAIT_V(2); PG8_BAR;
    PG8_STAGE(PG8_SB(1, 0), cB + kstep, voffB); PG8_STAGE(PG8_SA(1, 0), cA + kstep, voffA); PG8_STAGE(PG8_SB(1, 1), cB + hstepB + kstep, voffB); PG8_STAGE_S(1, cS + kstep);
    if constexpr (STRIP) PG8_WAIT_V(7); else PG8_WAIT_V(6);
    PG8_BAR;
    for (;;) {
        const bool has_next = S.next(ui + 1, nxt);
        const char* nA = has_next ? nxt.a : cA; const char* nB = has_next ? nxt.b : cB; const char* nS = has_next ? nxt.s : cS;
        for (int t = 0; t < nt; t += 2) {
            const bool last = (t == nt - 2);
            const char* a1 = cA + (size_t)(t + 1) * kstep;
            const char* a2 = last ? nA : cA + (size_t)(t + 2) * kstep; const char* b2 = last ? nB : cB + (size_t)(t + 2) * kstep; const char* s2 = last ? nS : cS + (size_t)(t + 2) * kstep;
            const char* a3 = a2 + kstep; const char* b3 = b2 + kstep; const char* s3 = s2 + kstep;
            PG8_LDB(B0, 0, 0); PG8_LDB(B1, 0, 1); PG8_SCHED; PG8_LDA(At, 0, 0); PG8_LDS_S(0); PG8_STAGE(PG8_SA(1, 1), a1 + hstepA, voffA);
            PG8_WAIT_VL(); PG8_WAIT_L(0); PG8_BAR; PG8_MMA(0, 0, At, B0); PG8_MMA(0, 1, At, B1); PG8_MMA_S(); PG8_BAR; PG8_SCHED;
            PG8_LDA(At, 0, 1); PG8_STAGE(PG8_SB(0, 0), b2, voffB); PG8_STAGE(PG8_SB(0, 1), b2 + hstepB, voffB); PG8_STAGE(PG8_SA(0, 0), a2, voffA); PG8_STAGE_S(0, s2);
            PG8_WAIT_VL(); PG8_WAIT_L(0); PG8_BAR; PG8_MMA(1, 0, At, B0); PG8_MMA(1, 1, At, B1); PG8_BAR; PG8_SCHED;
            PG8_LDB(B0, 1, 0); PG8_LDB(B1, 1, 1); PG8_SCHED; PG8_LDA(At, 1, 0); PG8_LDS_S(1); PG8_STAGE(PG8_SA(0, 1), a2 + hstepA, voffA);
            PG8_WAIT_VL(); PG8_WAIT_L(0); PG8_BAR; PG8_MMA(0, 0, At, B0); PG8_MMA(0, 1, At, B1); PG8_MMA_S(); PG8_BAR; PG8_SCHED;
            PG8_LDA(At, 1, 1); PG8_STAGE(PG8_SB(1, 0), b3, voffB); PG8_STAGE(PG8_SB(1, 1), b3 + hstepB, voffB); PG8_STAGE(PG8_SA(1, 0), a3, voffA); PG8_STAGE_S(1, s3);
            PG8_WAIT_VL(); PG8_WAIT_L(0); PG8_BAR; PG8_MMA(1, 0, At, B0); PG8_MMA(1, 1, At, B1); PG8_BAR; PG8_SCHED;
        }
        if constexpr (ALIGN_EPI) { if (wr == 0) PG8_BAR; }
        if constexpr (!Epi::AFTER_DRAIN) { E(acc, cur, wr, wc, fr, fq); if constexpr (STRIP) { if (cur.srow >= 0) E.strip(sacc, cur, wr, wc, fr, fq); } }
        if (!has_next) break;
#pragma unroll
        for (int a = 0; a < 2; ++a)
#pragma unroll
            for (int b = 0; b < 2; ++b)
#pragma unroll
                for (int m = 0; m < 4; ++m)
#pragma unroll
                    for (int n = 0; n < 2; ++n) acc[a][b][m][n] = (f32x4){0.f, 0.f, 0.f, 0.f};
        sacc[0] = (f32x4){0.f, 0.f, 0.f, 0.f}; sacc[1] = (f32x4){0.f, 0.f, 0.f, 0.f};
        cur = nxt; cA = nA; cB = nB; cS = nS; ++ui;
        if constexpr (ALIGN_EPI) { if (wr == 1) PG8_BAR; }
    }
    PG8_WAIT_V(0);
    if constexpr (!ALIGN_EPI) { if (wr == 0) PG8_BAR; }
    PG8_BAR;
    if constexpr (Epi::AFTER_DRAIN) { E.fused(acc, sacc, cur, wr, wc, fr, fq, lds, wid, lane); }
#undef PG8_SA
#undef PG8_SB
#undef PG8_STAGE
#undef PG8_STAGE_S
#undef PG8_LDS_S
#undef PG8_LDA
#undef PG8_LDB
#undef PG8_MMA
#undef PG8_MMA_S
#undef PG8_WAIT_V
#undef PG8_WAIT_VL
#undef PG8_WAIT_L
#undef PG8_BAR
#undef PG8_SCHED
}
typedef f32x4 Acc[2][2][4][2];

__device__ __forceinline__ void st_bf16x8(bf16_t* p, f32x4 v0, f32x4 v1) {
    u32x4 w; w.x = cvt_pk_bf16(v0[0], v0[1]); w.y = cvt_pk_bf16(v0[2], v0[3]); w.z = cvt_pk_bf16(v1[0], v1[1]); w.w = cvt_pk_bf16(v1[2], v1[3]); *(u32x4*)p = w;
}
__device__ __forceinline__ void st_bf16x4(bf16_t* p, f32x4 v) { u32x2 w; w.x = cvt_pk_bf16(v[0], v[1]); w.y = cvt_pk_bf16(v[2], v[3]); *(u32x2*)p = w; }
typedef f32x4 SAcc[2];
struct EpiInKv {
    static constexpr bool AFTER_DRAIN = false;
    bf16_t* P; float* out; bf16_t* KB; bf16_t* VT;
    __device__ __forceinline__ void operator()(const Acc& acc, const Unit& u, int wr, int wc, int fr, int fq) const {
        if (u.job == 0) {
#pragma unroll
            for (int ai = 0; ai < 2; ++ai)
#pragma unroll
                for (int m = 0; m < 4; ++m) {
                    const int row = u.pm * 256 + ai * 128 + wr * 64 + m * 16 + fr;
                    float* pbp = nullptr;
                    if (u.pn < 4) {
                        if (row < MP) { const int t = row & (SEQ - 1); if (t >= SEQ - PBUF) pbp = out + OUT_PBP + ((size_t)(row >> 11) * PBUF + (t - (SEQ - PBUF))) * PW; }
                        else { const int rs = row - MP; pbp = out + OUT_PBS + ((size_t)(rs >> 2) * PBUF + 11 + (rs & 3)) * PW; }
                    }
#pragma unroll
                    for (int bj = 0; bj < 2; ++bj) {
                        const int col = u.pn * 256 + bj * 128 + wc * 32 + 8 * fq;
                        const f32x4 v0 = acc[ai][bj][m][0], v1 = acc[ai][bj][m][1];
                        st_bf16x8(P + (size_t)row * D + col, v0, v1);
                        if (pbp) { *(f32x4*)(pbp + col) = v0; *(f32x4*)(pbp + col + 4) = v1; }
                    }
                }
        } else {
#pragma unroll
            for (int ai = 0; ai < 2; ++ai)
#pragma unroll
                for (int m = 0; m < 4; ++m) {
                    const int row = u.pm * 256 + ai * 128 + wr * 64 + m * 16 + fr;
#pragma unroll
                    for (int bj = 0; bj < 2; ++bj) {
                        const int col = u.pn * 256 + bj * 128 + wc * 32 + 8 * fq;
                        const f32x4 v0 = acc[ai][bj][m][0], v1 = acc[ai][bj][m][1];
                        if (col < D) {
                            float* o = out + OUT_MK + (size_t)row * D + col; *(f32x4*)o = v0; *(f32x4*)(o + 4) = v1;
                            st_bf16x8(KB + (size_t)row * D + col, v0, v1);
                        } else {
                            const int c = col - D;
                            float* o = out + OUT_MV + (size_t)row * D + c; *(f32x4*)o = v0; *(f32x4*)(o + 4) = v1;
#pragma unroll
                            for (int i = 0; i < 4; ++i) { VT[(size_t)(c + i) * 1024 + row] = (bf16_t)(cvt_pk_bf16(v0[i], 0.f) & 0xffffu); VT[(size_t)(c + 4 + i) * 1024 + row] = (bf16_t)(cvt_pk_bf16(v1[i], 0.f) & 0xffffu); }
                        }
                    }
                }
        }
    }
    __device__ __forceinline__ void strip(const SAcc& sacc, const Unit& u, int wr, int wc, int fr, int fq) const {
        const int row = u.srow + fr, rs = row - MP;
        float* pbp = (u.pn < 4) ? out + OUT_PBS + ((size_t)(rs >> 2) * PBUF + 11 + (rs & 3)) * PW : nullptr;
#pragma unroll
        for (int bj = 0; bj < 2; ++bj) {
            const int col = u.pn * 256 + bj * 128 + wc * 32 + 8 * fq + 4 * wr;
            st_bf16x4(P + (size_t)row * D + col, sacc[bj]);
            if (pbp) *(f32x4*)(pbp + col) = sacc[bj];
        }
    }
};
struct EpiPool {
    static constexpr bool AFTER_DRAIN = false;
    bf16_t* MIX; const float* scale;
    __device__ __forceinline__ void operator()(const Acc& acc, const Unit& u, int wr, int wc, int fr, int fq) const {
#pragma unroll
        for (int bj = 0; bj < 2; ++bj) {
            const int col = u.pn * 256 + bj * 128 + wc * 32 + 8 * fq;
            const f32x4 s0 = *(const f32x4*)(scale + col), s1 = *(const f32x4*)(scale + col + 4);
#pragma unroll
            for (int ai = 0; ai < 2; ++ai)
#pragma unroll
                for (int m = 0; m < 4; ++m) {
                    const int row = u.pm * 256 + ai * 128 + wr * 64 + m * 16 + fr;
                    st_bf16x8(MIX + (size_t)row * D + col, acc[ai][bj][m][0] * s0, acc[ai][bj][m][1] * s1);
                }
        }
    }
    __device__ __forceinline__ void strip(const SAcc& sacc, const Unit& u, int wr, int wc, int fr, int fq) const {
        const int row = u.srow + fr;
#pragma unroll
        for (int bj = 0; bj < 2; ++bj) {
            const int col = u.pn * 256 + bj * 128 + wc * 32 + 8 * fq + 4 * wr;
            st_bf16x4(MIX + (size_t)row * D + col, sacc[bj] * *(const f32x4*)(scale + col));
        }
    }
};
struct EpiGlu {
    static constexpr bool AFTER_DRAIN = false;
    bf16_t* MIX; const bf16_t* G; const float* bias;
    __device__ __forceinline__ void operator()(const Acc& acc, const Unit& u, int wr, int wc, int fr, int fq) const {
#pragma unroll
        for (int bj = 0; bj < 2; ++bj) {
            const int col = u.pn * 256 + bj * 128 + wc * 32 + 8 * fq;
            const f32x4 b0 = *(const f32x4*)(bias + col), b1 = *(const f32x4*)(bias + col + 4);
#pragma unroll
            for (int ai = 0; ai < 2; ++ai)
#pragma unroll
                for (int m = 0; m < 4; ++m) {
                    const int row = u.pm * 256 + ai * 128 + wr * 64 + m * 16 + fr;
                    const u32x4 gw = *(const u32x4*)(G + (size_t)row * 1024 + col);
                    const f32x4 x0 = acc[ai][bj][m][0] + b0, x1 = acc[ai][bj][m][1] + b1;
                    f32x4 o0, o1;
                    o0[0] = bf_lo(gw.x) * fast_sigmoid(x0[0]); o0[1] = bf_hi(gw.x) * fast_sigmoid(x0[1]); o0[2] = bf_lo(gw.y) * fast_sigmoid(x0[2]); o0[3] = bf_hi(gw.y) * fast_sigmoid(x0[3]);
                    o1[0] = bf_lo(gw.z) * fast_sigmoid(x1[0]); o1[1] = bf_hi(gw.z) * fast_sigmoid(x1[1]); o1[2] = bf_lo(gw.w) * fast_sigmoid(x1[2]); o1[3] = bf_hi(gw.w) * fast_sigmoid(x1[3]);
                    st_bf16x8(MIX + (size_t)row * D + 1024 + col, o0, o1);
                }
        }
    }
    __device__ __forceinline__ void strip(const SAcc& sacc, const Unit& u, int wr, int wc, int fr, int fq) const {
        const int row = u.srow + fr;
#pragma unroll
        for (int bj = 0; bj < 2; ++bj) {
            const int col = u.pn * 256 + bj * 128 + wc * 32 + 8 * fq + 4 * wr;
            const u32x2 gw = *(const u32x2*)(G + (size_t)row * 1024 + col);
            const f32x4 x = sacc[bj] + *(const f32x4*)(bias + col);
            f32x4 o; o[0] = bf_lo(gw.x) * fast_sigmoid(x[0]); o[1] = bf_hi(gw.x) * fast_sigmoid(x[1]); o[2] = bf_lo(gw.y) * fast_sigmoid(x[2]); o[3] = bf_hi(gw.y) * fast_sigmoid(x[3]);
            st_bf16x4(MIX + (size_t)row * D + 1024 + col, o);
        }
    }
};
__device__ __forceinline__ void ld_res8(const float* p, f32x4& a, f32x4& b) { a = *(const f32x4*)p; b = *(const f32x4*)(p + 4); }
__device__ __forceinline__ void ld_res8(const bf16_t* p, f32x4& a, f32x4& b) { const u32x4 w = *(const u32x4*)p; a = (f32x4){bf_lo(w.x), bf_hi(w.x), bf_lo(w.y), bf_hi(w.y)}; b = (f32x4){bf_lo(w.z), bf_hi(w.z), bf_lo(w.w), bf_hi(w.w)}; }
__device__ __forceinline__ f32x4 ld_res4(const float* p) { return *(const f32x4*)p; }
__device__ __forceinline__ f32x4 ld_res4(const bf16_t* p) { const u32x2 w = *(const u32x2*)p; return (f32x4){bf_lo(w.x), bf_hi(w.x), bf_lo(w.y), bf_hi(w.y)}; }
template <class RT>
struct EpiRes {
    static constexpr bool AFTER_DRAIN = false;
    const RT* xin_p; const RT* xin_s; float* xo; bf16_t* xb; float* ss;
    __device__ __forceinline__ void operator()(const Acc& acc, const Unit& u, int wr, int wc, int fr, int fq) const {
        const RT* xin = xin_p;
#pragma unroll
        for (int ai = 0; ai < 2; ++ai)
#pragma unroll
            for (int m = 0; m < 4; ++m) {
                const int row = u.pm * 256 + ai * 128 + wr * 64 + m * 16 + fr;
                float sq = 0.f;
#pragma unroll
                for (int bj = 0; bj < 2; ++bj) {
                    const int col = u.pn * 256 + bj * 128 + wc * 32 + 8 * fq;
                    const size_t off = (size_t)row * D + col;
                    f32x4 r0, r1; ld_res8(xin + off, r0, r1);
                    const f32x4 v0 = acc[ai][bj][m][0] + r0, v1 = acc[ai][bj][m][1] + r1;
                    if (xo) { *(f32x4*)(xo + off) = v0; *(f32x4*)(xo + off + 4) = v1; }
                    if (xb) st_bf16x8(xb + off, v0, v1);
                    sq += (v0[0] * v0[0] + v0[1] * v0[1]) + (v0[2] * v0[2] + v0[3] * v0[3]) + (v1[0] * v1[0] + v1[1] * v1[1]) + (v1[2] * v1[2] + v1[3] * v1[3]);
                }
                sq += __shfl_xor(sq, 16); sq += __shfl_xor(sq, 32);
                if (fq == 0) atomicAdd(ss + row, sq);
            }
    }
    __device__ __forceinline__ void strip(const SAcc& sacc, const Unit& u, int wr, int wc, int fr, int fq) const {
        const int row = u.srow + fr; const RT* xin = xin_s - (size_t)MP * D;
        float sq = 0.f;
#pragma unroll
        for (int bj = 0; bj < 2; ++bj) {
            const int col = u.pn * 256 + bj * 128 + wc * 32 + 8 * fq + 4 * wr;
            const size_t off = (size_t)row * D + col;
            const f32x4 v = sacc[bj] + ld_res4(xin + off);
            if (xo) *(f32x4*)(xo + off) = v;
            if (xb) st_bf16x4(xb + off, v);
            sq += (v[0] * v[0] + v[1] * v[1]) + (v[2] * v[2] + v[3] * v[3]);
        }
        sq += __shfl_xor(sq, 16); sq += __shfl_xor(sq, 32);
        if (fq == 0) atomicAdd(ss + row, sq);
    }
};
struct EpiFinal {
    static constexpr bool AFTER_DRAIN = true;
    const bf16_t* xin; float* out; float* ss; unsigned* cnt; const float* gf;
    __device__ __forceinline__ void operator()(const Acc&, const Unit&, int, int, int, int) const {}
    __device__ __forceinline__ void fused(Acc& acc, f32x4 (&sacc)[2], const Unit& u, int wr, int wc, int fr, int fq, LAS unsigned char* lds, int wid, int lane) const {
#pragma unroll
        for (int ai = 0; ai < 2; ++ai)
#pragma unroll
            for (int m = 0; m < 4; ++m) {
                const int row = u.pm * 256 + ai * 128 + wr * 64 + m * 16 + fr;
                float sq = 0.f;
#pragma unroll
                for (int bj = 0; bj < 2; ++bj) {
                    const size_t off = (size_t)row * D + u.pn * 256 + bj * 128 + wc * 32 + 8 * fq;
                    f32x4 r0, r1; ld_res8(xin + off, r0, r1);
                    const f32x4 v0 = acc[ai][bj][m][0] + r0, v1 = acc[ai][bj][m][1] + r1; acc[ai][bj][m][0] = v0; acc[ai][bj][m][1] = v1;
                    sq += (v0[0] * v0[0] + v0[1] * v0[1]) + (v0[2] * v0[2] + v0[3] * v0[3]) + (v1[0] * v1[0] + v1[1] * v1[1]) + (v1[2] * v1[2] + v1[3] * v1[3]);
                }
                sq += __shfl_xor(sq, 16); sq += __shfl_xor(sq, 32);
                if (fq == 0) { const float old = atomicAdd(ss + row, sq); asm volatile("" :: "v"(old)); }
            }
        const int srow = u.srow + fr;
        {
            float sq = 0.f;
#pragma unroll
            for (int bj = 0; bj < 2; ++bj) {
                const size_t off = (size_t)srow * D + u.pn * 256 + bj * 128 + wc * 32 + 8 * fq + 4 * wr;
                const f32x4 v = sacc[bj] + ld_res4(xin + off); sacc[bj] = v;
                sq += (v[0] * v[0] + v[1] * v[1]) + (v[2] * v[2] + v[3] * v[3]);
            }
            sq += __shfl_xor(sq, 16); sq += __shfl_xor(sq, 32);
            if (fq == 0) { const float old = atomicAdd(ss + srow, sq); asm volatile("" :: "v"(old)); }
        }
        asm volatile("s_waitcnt vmcnt(0)" ::: "memory");
        __builtin_amdgcn_s_barrier();
        if (wid == 0 && lane == 0) {
            unsigned* cw = cnt + 64 * u.pm;
            __hip_atomic_fetch_add(cw, 1u, __ATOMIC_RELEASE, __HIP_MEMORY_SCOPE_AGENT);
            unsigned sp = 0;
            while (__hip_atomic_load(cw, __ATOMIC_RELAXED, __HIP_MEMORY_SCOPE_AGENT) < 8u) { __builtin_amdgcn_s_sleep(1); if (++sp > (1u << 22)) break; }
            __builtin_amdgcn_fence(__ATOMIC_ACQUIRE, "agent");
            asm volatile("s_waitcnt vmcnt(0)" ::: "memory");
        }
        __builtin_amdgcn_s_barrier(); asm volatile("" ::: "memory");
        f32x4 g0[2], g1[2];
#pragma unroll
        for (int bj = 0; bj < 2; ++bj) { const int col = u.pn * 256 + bj * 128 + wc * 32 + 8 * fq; g0[bj] = *(const f32x4*)(gf + col); g1[bj] = *(const f32x4*)(gf + col + 4); }
#pragma unroll
        for (int ai = 0; ai < 2; ++ai)
#pragma unroll
            for (int m = 0; m < 4; ++m) {
                const int row = u.pm * 256 + ai * 128 + wr * 64 + m * 16 + fr;
                const float rs = rsqrtf(__hip_atomic_load(ss + row, __ATOMIC_RELAXED, __HIP_MEMORY_SCOPE_AGENT) * (1.0f / D) + EPS);
#pragma unroll
                for (int bj = 0; bj < 2; ++bj) {
                    const size_t off = (size_t)row * D + u.pn * 256 + bj * 128 + wc * 32 + 8 * fq;
                    *(f32x4*)(out + off) = acc[ai][bj][m][0] * rs * g0[bj]; *(f32x4*)(out + off + 4) = acc[ai][bj][m][1] * rs * g1[bj];
                }
            }
        {
            const float rs = rsqrtf(__hip_atomic_load(ss + srow, __ATOMIC_RELAXED, __HIP_MEMORY_SCOPE_AGENT) * (1.0f / D) + EPS);
#pragma unroll
            for (int bj = 0; bj < 2; ++bj) {
                const int col = u.pn * 256 + bj * 128 + wc * 32 + 8 * fq + 4 * wr;
                *(f32x4*)(out + (size_t)srow * D + col) = sacc[bj] * rs * *(const f32x4*)(gf + col);
            }
        }
    }
};
struct EpiQ {
    static constexpr bool AFTER_DRAIN = false;
    bf16_t* Q; const float* ss;
    __device__ __forceinline__ void operator()(const Acc& acc, const Unit& u, int wr, int wc, int fr, int fq) const {
#pragma unroll
        for (int ai = 0; ai < 2; ++ai)
#pragma unroll
            for (int m = 0; m < 4; ++m) {
                const int row = u.pm * 256 + ai * 128 + wr * 64 + m * 16 + fr;
                const float rs = rsqrtf(ss[row] * (1.0f / D) + EPS);
#pragma unroll
                for (int bj = 0; bj < 2; ++bj) {
                    const int col = u.pn * 256 + bj * 128 + wc * 32 + 8 * fq;
                    st_bf16x8(Q + (size_t)row * D + col, acc[ai][bj][m][0] * rs, acc[ai][bj][m][1] * rs);
                }
            }
    }
    __device__ __forceinline__ void strip(const SAcc& sacc, const Unit& u, int wr, int wc, int fr, int fq) const {
        const int row = u.srow + fr; const float rs = rsqrtf(ss[row] * (1.0f / D) + EPS);
#pragma unroll
        for (int bj = 0; bj < 2; ++bj) st_bf16x4(Q + (size_t)row * D + u.pn * 256 + bj * 128 + wc * 32 + 8 * fq + 4 * wr, sacc[bj] * rs);
    }
};
struct EpiGateUp {
    static constexpr bool AFTER_DRAIN = false;
    bf16_t* H; const float* ss;
    __device__ __forceinline__ void operator()(const Acc& acc, const Unit& u, int wr, int wc, int fr, int fq) const {
        const int col = u.pn * 128 + wc * 32 + 8 * fq;
#pragma unroll
        for (int ai = 0; ai < 2; ++ai)
#pragma unroll
            for (int m = 0; m < 4; ++m) {
                const int row = u.pm * 256 + ai * 128 + wr * 64 + m * 16 + fr;
                const float rs = rsqrtf(ss[row] * (1.0f / D) + EPS);
                f32x4 o[2];
#pragma unroll
                for (int n = 0; n < 2; ++n)
#pragma unroll
                    for (int j = 0; j < 4; ++j) { const float gt = acc[ai][0][m][n][j] * rs, up = acc[ai][1][m][n][j] * rs; o[n][j] = gt * fast_sigmoid(gt) * up; }
                st_bf16x8(H + (size_t)row * FF + col, o[0], o[1]);
            }
    }
    __device__ __forceinline__ void strip(const SAcc& sacc, const Unit& u, int wr, int wc, int fr, int fq) const {
        const int row = u.srow + fr; const float rs = rsqrtf(ss[row] * (1.0f / D) + EPS);
        f32x4 o;
#pragma unroll
        for (int j = 0; j < 4; ++j) { const float gt = sacc[0][j] * rs, up = sacc[1][j] * rs; o[j] = gt * fast_sigmoid(gt) * up; }
        st_bf16x4(H + (size_t)row * FF + u.pn * 128 + wc * 32 + 8 * fq + 4 * wr, o);
    }
};
struct EpiPV {
    static constexpr bool AFTER_DRAIN = false;
    bf16_t* ATT;
    __device__ __forceinline__ void operator()(const Acc& acc, const Unit& u, int wr, int wc, int fr, int fq) const {
#pragma unroll
        for (int ai = 0; ai < 2; ++ai)
#pragma unroll
            for (int m = 0; m < 4; ++m) {
                const int row = u.pm * 256 + ai * 128 + wr * 64 + m * 16 + fr;
#pragma unroll
                for (int bj = 0; bj < 2; ++bj) {
                    const int col = u.pn * 256 + bj * 128 + wc * 32 + 8 * fq;
                    st_bf16x8(ATT + (size_t)row * D + col, acc[ai][bj][m][0], acc[ai][bj][m][1]);
                }
            }
    }
};
struct EpiSoftmax {
    static constexpr bool AFTER_DRAIN = true;
    bf16_t* PR;
    __device__ __forceinline__ void operator()(const Acc&, const Unit&, int, int, int, int) const {}
    __device__ __forceinline__ void fused(Acc& acc, f32x4 (&)[2], const Unit& u, int wr, int wc, int fr, int fq, LAS unsigned char* lds, int wid, int lane) const {
        LAS float* MX = (LAS float*)lds;
        LAS float* SM = (LAS float*)(lds + 4096);
#pragma unroll
        for (int ai = 0; ai < 2; ++ai)
#pragma unroll
            for (int m = 0; m < 4; ++m) {
                float mx = -3.0e38f;
#pragma unroll
                for (int bj = 0; bj < 2; ++bj)
#pragma unroll
                    for (int n = 0; n < 2; ++n)
#pragma unroll
                        for (int j = 0; j < 4; ++j) mx = fmaxf(mx, acc[ai][bj][m][n][j]);
                mx = fmaxf(mx, __shfl_xor(mx, 16)); mx = fmaxf(mx, __shfl_xor(mx, 32));
                if (fq == 0) MX[(ai * 128 + wr * 64 + m * 16 + fr) * 4 + wc] = mx;
            }
        LDS_WAIT(); __builtin_amdgcn_s_barrier(); asm volatile("" ::: "memory");
#pragma unroll
        for (int ai = 0; ai < 2; ++ai)
#pragma unroll
            for (int m = 0; m < 4; ++m) {
                const int r = ai * 128 + wr * 64 + m * 16 + fr;
                const f32x4 mv = *(const LAS f32x4*)(MX + r * 4);
                const float mx = fmaxf(fmaxf(mv[0], mv[1]), fmaxf(mv[2], mv[3]));
                float sm = 0.f;
#pragma unroll
                for (int bj = 0; bj < 2; ++bj)
#pragma unroll
                    for (int n = 0; n < 2; ++n)
#pragma unroll
                        for (int j = 0; j < 4; ++j) { const float e = __expf(acc[ai][bj][m][n][j] - mx); acc[ai][bj][m][n][j] = e; sm += e; }
                sm += __shfl_xor(sm, 16); sm += __shfl_xor(sm, 32);
                if (fq == 0) SM[r * 4 + wc] = sm;
            }
        LDS_WAIT(); __builtin_amdgcn_s_barrier(); asm volatile("" ::: "memory");
#pragma unroll
        for (int ai = 0; ai < 2; ++ai)
#pragma unroll
            for (int m = 0; m < 4; ++m) {
                const int r = ai * 128 + wr * 64 + m * 16 + fr;
                const f32x4 sv = *(const LAS f32x4*)(SM + r * 4);
                const float inv = __builtin_amdgcn_rcpf((sv[0] + sv[1]) + (sv[2] + sv[3]));
#pragma unroll
                for (int bj = 0; bj < 2; ++bj) {
                    const int col = bj * 128 + wc * 32 + 8 * fq;
                    st_bf16x8(PR + ((size_t)u.job * SEQ + u.pm * 256 + r) * 256 + col, acc[ai][bj][m][0] * inv, acc[ai][bj][m][1] * inv);
                }
            }
        LDS_WAIT(); __builtin_amdgcn_s_barrier(); asm volatile("" ::: "memory");
    }
};
}
using pg8::Unit;

enum { I_XP = 0, I_XS = 1, I_MEM = 2, I_PBUF = 3, I_SRE = 4, I_SIM = 5, I_CK = 6, I_CV = 7, I_GMIX = 8, I_WIN = 9, I_WPOOL = 10, I_PSCALE = 11,
       I_LRE = 12, I_LIM = 13, I_LSTEP = 14, I_BRE = 15, I_BIM = 16, I_CRE = 17, I_CIM = 18, I_SSMD = 19, I_WGLU = 20, I_BGLU = 21, I_WOUT = 22,
       I_GCROSS = 23, I_GMEM = 24, I_WQ = 25, I_WK = 26, I_WV = 27, I_WO = 28, I_GFFN = 29, I_WGATE = 30, I_WUP = 31, I_WDOWN = 32, I_GFINAL = 33 };
struct Args {
    const float* in[34];
    float* out; unsigned char* ws;
};

struct CvItem { const float* src; bf16_t* dst; const float* gk; float sc; int N, ldt; };
__device__ __forceinline__ void cv_load(const CvItem& it, f32x4 (&v)[8], float (&g)[8], int lane) {
#pragma unroll
    for (int i = 0; i < 8; ++i) { const int kk = (lane >> 3) + 8 * i; v[i] = *(const f32x4*)(it.src + (size_t)kk * it.N + 4 * (lane & 7)); g[i] = it.gk ? it.gk[kk] : 1.0f; }
}
__device__ __forceinline__ void cv_finish(const CvItem& it, const f32x4 (&v)[8], const float (&g)[8], LAS float* scr, int lane) {
#pragma unroll
    for (int i = 0; i < 8; ++i) { const int kk = (lane >> 3) + 8 * i; const float m = g[i] * it.sc; LAS float* d = scr + kk * 33 + 4 * (lane & 7);
        d[0] = v[i][0] * m; d[1] = v[i][1] * m; d[2] = v[i][2] * m; d[3] = v[i][3] * m; }
    LDS_WAIT(); __builtin_amdgcn_wave_barrier();
    const int c = lane & 7;
#pragma unroll
    for (int j = 0; j < 4; ++j) { const int n = (lane >> 3) + 8 * j; const LAS float* q = scr + (8 * c) * 33 + n;
        u32x4 o; o.x = cvt_pk_bf16(q[0 * 33], q[1 * 33]); o.y = cvt_pk_bf16(q[2 * 33], q[3 * 33]); o.z = cvt_pk_bf16(q[4 * 33], q[5 * 33]); o.w = cvt_pk_bf16(q[6 * 33], q[7 * 33]);
        *(u32x4*)(it.dst + (size_t)n * it.ldt + 8 * c) = o; }
    LDS_WAIT(); __builtin_amdgcn_wave_barrier();
}
__device__ __forceinline__ void rms_row_to_bf16(const float* xrow, const float* g, bf16_t* orow, int lane) {
    const f32x4* xr = (const f32x4*)xrow + lane; const f32x4* gr = (const f32x4*)g + lane;
    f32x4 v[8]; float s = 0.f;
#pragma unroll
    for (int j = 0; j < 8; ++j) { v[j] = xr[64 * j]; s += (v[j][0] * v[j][0] + v[j][1] * v[j][1]) + (v[j][2] * v[j][2] + v[j][3] * v[j][3]); }
    const float rstd = rsqrtf(wave_sum(s) * (1.0f / D) + EPS);
    u32x2* o8 = (u32x2*)orow + lane;
#pragma unroll
    for (int j = 0; j < 8; ++j) { const f32x4 gg = gr[64 * j]; u32x2 w; w.x = cvt_pk_bf16(v[j][0] * rstd * gg[0], v[j][1] * rstd * gg[1]); w.y = cvt_pk_bf16(v[j][2] * rstd * gg[2], v[j][3] * rstd * gg[3]); o8[64 * j] = w; }
}
__device__ __forceinline__ void cmul(float ar, float ai, float br, float bi, float& cr, float& ci) { cr = ar * br - ai * bi; ci = ar * bi + ai * br; }

__device__ __forceinline__ void ssm_chan(const float* lam_re, const float* lam_im, float delta, int g, int ch, float& ar, float& ai, float& kr, float& ki) {
    const float lr = lam_re[g * 64 + ch], li = lam_im[g * 64 + ch];
    const float mag = expf(lr * delta);
    double rev = (double)li * (double)delta * 0.15915494309189535; rev -= __builtin_rint(rev);
    const float rv = (float)rev;
    ar = mag * __builtin_amdgcn_cosf(rv); ai = mag * __builtin_amdgcn_sinf(rv);
    const float nr = ar - 1.0f, ni = ai, den = 1.0f / (lr * lr + li * li);
    kr = (nr * lr + ni * li) * den; ki = (ni * lr - nr * li) * den;
}

__device__ __forceinline__ void ssm_tables(const Args& A, int g, int lane) {
    const float* lam_re = A.in[I_LRE]; const float* lam_im = A.in[I_LIM]; const float* log_step = A.in[I_LSTEP];
    const float* b_re = A.in[I_BRE]; const float* b_im = A.in[I_BIM]; const float* c_re = A.in[I_CRE]; const float* c_im = A.in[I_CIM];
    float* ABAR = (float*)(A.ws + O_ABAR); bf16_t* BB = (bf16_t*)(A.ws + O_BB); bf16_t* CM = (bf16_t*)(A.ws + O_CM);
    const float delta = expf(log_step[g]);
    {
        float ar, ai, kr, ki; ssm_chan(lam_re, lam_im, delta, g, lane, ar, ai, kr, ki);
        float pr = ar, pi = ai;
#pragma unroll
        for (int s = 0; s < 7; ++s) { float tr, ti; cmul(pr, pi, pr, pi, tr, ti); pr = tr; pi = ti; }
        *(f32x4*)(ABAR + ((size_t)g * 64 + lane) * 4) = (f32x4){ar, ai, pr, pi};
    }
    {
        const int j = lane & 31, hi = lane >> 5;
#pragma unroll
        for (int half = 0; half < 2; ++half) {
            const int ch = j + 32 * half; float ar, ai, kr, ki; ssm_chan(lam_re, lam_im, delta, g, ch, ar, ai, kr, ki);
            float vr[8], vi[8];
#pragma unroll
            for (int i = 0; i < 8; ++i) { const int c = 8 * hi + i; const float br = b_re[((size_t)g * 64 + ch) * 16 + c], bi = b_im[((size_t)g * 64 + ch) * 16 + c]; cmul(kr, ki, br, bi, vr[i], vi[i]); }
            u32x4 wr_, wi_;
            wr_.x = cvt_pk_bf16(vr[0], vr[1]); wr_.y = cvt_pk_bf16(vr[2], vr[3]); wr_.z = cvt_pk_bf16(vr[4], vr[5]); wr_.w = cvt_pk_bf16(vr[6], vr[7]);
            wi_.x = cvt_pk_bf16(vi[0], vi[1]); wi_.y = cvt_pk_bf16(vi[2], vi[3]); wi_.z = cvt_pk_bf16(vi[4], vi[5]); wi_.w = cvt_pk_bf16(vi[6], vi[7]);
            *(u32x4*)(BB + (((size_t)g * 4 + half) * 64 + lane) * 8) = wr_;
            *(u32x4*)(BB + (((size_t)g * 4 + 2 + half) * 64 + lane) * 8) = wi_;
        }
    }
    {
        const int c = lane & 15, fq = lane >> 4;
#pragma unroll
        for (int ks = 0; ks < 4; ++ks) {
            float v[8];
#pragma unroll
            for (int i = 0; i < 8; ++i) { const int k = 32 * ks + 8 * fq + i, jj = k >> 2, sel = k & 3, ch = jj + 32 * (sel >> 1);
                v[i] = (sel & 1) ? -c_im[((size_t)g * 16 + c) * 64 + ch] : c_re[((size_t)g * 16 + c) * 64 + ch]; }
            u32x4 w; w.x = cvt_pk_bf16(v[0], v[1]); w.y = cvt_pk_bf16(v[2], v[3]); w.z = cvt_pk_bf16(v[4], v[5]); w.w = cvt_pk_bf16(v[6], v[7]);
            *(u32x4*)(CM + (((size_t)g * 4 + ks) * 64 + lane) * 8) = w;
        }
    }
}

constexpr int I_SQ = (D / 64) * (D / 32);
constexpr int I_POOL = 4 * (256 / 64) * (256 / 32);
constexpr int I_GLU = (1024 / 64) * (1024 / 32);
constexpr int I_FF = (D / 64) * (FF / 32);
constexpr int I_DN = (FF / 64) * (D / 32);
constexpr int NITEMS = 6 * I_SQ + I_POOL + I_GLU + 2 * I_FF + I_DN, NEARLY = 3 * I_SQ;
__device__ __forceinline__ CvItem cv_decode(const Args& A, int r) {
    unsigned char* ws = A.ws; CvItem it; it.gk = nullptr; it.sc = 1.f;
    const float* W; bf16_t* WT; int N, ldt, k0, n0, row0; const float* gkb = nullptr;
    if (r < 6 * I_SQ) {
        const int mtx = r / I_SQ; r -= mtx * I_SQ; const int kb = r / (D / 32), nb = r % (D / 32);
        N = D; ldt = D; k0 = 64 * kb; n0 = 32 * nb; row0 = n0;
        switch (mtx) {
            case 0: W = A.in[I_WIN]; WT = (bf16_t*)(ws + O_WIN); break;
            case 1: W = A.in[I_WK]; WT = (bf16_t*)(ws + O_WKV); break;
            case 2: W = A.in[I_WV]; WT = (bf16_t*)(ws + O_WKV); row0 += D; break;
            case 3: W = A.in[I_WOUT]; WT = (bf16_t*)(ws + O_WOUT); break;
            case 4: W = A.in[I_WQ]; WT = (bf16_t*)(ws + O_WQ); gkb = A.in[I_GCROSS]; it.sc = 0.04419417382415922f; break;
            default: W = A.in[I_WO]; WT = (bf16_t*)(ws + O_WO); break;
        }
    } else if ((r -= 6 * I_SQ) < I_POOL) {
        const int gg = r / 32, q = r % 32, kb = q / 8, nb = q % 8;
        W = A.in[I_WPOOL] + (size_t)gg * 65536; WT = (bf16_t*)(ws + O_WPOOL); N = 256; ldt = 256; k0 = 64 * kb; n0 = 32 * nb; row0 = gg * 256 + n0;
    } else if ((r -= I_POOL) < I_GLU) {
        const int kb = r / 32, nb = r % 32; W = A.in[I_WGLU]; WT = (bf16_t*)(ws + O_WGLU); N = 1024; ldt = 1024; k0 = 64 * kb; n0 = 32 * nb; row0 = n0;
    } else if ((r -= I_GLU) < 2 * I_FF) {
        const int up = r / I_FF; r -= up * I_FF; const int kb = r / (FF / 32), nb = r % (FF / 32);
        W = up ? A.in[I_WUP] : A.in[I_WGATE]; WT = (bf16_t*)(ws + O_WGU); N = FF; ldt = D; k0 = 64 * kb; n0 = 32 * nb; row0 = (n0 >> 7) * 256 + up * 128 + (n0 & 127); gkb = A.in[I_GFFN];
    } else {
        r -= 2 * I_FF; const int kb = r / (D / 32), nb = r % (D / 32);
        W = A.in[I_WDOWN]; WT = (bf16_t*)(ws + O_WDN); N = D; ldt = FF; k0 = 64 * kb; n0 = 32 * nb; row0 = n0;
    }
    it.src = W + (size_t)k0 * N + n0; it.dst = WT + (size_t)row0 * ldt + k0; it.gk = gkb ? gkb + k0 : nullptr; it.N = N; it.ldt = ldt;
    return it;
}
__device__ __forceinline__ void convert_weights(const Args& A, LAS unsigned char* lds, int lo, int hi, int gw, int NGW, const int wv) {
    const int tid = opaque_tid(wv), lane = tid & 63, wave = __builtin_amdgcn_readfirstlane(tid >> 6);
    LAS float* scr = (LAS float*)(lds + wave * 16384);
    if (gw < 0) return;
    int it = lo + gw; if (it >= hi) return;
    CvItem cur = cv_decode(A, it); f32x4 va[8]; float ga[8]; cv_load(cur, va, ga, lane);
    for (;;) {
        const int nit = it + NGW; const bool hn = nit < hi;
        CvItem nx = cur; f32x4 vb[8]; float gb[8];
        if (hn) { nx = cv_decode(A, nit); cv_load(nx, vb, gb, lane); }
        cv_finish(cur, va, ga, scr, lane);
        if (!hn) break;
        cur = nx; it = nit;
#pragma unroll
        for (int i = 0; i < 8; ++i) { va[i] = vb[i]; ga[i] = gb[i]; }
    }
}
__device__ __forceinline__ void phase0_rest(const Args& A, int G, const int wv) {
    const int tid = opaque_tid(wv), lane = tid & 63, wave = __builtin_amdgcn_readfirstlane(tid >> 6);
    const int gw = blockIdx.x * 8 + wave, NGW = G * 8;
    unsigned char* ws = A.ws;
    for (int m = gw; m < M + 1024; m += NGW) {
        if (m < MP) rms_row_to_bf16(A.in[I_XP] + (size_t)m * D, A.in[I_GMIX], (bf16_t*)(ws + O_HMIX) + (size_t)m * D, lane);
        else if (m < M) rms_row_to_bf16(A.in[I_XS] + (size_t)(m - MP) * D, A.in[I_GMIX], (bf16_t*)(ws + O_HMIX) + (size_t)m * D, lane);
        else rms_row_to_bf16(A.in[I_MEM] + (size_t)(m - M) * D, A.in[I_GMEM], (bf16_t*)(ws + O_MN) + (size_t)(m - M) * D, lane);
    }
    for (int g = gw; g < NG; g += NGW) ssm_tables(A, g, lane);
    {
        const f32x4* src = (const f32x4*)A.in[I_PBUF]; f32x4* dst = (f32x4*)(A.out + OUT_PBS);
        const int total = DB * 11 * (PW / 4);
        for (int i = blockIdx.x * 512 + tid; i < total; i += G * 512) { const int b = i / (11 * 256), r = i % (11 * 256); dst[(size_t)b * (15 * 256) + r] = src[(size_t)b * (15 * 256) + 4 * 256 + r]; }
    }
}

__device__ __forceinline__ void acc8(float (&s)[8], u32x4 w) {
    s[0] += bf_lo(w.x); s[1] += bf_hi(w.x); s[2] += bf_lo(w.y); s[3] += bf_hi(w.y); s[4] += bf_lo(w.z); s[5] += bf_hi(w.z); s[6] += bf_lo(w.w); s[7] += bf_hi(w.w);
}
template <int W>
__device__ __forceinline__ void pooled_prompt_item(const bf16_t* P, bf16_t* PO, int row0, int col) {
    const int t0 = row0 & (SEQ - 1);
    u32x4 z[W + 7];
#pragma unroll
    for (int i = 0; i < W + 7; ++i) {
        const int t = t0 - (W - 1) + i;
        z[i] = (u32x4){0u, 0u, 0u, 0u};
        if (t >= 0) z[i] = *(const u32x4*)(P + (size_t)(row0 - (W - 1) + i) * D + col);
    }
    float s[8] = {0.f, 0.f, 0.f, 0.f, 0.f, 0.f, 0.f, 0.f};
#pragma unroll
    for (int i = 0; i < W - 1; ++i) acc8(s, z[i]);
#pragma unroll
    for (int o = 0; o < 8; ++o) {
        const u32x4 uw = z[o + W - 1];
        acc8(s, uw);
        const int n = (t0 + o + 1 < W) ? t0 + o + 1 : W; const float ic = 1.0f / (float)n;
        u32x4 ow;
        ow.x = cvt_pk_bf16(s[0] * ic - bf_lo(uw.x), s[1] * ic - bf_hi(uw.x)); ow.y = cvt_pk_bf16(s[2] * ic - bf_lo(uw.y), s[3] * ic - bf_hi(uw.y));
        ow.z = cvt_pk_bf16(s[4] * ic - bf_lo(uw.z), s[5] * ic - bf_hi(uw.z)); ow.w = cvt_pk_bf16(s[6] * ic - bf_lo(uw.w), s[7] * ic - bf_hi(uw.w));
        *(u32x4*)(PO + (size_t)(row0 + o) * 1024 + col) = ow;
        const u32x4 zo = z[o];
        s[0] -= bf_lo(zo.x); s[1] -= bf_hi(zo.x); s[2] -= bf_lo(zo.y); s[3] -= bf_hi(zo.y); s[4] -= bf_lo(zo.z); s[5] -= bf_hi(zo.z); s[6] -= bf_lo(zo.w); s[7] -= bf_hi(zo.w);
    }
}
template <int W>
__device__ __forceinline__ void pooled_sample_item(const bf16_t* P, bf16_t* PO, const float* sbuf, int b, int col) {
    float h[W - 1][8];
#pragma unroll
    for (int i = 0; i < W - 1; ++i) { const float* q = sbuf + ((size_t)b * PBUF + (PBUF - (W - 1) + i)) * PW + col; const f32x4 a = *(const f32x4*)q, c = *(const f32x4*)(q + 4);
        h[i][0] = a[0]; h[i][1] = a[1]; h[i][2] = a[2]; h[i][3] = a[3]; h[i][4] = c[0]; h[i][5] = c[1]; h[i][6] = c[2]; h[i][7] = c[3]; }
    u32x4 z[4];
#pragma unroll
    for (int t = 0; t < 4; ++t) z[t] = *(const u32x4*)(P + ((size_t)MP + b * 4 + t) * D + col);
    float s[8] = {0.f, 0.f, 0.f, 0.f, 0.f, 0.f, 0.f, 0.f};
#pragma unroll
    for (int i = 0; i < W - 1; ++i)
#pragma unroll
        for (int j = 0; j < 8; ++j) s[j] += h[i][j];
    const float ic = 1.0f / (float)W;
#pragma unroll
    for (int t = 0; t < 4; ++t) {
        const u32x4 uw = z[t];
        acc8(s, uw);
        u32x4 o;
        o.x = cvt_pk_bf16(s[0] * ic - bf_lo(uw.x), s[1] * ic - bf_hi(uw.x)); o.y = cvt_pk_bf16(s[2] * ic - bf_lo(uw.y), s[3] * ic - bf_hi(uw.y));
        o.z = cvt_pk_bf16(s[4] * ic - bf_lo(uw.z), s[5] * ic - bf_hi(uw.z)); o.w = cvt_pk_bf16(s[6] * ic - bf_lo(uw.w), s[7] * ic - bf_hi(uw.w));
        *(u32x4*)(PO + ((size_t)MP + b * 4 + t) * 1024 + col) = o;
        if (t < W - 1) {
#pragma unroll
            for (int j = 0; j < 8; ++j) s[j] -= h[t < W - 1 ? t : 0][j];
        } else {
            const u32x4 zo = z[t - (W - 1) >= 0 ? t - (W - 1) : 0];
            s[0] -= bf_lo(zo.x); s[1] -= bf_hi(zo.x); s[2] -= bf_lo(zo.y); s[3] -= bf_hi(zo.y); s[4] -= bf_lo(zo.z); s[5] -= bf_hi(zo.z); s[6] -= bf_lo(zo.w); s[7] -= bf_hi(zo.w);
        }
    }
}
__device__ __forceinline__ void pooled_phase(const Args& A, int G, const int wv) {
    const bf16_t* P = (const bf16_t*)(A.ws + O_P); bf16_t* PO = (bf16_t*)(A.ws + O_POOLED); const float* sbuf = A.in[I_PBUF];
    const int tid0 = blockIdx.x * 512 + opaque_tid(wv);
    for (int it = tid0; it < 4 * 1024 * 32; it += G * 512) {
        const int g = it >> 15, rb = (it >> 5) & 1023, col = g * 256 + (it & 31) * 8, row0 = rb * 8;
        if (g == 0) pooled_prompt_item<2>(P, PO, row0, col); else if (g == 1) pooled_prompt_item<4>(P, PO, row0, col);
        else if (g == 2) pooled_prompt_item<8>(P, PO, row0, col); else pooled_prompt_item<16>(P, PO, row0, col);
    }
    for (int it = tid0; it < 4 * DB * 32; it += G * 512) {
        const int g = it >> 12, b = (it >> 5) & (DB - 1), col = g * 256 + (it & 31) * 8;
        if (g == 0) pooled_sample_item<2>(P, PO, sbuf, b, col); else if (g == 1) pooled_sample_item<4>(P, PO, sbuf, b, col);
        else if (g == 2) pooled_sample_item<8>(P, PO, sbuf, b, col); else pooled_sample_item<16>(P, PO, sbuf, b, col);
    }
}

struct SsmCtx {
    bf16x8 BB[4], CMf[4];
    float a[4];
    float dsk[4];
    float s[4];
};
template <int MODE>
__device__ __forceinline__ void ssm_sub(SsmCtx& cx, const bf16_t* P, bf16_t* Gout, int g, const bf16x8 af  ,
                                        const size_t (&yrow)[2]  , LAS unsigned char* tile, int lane,
                                        const float* h_re, const float* h_im, float* o_re, float* o_im, int sbatch0  ) {
    const int j = lane & 31, hi = lane >> 5, fr = lane & 15, fq = lane >> 4;
    u32x2 uwp[2] = {(u32x2){0u, 0u}, (u32x2){0u, 0u}};
    if (MODE != 0) { uwp[0] = *(const u32x2*)(P + yrow[0] * D + 1024 + 16 * g + 4 * fq); uwp[1] = *(const u32x2*)(P + yrow[1] * D + 1024 + 16 * g + 4 * fq); }
    const f32x16 z = {0.f, 0.f, 0.f, 0.f, 0.f, 0.f, 0.f, 0.f, 0.f, 0.f, 0.f, 0.f, 0.f, 0.f, 0.f, 0.f};
    const f32x16 r0 = __builtin_amdgcn_mfma_f32_32x32x16_bf16(af, cx.BB[0], z, 0, 0, 0);
    const f32x16 r1 = __builtin_amdgcn_mfma_f32_32x32x16_bf16(af, cx.BB[1], z, 0, 0, 0);
    const f32x16 i0 = __builtin_amdgcn_mfma_f32_32x32x16_bf16(af, cx.BB[2], z, 0, 0, 0);
    const f32x16 i1 = __builtin_amdgcn_mfma_f32_32x32x16_bf16(af, cx.BB[3], z, 0, 0, 0);
    float sr0 = cx.s[0], si0 = cx.s[1], sr1 = cx.s[2], si1 = cx.s[3];
    const float ar0 = cx.a[0], ai0 = cx.a[1], ar1 = cx.a[2], ai1 = cx.a[3];
#pragma unroll
    for (int r = 0; r < 16; ++r) {
        if (MODE == 2 && (r & 3) == 0) {
            const size_t o = ((size_t)(sbatch0 + (r >> 2)) * NG + g) * 64 + j;
            sr0 = h_re[o]; si0 = h_im[o]; sr1 = h_re[o + 32]; si1 = h_im[o + 32];
        }
        const float nr0 = fmaf(ar0, sr0, fmaf(-ai0, si0, r0[r])), ni0 = fmaf(ar0, si0, fmaf(ai0, sr0, i0[r]));
        const float nr1 = fmaf(ar1, sr1, fmaf(-ai1, si1, r1[r])), ni1 = fmaf(ar1, si1, fmaf(ai1, sr1, i1[r]));
        sr0 = nr0; si0 = ni0; sr1 = nr1; si1 = ni1;
        if (MODE != 0) { u32x2 w; w.x = cvt_pk_bf16(sr0, si0); w.y = cvt_pk_bf16(sr1, si1); *(LAS u32x2*)(tile + (16 * hi + r) * 272 + 8 * j) = w; }
        if (MODE == 2 && (r & 3) == 3) {
            const size_t o = ((size_t)(sbatch0 + (r >> 2)) * NG + g) * 64 + j;
            o_re[o] = sr0; o_im[o] = si0; o_re[o + 32] = sr1; o_im[o + 32] = si1;
        }
    }
    cx.s[0] = sr0; cx.s[1] = si0; cx.s[2] = sr1; cx.s[3] = si1;
    if (MODE != 0) {
        LDS_WAIT(); __builtin_amdgcn_wave_barrier();
#pragma unroll
        for (int tg = 0; tg < 2; ++tg) {
            f32x4 y = {0.f, 0.f, 0.f, 0.f};
#pragma unroll
            for (int ks = 0; ks < 4; ++ks) {
                const bf16x8 sf = *(const LAS bf16x8*)(tile + (16 * tg + fr) * 272 + (32 * ks + 8 * fq) * 2);
                y = __builtin_amdgcn_mfma_f32_16x16x32_bf16(cx.CMf[ks], sf, y, 0, 0, 0);
            }
            const u32x2 uw = uwp[tg];
            const float y0 = gelu_tanh(y[0] + cx.dsk[0] * bf_lo(uw.x)), y1 = gelu_tanh(y[1] + cx.dsk[1] * bf_hi(uw.x));
            const float y2 = gelu_tanh(y[2] + cx.dsk[2] * bf_lo(uw.y)), y3 = gelu_tanh(y[3] + cx.dsk[3] * bf_hi(uw.y));
            u32x2 o; o.x = cvt_pk_bf16(y0, y1); o.y = cvt_pk_bf16(y2, y3);
            *(u32x2*)(Gout + yrow[tg] * 1024 + 16 * g + 4 * fq) = o;
        }
    }
}

__device__ __forceinline__ void ssm_load_ctx(SsmCtx& cx, const Args& A, int g, int lane) {
    const bf16_t* BB = (const bf16_t*)(A.ws + O_BB); const bf16_t* CM = (const bf16_t*)(A.ws + O_CM); const float* ABAR = (const float*)(A.ws + O_ABAR);
    const int j = lane & 31, fq = lane >> 4;
#pragma unroll
    for (int i = 0; i < 4; ++i) { cx.BB[i] = *(const bf16x8*)(BB + (((size_t)g * 4 + i) * 64 + lane) * 8); cx.CMf[i] = *(const bf16x8*)(CM + (((size_t)g * 4 + i) * 64 + lane) * 8); }
    const f32x4 a0 = *(const f32x4*)(ABAR + ((size_t)g * 64 + j) * 4), a1 = *(const f32x4*)(ABAR + ((size_t)g * 64 + j + 32) * 4);
    cx.a[0] = a0[0]; cx.a[1] = a0[1]; cx.a[2] = a1[0]; cx.a[3] = a1[1];
    const f32x4 dv = *(const f32x4*)(A.in[I_SSMD] + 16 * g + 4 * fq);
    cx.dsk[0] = dv[0]; cx.dsk[1] = dv[1]; cx.dsk[2] = dv[2]; cx.dsk[3] = dv[3];
}

__device__ __forceinline__ void ssm_phase(const Args& A, LAS unsigned char* lds, int G, const int wv) {
    const int tid = opaque_tid(wv), lane = tid & 63, w = __builtin_amdgcn_readfirstlane(tid >> 6);
    const int j = lane & 31, hi = lane >> 5, fr = lane & 15;
    const bf16_t* P = (const bf16_t*)(A.ws + O_P); bf16_t* Gout = (bf16_t*)(A.ws + O_G);
    const float* ABAR = (const float*)(A.ws + O_ABAR);
    LAS unsigned char* tile = lds + w * 8704;
    LAS f32x4* EL = (LAS f32x4*)(lds + 8 * 8704);
    const int arow_i = lane & 31, own = (arow_i >> 2) & 1, rloc = 4 * (arow_i >> 3) + (arow_i & 3);
    for (int un = blockIdx.x; un < NB * NG; un += G) {
        const int b = un >> 6, g = un & 63;
        SsmCtx cx; ssm_load_ctx(cx, A, g, lane);
        const f32x4 p0 = *(const f32x4*)(ABAR + ((size_t)g * 64 + j) * 4), p1 = *(const f32x4*)(ABAR + ((size_t)g * 64 + j + 32) * 4);
        const size_t rowb = (size_t)b * SEQ;
        size_t yrow[2];
        cx.s[0] = cx.s[1] = cx.s[2] = cx.s[3] = 0.f;
        const bf16_t* abase = P + (rowb + (2 * w + own) * 128 + rloc) * D + 1024 + 16 * g + 8 * hi;
        bf16x8 af = *(const bf16x8*)abase;
        for (int k = 0; k < 8; ++k) {
            const bf16x8 afn = *(const bf16x8*)(abase + (size_t)(16 * ((k + 1) & 7)) * D);
            yrow[0] = 0; yrow[1] = 0;
            ssm_sub<0>(cx, P, Gout, g, af, yrow, tile, lane, nullptr, nullptr, nullptr, nullptr, 0);
            af = afn;
        }
        EL[(2 * w + hi) * 32 + j] = (f32x4){cx.s[0], cx.s[1], cx.s[2], cx.s[3]};
        LDS_WAIT(); __syncthreads();
        {
            float sr0 = 0.f, si0 = 0.f, sr1 = 0.f, si1 = 0.f; const int wk = 2 * w + hi;
            for (int q = 0; q < 15; ++q) {
                if (q < wk) { const f32x4 e = EL[q * 32 + j]; float tr, ti;
                    cmul(p0[2], p0[3], sr0, si0, tr, ti); sr0 = tr + e[0]; si0 = ti + e[1];
                    cmul(p1[2], p1[3], sr1, si1, tr, ti); sr1 = tr + e[2]; si1 = ti + e[3]; }
            }
            cx.s[0] = sr0; cx.s[1] = si0; cx.s[2] = sr1; cx.s[3] = si1;
        }
        for (int k = 0; k < 8; ++k) {
            const bf16x8 afn = *(const bf16x8*)(abase + (size_t)(16 * ((k + 1) & 7)) * D);
            yrow[0] = rowb + (2 * w) * 128 + 16 * k + fr; yrow[1] = rowb + (2 * w + 1) * 128 + 16 * k + fr;
            ssm_sub<1>(cx, P, Gout, g, af, yrow, tile, lane, nullptr, nullptr, nullptr, nullptr, 0);
            af = afn;
        }
        if (w == 7 && hi == 1) {
            const size_t o = ((size_t)b * NG + g) * 64 + j;
            A.out[OUT_REP + o] = cx.s[0]; A.out[OUT_IMP + o] = cx.s[1]; A.out[OUT_REP + o + 32] = cx.s[2]; A.out[OUT_IMP + o + 32] = cx.s[3];
        }
        LDS_WAIT(); __syncthreads();
    }
    for (int un = (int)blockIdx.x; un < 2 * NG; un += G) {
        const int g = un >> 1, bh = un & 1;
        SsmCtx cx; ssm_load_ctx(cx, A, g, lane);
        cx.s[0] = cx.s[1] = cx.s[2] = cx.s[3] = 0.f;
        const int bbase = bh * 64 + w * 8;
        const size_t arow = (size_t)MP + (size_t)(bbase + own * 4 + (arow_i >> 3)) * 4 + (arow_i & 3);
        size_t yrow[2];
        yrow[0] = (size_t)MP + (size_t)(bbase + (fr >> 2)) * 4 + (fr & 3); yrow[1] = (size_t)MP + (size_t)(bbase + 4 + (fr >> 2)) * 4 + (fr & 3);
        const bf16x8 af = *(const bf16x8*)(P + arow * D + 1024 + 16 * g + 8 * hi);
        ssm_sub<2>(cx, P, Gout, g, af, yrow, tile, lane, A.in[I_SRE], A.in[I_SIM], A.out + OUT_RES, A.out + OUT_IMS, bbase + hi * 4);
    }
}

template <int WPU>
__device__ __forceinline__ void sample_attn_units(const Args& A, LAS unsigned char* lds, int su0, const int wv) {
    constexpr int KPW = 256 / WPU, NB = KPW / 8, NKG = KPW / 16;
    const int tid = opaque_tid(wv), lane = tid & 63, w = __builtin_amdgcn_readfirstlane(tid >> 6), fr = lane & 15, fq = lane >> 4;
    const int su = su0 + (WPU == 4 ? (w >> 2) : 0), b = su >> 2, h = su & 3, kq = (WPU == 4) ? (w & 3) : w;
    const bf16_t* Q = (const bf16_t*)(A.ws + O_Q); bf16_t* ATT = (bf16_t*)(A.ws + O_ATT);
    const float* Kc = A.in[I_CK] + (((size_t)b * NMEM + KPW * kq) * NH + h) * HD;
    const float* Vc = A.in[I_CV] + (((size_t)b * NMEM + KPW * kq) * NH + h) * HD;
    LAS bf16_t* QSw = (LAS bf16_t*)(lds + w * 4096);
    LAS float* PLw = (LAS float*)(lds + 32768 + w * 1024);
    LAS float* ML = (LAS float*)(lds + 40960);
    LAS float* RED = (LAS float*)(lds + 49152);
#pragma unroll
    for (int t = 0; t < 4; ++t) *(LAS u32x4*)(QSw + t * 512 + lane * 8) = *(const u32x4*)(Q + ((size_t)MP + b * 4 + t) * D + h * HD + lane * 8);
    f32x4 ra[16], rb[16];
#define KLOAD(dst, bi) do { const float* kp_ = Kc + (size_t)(16 * ((bi) >> 1) + fr) * (NH * HD) + 4 * fq + 256 * ((bi) & 1); \
        _Pragma("unroll") for (int i = 0; i < 8; ++i) { dst[2 * i] = *(const f32x4*)(kp_ + 32 * i); dst[2 * i + 1] = *(const f32x4*)(kp_ + 32 * i + 16); } } while (0)
#define KUSE(src, bi) do { _Pragma("unroll") for (int i = 0; i < 8; ++i) { const int kd = 8 * ((bi) & 1) + i; const f32x4 k0 = src[2 * i], k1 = src[2 * i + 1]; \
        u32x4 kw; kw.x = cvt_pk_bf16(k0[0], k0[1]); kw.y = cvt_pk_bf16(k0[2], k0[3]); kw.z = cvt_pk_bf16(k1[0], k1[1]); kw.w = cvt_pk_bf16(k1[2], k1[3]); \
        u32x4 qw = {0u, 0u, 0u, 0u}; \
        if (fr < 4) { const u32x2 qa = *(const LAS u32x2*)(QSw + fr * 512 + 32 * kd + 4 * fq), qb = *(const LAS u32x2*)(QSw + fr * 512 + 32 * kd + 16 + 4 * fq); qw.x = qa.x; qw.y = qa.y; qw.z = qb.x; qw.w = qb.y; } \
        sc[(bi) >> 1] = __builtin_amdgcn_mfma_f32_16x16x32_bf16(__builtin_bit_cast(bf16x8, kw), __builtin_bit_cast(bf16x8, qw), sc[(bi) >> 1], 0, 0, 0); } } while (0)
#define VLOAD(dst, vb) do { const float* vp_ = Vc + (size_t)(8 * (vb)) * (NH * HD) + 4 * lane; \
        _Pragma("unroll") for (int k = 0; k < 8; ++k) { dst[2 * k] = __builtin_nontemporal_load((const f32x4*)(vp_ + (size_t)k * (NH * HD))); dst[2 * k + 1] = __builtin_nontemporal_load((const f32x4*)(vp_ + (size_t)k * (NH * HD) + 256)); } } while (0)
#define VUSE(src, vb) do { _Pragma("unroll") for (int k = 0; k < 8; ++k) { const f32x4 p = *(const LAS f32x4*)(PLw + (8 * (vb) + k) * 4); \
        _Pragma("unroll") for (int t = 0; t < 4; ++t) { o[t][0] += src[2 * k] * p[t]; o[t][1] += src[2 * k + 1] * p[t]; } } } while (0)
#define SB() __builtin_amdgcn_sched_barrier(0)
    KLOAD(ra, 0); KLOAD(rb, 1);
    LDS_WAIT(); __builtin_amdgcn_wave_barrier();
    f32x4 sc[NKG];
#pragma unroll
    for (int i = 0; i < NKG; ++i) sc[i] = (f32x4){0.f, 0.f, 0.f, 0.f};
    SB(); KUSE(ra, 0); SB(); KLOAD(ra, 2); SB(); KUSE(rb, 1); SB(); KLOAD(rb, 3); SB();
    if constexpr (NB == 8) {
        KUSE(ra, 2); SB(); KLOAD(ra, 4); SB(); KUSE(rb, 3); SB(); KLOAD(rb, 5); SB();
        KUSE(ra, 4); SB(); KLOAD(ra, 6); SB(); KUSE(rb, 5); SB(); KLOAD(rb, 7); SB();
        KUSE(ra, 6); SB(); VLOAD(ra, 0); SB(); KUSE(rb, 7); SB(); VLOAD(rb, 1); SB();
    } else {
        KUSE(ra, 2); SB(); VLOAD(ra, 0); SB(); KUSE(rb, 3); SB(); VLOAD(rb, 1); SB();
    }
    float mt = -3.0e38f;
#pragma unroll
    for (int kg = 0; kg < NKG; ++kg) mt = fmaxf(mt, fmaxf(fmaxf(sc[kg][0], sc[kg][1]), fmaxf(sc[kg][2], sc[kg][3])));
    mt = fmaxf(mt, __shfl_xor(mt, 16)); mt = fmaxf(mt, __shfl_xor(mt, 32));
    float lt = 0.f;
#pragma unroll
    for (int kg = 0; kg < NKG; ++kg)
#pragma unroll
        for (int r = 0; r < 4; ++r) { const float e = __expf(sc[kg][r] - mt); lt += e; if (fr < 4) PLw[(16 * kg + 4 * fq + r) * 4 + fr] = e; }
    lt += __shfl_xor(lt, 16); lt += __shfl_xor(lt, 32);
    if (fr < 4 && fq == 0) { ML[(w * 4 + fr) * 2] = mt; ML[(w * 4 + fr) * 2 + 1] = lt; }
    LDS_WAIT(); __builtin_amdgcn_wave_barrier();
    f32x4 o[4][2];
#pragma unroll
    for (int t = 0; t < 4; ++t) { o[t][0] = (f32x4){0.f, 0.f, 0.f, 0.f}; o[t][1] = (f32x4){0.f, 0.f, 0.f, 0.f}; }
    SB(); VUSE(ra, 0); SB(); VLOAD(ra, 2); SB(); VUSE(rb, 1); SB(); VLOAD(rb, 3); SB();
    if constexpr (NB == 8) {
        VUSE(ra, 2); SB(); VLOAD(ra, 4); SB(); VUSE(rb, 3); SB(); VLOAD(rb, 5); SB();
        VUSE(ra, 4); SB(); VLOAD(ra, 6); SB(); VUSE(rb, 5); SB(); VLOAD(rb, 7); SB();
        VUSE(ra, 6); SB(); VUSE(rb, 7);
    } else {
        VUSE(ra, 2); SB(); VUSE(rb, 3);
    }
#undef KLOAD
#undef KUSE
#undef VLOAD
#undef VUSE
#undef SB
#pragma unroll
    for (int t = 0; t < 4; ++t) { *(LAS f32x4*)(RED + (w * 4 + t) * 512 + 4 * lane) = o[t][0]; *(LAS f32x4*)(RED + (w * 4 + t) * 512 + 256 + 4 * lane) = o[t][1]; }
    LDS_WAIT(); __syncthreads();
    if constexpr (WPU == 4) {
        const int uh = tid >> 8, t = (tid >> 6) & 3, c = (tid & 63) * 8;
        float m4[4], l4[4], Mx = -3.0e38f;
#pragma unroll
        for (int q = 0; q < 4; ++q) { m4[q] = ML[((uh * 4 + q) * 4 + t) * 2]; l4[q] = ML[((uh * 4 + q) * 4 + t) * 2 + 1]; Mx = fmaxf(Mx, m4[q]); }
        f32x4 s0 = {0.f, 0.f, 0.f, 0.f}, s1 = {0.f, 0.f, 0.f, 0.f}; float L = 0.f;
#pragma unroll
        for (int q = 0; q < 4; ++q) { const float f = __expf(m4[q] - Mx); L += l4[q] * f;
            s0 += *(const LAS f32x4*)(RED + ((uh * 4 + q) * 4 + t) * 512 + c) * f; s1 += *(const LAS f32x4*)(RED + ((uh * 4 + q) * 4 + t) * 512 + c + 4) * f; }
        const float iv = 1.0f / L; const int su2 = su0 + uh, b2 = su2 >> 2, h2 = su2 & 3;
        pg8::st_bf16x8(ATT + ((size_t)MP + b2 * 4 + t) * D + h2 * HD + c, s0 * iv, s1 * iv);
    } else {
        const int t = tid >> 7, c = (tid & 127) * 4;
        float m8[8], l8[8], Mx = -3.0e38f;
#pragma unroll
        for (int q = 0; q < 8; ++q) { m8[q] = ML[(q * 4 + t) * 2]; l8[q] = ML[(q * 4 + t) * 2 + 1]; Mx = fmaxf(Mx, m8[q]); }
        f32x4 s0 = {0.f, 0.f, 0.f, 0.f}; float L = 0.f;
#pragma unroll
        for (int q = 0; q < 8; ++q) { const float f = __expf(m8[q] - Mx); L += l8[q] * f; s0 += *(const LAS f32x4*)(RED + (q * 4 + t) * 512 + c) * f; }
        const float iv = 1.0f / L; const int b2 = su0 >> 2, h2 = su0 & 3;
        pg8::st_bf16x4(ATT + ((size_t)MP + b2 * 4 + t) * D + h2 * HD + c, s0 * iv);
    }
    LDS_WAIT(); __syncthreads();
}

constexpr int MTP = MP / 256;
struct SchedGrid {
    int G, c, nM, nN; const char* A; const char* B; size_t ta, tb; const char* Sb; size_t ts;
    __device__ __forceinline__ bool next(int i, Unit& u) const {
        const int L = i * G + c, nwg = nM * nN; if (L >= nwg) return false;
        int wgid = L; { const int q = nwg / 8, r = nwg % 8, xcd = wgid % 8, off = wgid / 8; wgid = (xcd < r ? xcd * (q + 1) : r * (q + 1) + (xcd - r) * q) + off; }
        const int nig = 8 * nN, gid = wgid / nig, fm = gid * 8, gsz = (nM - fm) < 8 ? (nM - fm) : 8;
        u.pm = fm + ((wgid % nig) % gsz); u.pn = (wgid % nig) / gsz;
        u.job = 0; u.a = A + (size_t)u.pm * ta; u.b = B + (size_t)u.pn * tb; u.s = Sb + (size_t)u.pm * ts; u.srow = MP + 16 * u.pm; return true;
    }
};
struct Sched1 {
    int G, c; const char* hmix; const char* win; const char* mn; const char* wkv;
    __device__ __forceinline__ bool next(int i, Unit& u) const {
        int L = i * G + c;
        if (L < MTP * 8) { u.job = 0; u.pm = L % MTP; u.pn = L / MTP; u.a = hmix + (size_t)u.pm * 256 * D * 2; u.b = win + (size_t)u.pn * 256 * D * 2;
            u.s = hmix + ((size_t)MP + 16 * u.pm) * D * 2; u.srow = MP + 16 * u.pm; return true; }
        L -= MTP * 8;
        if (L < 64) { u.job = 1; u.pm = L & 3; u.pn = L >> 2; u.a = mn + (size_t)u.pm * 256 * D * 2; u.b = wkv + (size_t)u.pn * 256 * D * 2; u.s = u.a; u.srow = -1; return true; }
        return false;
    }
};
struct SchedPool {
    int G, c; const char* pooled; const char* wp;
    __device__ __forceinline__ bool next(int i, Unit& u) const {
        const int L = i * G + c; if (L >= MTP * 4) return false;
        u.job = 0; u.pm = L % MTP; u.pn = L / MTP; u.a = pooled + ((size_t)u.pm * 256 * 1024 + u.pn * 256) * 2; u.b = wp + (size_t)u.pn * 256 * 256 * 2;
        u.s = pooled + (((size_t)MP + 16 * u.pm) * 1024 + u.pn * 256) * 2; u.srow = MP + 16 * u.pm; return true;
    }
};
struct SchedScores {
    int c; const char* Q; const char* KB;
    __device__ __forceinline__ bool next(int i, Unit& u) const {
        if (i > 0 || c >= 128) return false;
        const int bh = c >> 3, qb = c & 7, b = bh >> 2, h = bh & 3;
        u.job = bh; u.pm = qb; u.pn = 0; u.a = Q + (((size_t)b * SEQ + qb * 256) * D + h * HD) * 2; u.b = KB + ((size_t)b * NMEM * D + h * HD) * 2; u.s = u.a; u.srow = -1; return true;
    }
};
struct SchedPVown {
    int c; const char* PR; const char* VT;
    __device__ __forceinline__ bool next(int i, Unit& u) const {
        if (i > 1 || c >= 128) return false;
        const int bh = c >> 3, qb = c & 7, pn = i, b = bh >> 2, h = bh & 3;
        u.job = 0; u.pm = b * 8 + qb; u.pn = h * 2 + pn;
        u.a = PR + ((size_t)bh * SEQ + qb * 256) * 256 * 2; u.b = VT + (((size_t)h * HD + pn * 256) * 1024 + b * 256) * 2; u.s = u.a; u.srow = -1; return true;
    }
};
struct SchedPV {
    int G, c; const char* PR; const char* VT;
    __device__ __forceinline__ bool next(int i, Unit& u) const {
        const int L = i * G + c; if (L >= 256) return false;
        const int bh = L >> 4, rem = L & 15, qb = rem >> 1, pn = rem & 1, b = bh >> 2, h = bh & 3;
        u.job = 0; u.pm = b * 8 + qb; u.pn = h * 2 + pn;
        u.a = PR + ((size_t)bh * SEQ + qb * 256) * 256 * 2; u.b = VT + (((size_t)h * HD + pn * 256) * 1024 + b * 256) * 2; u.s = u.a; u.srow = -1; return true;
    }
};


#define XB_TMO      128
#define XB_XCNT(j)  (256  + 64 * (j))
#define XB_XSUB(j)  (1280 + 64 * (j))
#define XB_XGEN(j)  (2304 + 64 * (j))
#define XB_TOP      3328
#define XB_TOPGEN   3392
#define XCD_BAR_WORDS 3456
#define XB_SPIN_CAP (1u << 18)
__device__ __forceinline__ unsigned xb_ld(unsigned* p)              { return __hip_atomic_load(p, __ATOMIC_RELAXED, __HIP_MEMORY_SCOPE_AGENT); }
__device__ __forceinline__ unsigned xb_add(unsigned* p, unsigned v) { return __hip_atomic_fetch_add(p, v, __ATOMIC_RELAXED, __HIP_MEMORY_SCOPE_AGENT); }
__device__ __forceinline__ unsigned xb_xcc_id() { return (unsigned)__builtin_amdgcn_s_getreg((3 << 11) | 20) & 0xFu; }
#define XB_SPIN(cond, bar) do { unsigned _sp = 0; while (cond) { __builtin_amdgcn_s_sleep(1); \
    if ((++_sp & 255u) == 0u) { if (xb_ld(&(bar)[XB_TMO])) break; if (_sp > XB_SPIN_CAP) { atomicAdd(&(bar)[XB_TMO], 1u); break; } } } } while (0)
struct XcdBarrier { unsigned* bar; unsigned x; volatile LAS unsigned* st; };
__device__ __forceinline__ XcdBarrier xcd_barrier_post(unsigned* bar, volatile LAS unsigned* st) {
    XcdBarrier b; b.bar = bar; b.x = xb_xcc_id(); b.st = st;
    if (threadIdx.x == 0) (void)xb_add(&bar[XB_XCNT(b.x)], 1u);
    return b;
}
__device__ __forceinline__ void xcd_barrier_complete(unsigned* bar, unsigned x, unsigned& nloc, unsigned& nx) {
    const unsigned G = gridDim.x * gridDim.y * gridDim.z;
    unsigned sum, cnt, mine, sp = 0u;
    for (;;) {
        sum = 0u; cnt = 0u; mine = 0u;
#pragma unroll
        for (unsigned j = 0; j < 16; ++j) { const unsigned c = xb_ld(&bar[XB_XCNT(j)]); sum += c; cnt += (c > 0u) ? 1u : 0u; mine = (j == x) ? c : mine; }
        if (sum == G) break;
        __builtin_amdgcn_s_sleep(1);
        if ((++sp & 255u) == 0u) { if (xb_ld(&bar[XB_TMO])) break; if (sp > XB_SPIN_CAP) { atomicAdd(&bar[XB_TMO], 1u); break; } }
    }
    nloc = mine > 0u ? mine : 1u; nx = cnt > 0u ? cnt : 1u;
}
__device__ __forceinline__ void xcd_barrier(const XcdBarrier& b, const int wv) {
    asm volatile("s_waitcnt vmcnt(0)" ::: "memory");
    __syncthreads();
    if (opaque_tid(wv) == 0) {
        unsigned* bar = b.bar;
        __builtin_amdgcn_s_waitcnt(0);
        unsigned nloc = b.st[0], nx = b.st[1];
        if (nloc == 0u) { xcd_barrier_complete(bar, b.x, nloc, nx); b.st[0] = nloc; b.st[1] = nx; }
        const unsigned old = xb_add(&bar[XB_XSUB(b.x)], 1u);
        const unsigned gen = old / nloc;
        if (old + 1u == (gen + 1u) * nloc) {
            __builtin_amdgcn_fence(__ATOMIC_RELEASE, "agent");
            asm volatile("s_waitcnt vmcnt(0)" ::: "memory");
            __builtin_amdgcn_fence(__ATOMIC_RELEASE, "agent");
            asm volatile("s_waitcnt vmcnt(0)" ::: "memory");
            const unsigned og = xb_add(&bar[XB_TOP], 1u);
            const unsigned tg = og / nx;
            if (og + 1u == (tg + 1u) * nx) xb_add(&bar[XB_TOPGEN], 1u);
            else XB_SPIN(xb_ld(&bar[XB_TOPGEN]) == tg, bar);
            __builtin_amdgcn_fence(__ATOMIC_ACQUIRE, "agent");
            xb_add(&bar[XB_XGEN(b.x)], 1u);
            asm volatile("s_waitcnt vmcnt(0)" ::: "memory");
        } else {
            XB_SPIN(xb_ld(&bar[XB_XGEN(b.x)]) == gen, bar);
            __builtin_amdgcn_fence(__ATOMIC_ACQUIRE, "agent");
            asm volatile("s_waitcnt vmcnt(0)" ::: "memory");
        }
    }
    __syncthreads();
}

#ifndef REP_PHASE
#define REP_PHASE -1
#endif
#define REPEAT(k) for (int rep_ = 0; rep_ < ((REP_PHASE == (k)) ? 2 : 1); ++rep_)
__global__ void __launch_bounds__(512, 2) hymba_fwd(Args A) {
    extern __shared__ __attribute__((aligned(16))) unsigned char lds_raw[];
    LAS unsigned char* lds = (LAS unsigned char*)lds_raw;
    cg::grid_group grid = cg::this_grid();
    const int G = gridDim.x, c = blockIdx.x, wv = __builtin_amdgcn_readfirstlane((int)threadIdx.x >> 6);
    unsigned char* ws = A.ws;
    float* SS1 = (float*)(ws + O_SS1); float* SS2 = (float*)(ws + O_SS2); float* SS3 = (float*)(ws + O_SS3); float* SSD = (float*)(ws + O_BAR + 16384);
    volatile LAS unsigned* bst = (volatile LAS unsigned*)(lds + RING_BYTES + 8192);
    if (threadIdx.x < 4) bst[threadIdx.x] = 0u;
    __syncthreads();
    const XcdBarrier xbar = xcd_barrier_post((unsigned*)(ws + O_BAR), bst);
#define SEAM() xcd_barrier(xbar, wv)

    REPEAT(0) {
    {
        convert_weights(A, lds, 0, NEARLY, c * 8 + wv, G * 8, wv);
        phase0_rest(A, G, wv);
    }
    if (A.ws == nullptr) grid.sync();
    SEAM();
    }
    REPEAT(1) {
    {
        Sched1 S{G, c, (const char*)(ws + O_HMIX), (const char*)(ws + O_WIN), (const char*)(ws + O_MN), (const char*)(ws + O_WKV)};
        pg8::EpiInKv E{(bf16_t*)(ws + O_P), A.out, (bf16_t*)(ws + O_KB), (bf16_t*)(ws + O_VT)};
        pg8::gemm_phase<pg8::EpiInKv, Sched1, true, true>(lds, pg8::Dims{D, D, D}, S, E, wv);
        __syncthreads();
        const int skip = (G > 128) ? 64 : 0;
        convert_weights(A, lds, NEARLY, NITEMS, (c >= skip) ? (c - skip) * 8 + wv : -1, (G - skip) * 8, wv);
    }
    SEAM();
    }
    REPEAT(2) {
    ssm_phase(A, lds, G, wv);
    pooled_phase(A, G, wv);
    SEAM();
    }
    REPEAT(3) {
    {
        SchedPool S{G, c, (const char*)(ws + O_POOLED), (const char*)(ws + O_WPOOL)};
        pg8::EpiPool E{(bf16_t*)(ws + O_MIX), A.in[I_PSCALE]};
        pg8::gemm_phase<pg8::EpiPool, SchedPool, true, true>(lds, pg8::Dims{1024, 256, 256}, S, E, wv);
        SchedGrid S2{G, G - 1 - c, MTP, 4, (const char*)(ws + O_G), (const char*)(ws + O_WGLU), (size_t)256 * 1024 * 2, (size_t)256 * 1024 * 2, (const char*)(ws + O_G) + (size_t)MP * 1024 * 2, (size_t)16 * 1024 * 2};
        pg8::EpiGlu E2{(bf16_t*)(ws + O_MIX), (const bf16_t*)(ws + O_G), A.in[I_BGLU]};
        pg8::gemm_phase<pg8::EpiGlu, SchedGrid, true, true>(lds, pg8::Dims{1024, 1024, 1024}, S2, E2, wv);
    }
    SEAM();
    }
    REPEAT(4) {
    {
        SchedGrid S{G, c, MTP, 8, (const char*)(ws + O_MIX), (const char*)(ws + O_WOUT), (size_t)256 * D * 2, (size_t)256 * D * 2, (const char*)(ws + O_MIX) + (size_t)MP * D * 2, (size_t)16 * D * 2};
        pg8::EpiRes<float> E{A.in[I_XP], A.in[I_XS], nullptr, (bf16_t*)(ws + O_XB), rep_ ? SSD : SS1};
        pg8::gemm_phase<pg8::EpiRes<float>, SchedGrid, true, true>(lds, pg8::Dims{D, D, D}, S, E, wv);
    }
    SEAM();
    }
    REPEAT(5) {
    {
        SchedGrid S{G, c, MTP, 8, (const char*)(ws + O_XB), (const char*)(ws + O_WQ), (size_t)256 * D * 2, (size_t)256 * D * 2, (const char*)(ws + O_XB) + (size_t)MP * D * 2, (size_t)16 * D * 2};
        pg8::EpiQ E{(bf16_t*)(ws + O_Q), SS1};
        pg8::gemm_phase<pg8::EpiQ, SchedGrid, true, true>(lds, pg8::Dims{D, D, D}, S, E, wv);
    }
    SEAM();
    }
    REPEAT(6) {
    {
        if (G == 256) {
            if (c < 128) {
                { SchedScores S{c, (const char*)(ws + O_Q), (const char*)(ws + O_KB)};
                  pg8::EpiSoftmax E{(bf16_t*)(ws + O_PR)};
                  pg8::gemm_phase<pg8::EpiSoftmax, SchedScores, false, false>(lds, pg8::Dims{D, D, HD}, S, E, wv); }
                asm volatile("s_waitcnt vmcnt(0)" ::: "memory"); __syncthreads();
                { SchedPVown S{c, (const char*)(ws + O_PR), (const char*)(ws + O_VT)};
                  pg8::EpiPV E{(bf16_t*)(ws + O_ATT)};
                  pg8::gemm_phase<pg8::EpiPV, SchedPVown, true, false>(lds, pg8::Dims{256, 1024, 256}, S, E, wv); }
                __syncthreads();
                sample_attn_units<8>(A, lds, c, wv);
            } else {
                sample_attn_units<4>(A, lds, 128 + 2 * (c - 128), wv);
                sample_attn_units<8>(A, lds, 384 + (c - 128), wv);
            }
        } else {
            for (int base = 0; base < 128; base += G) {
                SchedScores S{c + base, (const char*)(ws + O_Q), (const char*)(ws + O_KB)};
                pg8::EpiSoftmax E{(bf16_t*)(ws + O_PR)};
                pg8::gemm_phase<pg8::EpiSoftmax, SchedScores, false, false>(lds, pg8::Dims{D, D, HD}, S, E, wv);
            }
            __syncthreads();
            for (int du = c; du < 256; du += G) sample_attn_units<4>(A, lds, 2 * du, wv);
        }
    }
    SEAM();
    }
    if (G != 256) {
        SchedPV S{G, c, (const char*)(ws + O_PR), (const char*)(ws + O_VT)};
        pg8::EpiPV E{(bf16_t*)(ws + O_ATT)};
        pg8::gemm_phase<pg8::EpiPV, SchedPV, true, false>(lds, pg8::Dims{256, 1024, 256}, S, E, wv);
        SEAM();
    }
    REPEAT(8) {
    {
        SchedGrid S{G, c, MTP, 8, (const char*)(ws + O_ATT), (const char*)(ws + O_WO), (size_t)256 * D * 2, (size_t)256 * D * 2, (const char*)(ws + O_ATT) + (size_t)MP * D * 2, (size_t)16 * D * 2};
        pg8::EpiRes<bf16_t> E{(const bf16_t*)(ws + O_XB), (const bf16_t*)(ws + O_XB) + (size_t)MP * D, nullptr, (bf16_t*)(ws + O_XB), SS2};
        pg8::gemm_phase<pg8::EpiRes<bf16_t>, SchedGrid, true, true>(lds, pg8::Dims{D, D, D}, S, E, wv);
    }
    SEAM();
    }
    REPEAT(9) {
    {
        SchedGrid S{G, c, MTP, 44, (const char*)(ws + O_XB), (const char*)(ws + O_WGU), (size_t)256 * D * 2, (size_t)256 * D * 2, (const char*)(ws + O_XB) + (size_t)MP * D * 2, (size_t)16 * D * 2};
        pg8::EpiGateUp E{(bf16_t*)(ws + O_H), SS2};
        pg8::gemm_phase<pg8::EpiGateUp, SchedGrid, true, true>(lds, pg8::Dims{D, D, D}, S, E, wv);
    }
    SEAM();
    }
    if (G == 256) {
        SchedGrid S{G, c, MTP, 8, (const char*)(ws + O_H), (const char*)(ws + O_WDN), (size_t)256 * FF * 2, (size_t)256 * FF * 2, (const char*)(ws + O_H) + (size_t)MP * FF * 2, (size_t)16 * FF * 2};
        pg8::EpiFinal E{(const bf16_t*)(ws + O_XB), A.out + OUT_Y, SS3, (unsigned*)(ws + O_PCNT), A.in[I_GFINAL]};
        pg8::gemm_phase<pg8::EpiFinal, SchedGrid, false, true>(lds, pg8::Dims{FF, FF, FF}, S, E, wv);
    } else {
        {
            SchedGrid S{G, c, MTP, 8, (const char*)(ws + O_H), (const char*)(ws + O_WDN), (size_t)256 * FF * 2, (size_t)256 * FF * 2, (const char*)(ws + O_H) + (size_t)MP * FF * 2, (size_t)16 * FF * 2};
            pg8::EpiRes<bf16_t> E{(const bf16_t*)(ws + O_XB), (const bf16_t*)(ws + O_XB) + (size_t)MP * D, A.out + OUT_Y, nullptr, SS3};
            pg8::gemm_phase<pg8::EpiRes<bf16_t>, SchedGrid, true, true>(lds, pg8::Dims{FF, FF, FF}, S, E, wv);
        }
        SEAM();
        const float* gf = A.in[I_GFINAL]; const int tid = opaque_tid(wv), lane = tid & 63, wave = wv;
        for (int m = c * 8 + wave; m < M; m += G * 8) {
            const float rs = rsqrtf(SS3[m] * (1.0f / D) + EPS);
            f32x4* row = (f32x4*)(A.out + OUT_Y + (size_t)m * D) + lane; const f32x4* gr = (const f32x4*)gf + lane;
#pragma unroll
            for (int jj = 0; jj < 8; ++jj) row[64 * jj] = row[64 * jj] * rs * gr[64 * jj];
        }
    }
}

extern "C" void kernel_launch(void* const* d_in, const int* in_sizes, int n_in, void* d_out, int out_size, void* d_ws, size_t ws_size, hipStream_t stream) {
    static int grid = 0;
    if (grid == 0) {
        if (n_in != 34 || ws_size < WS_END) { fprintf(stderr, "kernel_launch: unexpected inputs (n_in %d, ws %zu, need %zu)\n", n_in, ws_size, (size_t)WS_END); grid = -1; return; }
        int dev = 0, cus = 0, per_cu = 0;
        hipGetDevice(&dev);
        hipDeviceGetAttribute(&cus, hipDeviceAttributeMultiprocessorCount, dev);
        if (hipFuncSetAttribute((const void*)hymba_fwd, hipFuncAttributeMaxDynamicSharedMemorySize, LDS_BYTES) != hipSuccess) { fprintf(stderr, "kernel_launch: hipFuncSetAttribute failed\n"); grid = -1; return; }
        if (hipOccupancyMaxActiveBlocksPerMultiprocessor(&per_cu, (const void*)hymba_fwd, 512, LDS_BYTES) != hipSuccess || per_cu < 1) { fprintf(stderr, "kernel_launch: occupancy query failed (%d)\n", per_cu); per_cu = 1; }
        (void)hipGetLastError();
        grid = cus * per_cu;
    }
    if (grid < 0) return;
    hipMemsetAsync(d_ws, 0, CTL_BYTES, stream);
    Args a{};
    for (int i = 0; i < 34; ++i) a.in[i] = (const float*)d_in[i];
    a.out = (float*)d_out; a.ws = (unsigned char*)d_ws;
    void* args[] = {&a};
    hipError_t e = hipLaunchCooperativeKernel((const void*)hymba_fwd, dim3(grid), dim3(512), args, LDS_BYTES, stream);
    if (e != hipSuccess) fprintf(stderr, "cooperative launch failed: %s (grid %d)\n", hipGetErrorString(e), grid);
}
```

```cpp
#include <hip/hip_runtime.h>
#include <hip/hip_cooperative_groups.h>
#include <cstdio>
#include <cstdint>
namespace cg = cooperative_groups;

#define LAS __attribute__((address_space(3)))
typedef unsigned short bf16_t;
typedef short bf16x8 __attribute__((ext_vector_type(8)));
typedef float f32x4 __attribute__((ext_vector_type(4)));
typedef float f32x16 __attribute__((ext_vector_type(16)));
typedef unsigned u32x4 __attribute__((ext_vector_type(4)));
typedef unsigned u32x2 __attribute__((ext_vector_type(2)));

constexpr int D = 2048, SEQ = 2048, NB = 4, MP = NB * SEQ, DB = 128, DS = 4, MS = DB * DS, M = MP + MS;
constexpr int PW = 1024, NG = 64, NMEM = 256, NH = 4, HD = 512, FF = 5632, PBUF = 15;
constexpr float EPS = 1e-6f;

constexpr size_t OUT_Y = 0;
constexpr size_t OUT_PBP = (size_t)M * D;
constexpr size_t OUT_REP = OUT_PBP + (size_t)NB * PBUF * PW;
constexpr size_t OUT_IMP = OUT_REP + (size_t)NB * NG * 64;
constexpr size_t OUT_MK = OUT_IMP + (size_t)NB * NG * 64;
constexpr size_t OUT_MV = OUT_MK + (size_t)NB * NMEM * D;
constexpr size_t OUT_PBS = OUT_MV + (size_t)NB * NMEM * D;
constexpr size_t OUT_RES = OUT_PBS + (size_t)DB * PBUF * PW;
constexpr size_t OUT_IMS = OUT_RES + (size_t)DB * NG * 64;

constexpr size_t CTL_BYTES = 256 * 1024;
constexpr size_t O_SS1 = 0, O_SS2 = 64 * 1024, O_SS3 = 128 * 1024, O_BAR = 192 * 1024, O_PCNT = 248 * 1024;
constexpr size_t O_WIN = 1 << 20;
constexpr size_t O_WKV = O_WIN + (size_t)D * D * 2;
constexpr size_t O_WPOOL = O_WKV + (size_t)2 * D * D * 2;
constexpr size_t O_WGLU = O_WPOOL + (size_t)4 * 256 * 256 * 2;
constexpr size_t O_WOUT = O_WGLU + (size_t)1024 * 1024 * 2;
constexpr size_t O_WQ = O_WOUT + (size_t)D * D * 2;
constexpr size_t O_WO = O_WQ + (size_t)D * D * 2;
constexpr size_t O_WGU = O_WO + (size_t)D * D * 2;
constexpr size_t O_WDN = O_WGU + (size_t)2 * FF * D * 2;
constexpr size_t O_TAB = O_WDN + (size_t)D * FF * 2;
constexpr size_t O_ABAR = O_TAB, O_BB = O_ABAR + 64 * 64 * 16, O_CM = O_BB + 64 * 4096;
constexpr size_t O_HMIX = O_CM + 64 * 4096;
constexpr size_t O_MN = O_HMIX + (size_t)M * D * 2;
constexpr size_t O_P = O_MN + (size_t)1024 * D * 2;
constexpr size_t O_POOLED = O_P + (size_t)M * D * 2;
constexpr size_t O_G = O_POOLED + (size_t)M * 1024 * 2;
constexpr size_t O_MIX = O_G + (size_t)M * 1024 * 2;
constexpr size_t O_X1 = O_MIX + (size_t)M * D * 2;
constexpr size_t O_XB = O_X1 + (size_t)M * D * 4;
constexpr size_t O_Q = O_XB + (size_t)M * D * 2;
constexpr size_t O_KB = O_Q + (size_t)M * D * 2;
constexpr size_t O_VT = O_KB + (size_t)1024 * D * 2;
constexpr size_t O_PR = O_VT + (size_t)D * 1024 * 2;
constexpr size_t O_ATT = O_PR + (size_t)16 * 2048 * 256 * 2;
constexpr size_t O_H = O_ATT + (size_t)M * D * 2;
constexpr size_t WS_END = O_H + (size_t)M * FF * 2;

constexpr int RING_BYTES = 131072, LDS_BYTES = 147456;

__device__ __forceinline__ unsigned cvt_pk_bf16(float lo, float hi) { unsigned r; asm volatile("v_cvt_pk_bf16_f32 %0, %1, %2" : "=v"(r) : "v"(lo), "v"(hi)); return r; }
__device__ __forceinline__ float bf_lo(unsigned w) { return __uint_as_float(w << 16); }
__device__ __forceinline__ float bf_hi(unsigned w) { return __uint_as_float(w & 0xffff0000u); }
__device__ __forceinline__ float wave_sum(float v) {
#pragma unroll
    for (int o = 1; o < 64; o <<= 1) v += __shfl_xor(v, o);
    return v;
}
__device__ __forceinline__ float wave_max(float v) {
#pragma unroll
    for (int o = 1; o < 64; o <<= 1) v = fmaxf(v, __shfl_xor(v, o));
    return v;
}
__device__ __forceinline__ float fast_sigmoid(float x) { return __builtin_amdgcn_rcpf(1.0f + __expf(-x)); }
__device__ __forceinline__ float gelu_tanh(float y) { const float t = 1.5957691216f * (y + 0.044715f * y * y * y); return y * fast_sigmoid(t); }
#define LDS_WAIT() asm volatile("s_waitcnt lgkmcnt(0)" ::: "memory")
__device__ __forceinline__ int opaque_tid(int wv) { int t; asm volatile("v_mbcnt_lo_u32_b32 %0, -1, 0\n\tv_mbcnt_hi_u32_b32 %0, -1, %0\n\tv_lshl_add_u32 %0, %1, 6, %0" : "=&v"(t) : "s"(wv)); return t; }

namespace pg8 {
constexpr int BM = 256, BK = 64, HALF = 128, HTB = HALF * BK * 2;
__device__ __forceinline__ int lds_byte(int r, int c) { const int st = (r >> 4) * 2 + (c >> 5), rr = r & 15, cc = c & 31, ob = rr * 64 + cc * 2; return st * 1024 + (ob ^ (((ob >> 9) & 1) << 5)); }
__device__ __forceinline__ void stage_rc(int b, int& R, int& C) { const int st = b / 1024, sb = b % 1024, swz = sb ^ (((sb >> 9) & 1) << 5); R = (st >> 1) * 16 + swz / 64; C = (st & 1) * 32 + (swz % 64) / 2; }
__device__ __forceinline__ int perm32(int rho) { const int n = rho >> 4, i = rho & 15; return 8 * (i >> 2) + 4 * n + (i & 3); }

struct Unit { const char* a; const char* b; const char* s; int pm, pn, job, srow; };
struct Dims { int lda, ldb, K; };

constexpr int SBUF_OFF = 131072;
template <class Epi, class Sched, bool ALIGN_EPI, bool STRIP>
__device__ __forceinline__ void gemm_phase(LAS unsigned char* lds, const Dims g, const Sched& S, const Epi& E, const int wv) {
    const int tid = opaque_tid(wv), wid = __builtin_amdgcn_readfirstlane(tid >> 6), lane = tid & 63, wr = wid >> 2, wc = wid & 3, fr = lane & 15, fq = lane >> 4;
    int nt = g.K / BK; asm volatile("" : "+s"(nt));
    unsigned voffA[2], voffB[2];
#pragma unroll
    for (int i = 0; i < 2; ++i) { int R, C; stage_rc(tid * 16 + i * 8192, R, C); const int Rb = (R & ~31) + perm32(R & 31);
        voffA[i] = (unsigned)(R * g.lda + C) * 2u; voffB[i] = (unsigned)(Rb * g.ldb + C) * 2u; }
    const unsigned voffS = (unsigned)((2 * wid + (lane >> 5)) * g.lda * 2 + (((((lane & 31) >> 2) ^ wid) & 7) * 16) + (lane & 3) * 4);
    const int soff = fr * 128 + ((fq ^ ((fr >> 1) & 7)) * 16);
    const size_t kstep = (size_t)(BK * 2);
    const size_t hstepA = (size_t)HALF * g.lda * 2, hstepB = (size_t)HALF * g.ldb * 2;
    const unsigned ldsw = (unsigned)wid * 1024u;
    const int aoff = lds_byte(wr * 64 + fr, fq * 8), boff = lds_byte(wc * 32 + fr, fq * 8);
#define PG8_SA(b, h) (((b) * 2 + (h)) * HTB)
#define PG8_SB(b, h) ((4 + (b) * 2 + (h)) * HTB)
#define PG8_STAGE(bufoff, gbase, voff) do { _Pragma("unroll") for (int _i = 0; _i < 2; ++_i) \
        __builtin_amdgcn_global_load_lds((const unsigned*)((const char*)(gbase) + (voff)[_i]), (LAS unsigned*)(lds + (bufoff) + ldsw + _i * 8192), 16, 0, 0); } while (0)
#define PG8_STAGE_S(b, gbase) do { if constexpr (STRIP) __builtin_amdgcn_global_load_lds((const unsigned*)((const char*)(gbase) + voffS), (LAS unsigned*)(lds + SBUF_OFF + (b) * 2048 + wid * 256), 4, 0, 0); } while (0)
#define PG8_LDS_S(b) do { if constexpr (STRIP) { As[0] = *(const LAS bf16x8*)(lds + SBUF_OFF + (b) * 2048 + soff); As[1] = *(const LAS bf16x8*)(lds + SBUF_OFF + (b) * 2048 + (soff ^ 64)); } } while (0)
#define PG8_LDA(dst, b, h) do { _Pragma("unroll") for (int m = 0; m < 4; ++m) _Pragma("unroll") for (int k = 0; k < 2; ++k) dst[m][k] = *(const LAS bf16x8*)(lds + PG8_SA(b, h) + aoff + m * 2048 + k * 1024); } while (0)
#define PG8_LDB(dst, b, h) do { _Pragma("unroll") for (int n = 0; n < 2; ++n) _Pragma("unroll") for (int k = 0; k < 2; ++k) dst[n][k] = *(const LAS bf16x8*)(lds + PG8_SB(b, h) + boff + n * 2048 + k * 1024); } while (0)
#define PG8_MMA(ai, bj, At, Bt) do { __builtin_amdgcn_s_setprio(1); _Pragma("unroll") for (int m = 0; m < 4; ++m) _Pragma("unroll") for (int n = 0; n < 2; ++n) _Pragma("unroll") for (int k = 0; k < 2; ++k) \
        acc[ai][bj][m][n] = __builtin_amdgcn_mfma_f32_16x16x32_bf16(Bt[n][k], At[m][k], acc[ai][bj][m][n], 0, 0, 0); __builtin_amdgcn_s_setprio(0); } while (0)
#define PG8_MMA_S() do { if constexpr (STRIP) { __builtin_amdgcn_s_setprio(1); \
        if (wr == 0) { _Pragma("unroll") for (int k = 0; k < 2; ++k) { sacc[0] = __builtin_amdgcn_mfma_f32_16x16x32_bf16(B0[0][k], As[k], sacc[0], 0, 0, 0); sacc[1] = __builtin_amdgcn_mfma_f32_16x16x32_bf16(B1[0][k], As[k], sacc[1], 0, 0, 0); } } \
        else         { _Pragma("unroll") for (int k = 0; k < 2; ++k) { sacc[0] = __builtin_amdgcn_mfma_f32_16x16x32_bf16(B0[1][k], As[k], sacc[0], 0, 0, 0); sacc[1] = __builtin_amdgcn_mfma_f32_16x16x32_bf16(B1[1][k], As[k], sacc[1], 0, 0, 0); } } \
        __builtin_amdgcn_s_setprio(0); } } while (0)
#define PG8_WAIT_V(n) asm volatile("s_waitcnt vmcnt(" #n ")" ::: "memory")
#define PG8_WAIT_VL() do { if constexpr (STRIP) PG8_WAIT_V(9); else PG8_WAIT_V(8); } while (0)
#define PG8_WAIT_L(n) asm volatile("s_waitcnt lgkmcnt(" #n ")" ::: "memory")
#define PG8_BAR __builtin_amdgcn_s_barrier()
#define PG8_SCHED __builtin_amdgcn_sched_barrier(0)
    Unit cur, nxt; int ui = 0;
    if (!S.next(0, cur)) return;
    f32x4 acc[2][2][4][2];
#pragma unroll
    for (int a = 0; a < 2; ++a)
#pragma unroll
        for (int b = 0; b < 2; ++b)
#pragma unroll
            for (int m = 0; m < 4; ++m)
#pragma unroll
                for (int n = 0; n < 2; ++n) acc[a][b][m][n] = (f32x4){0.f, 0.f, 0.f, 0.f};
    f32x4 sacc[2]; sacc[0] = (f32x4){0.f, 0.f, 0.f, 0.f}; sacc[1] = (f32x4){0.f, 0.f, 0.f, 0.f};
    bf16x8 At[4][2], B0[2][2], B1[2][2], As[2];
    const char* cA = cur.a; const char* cB = cur.b; const char* cS = cur.s;
    PG8_STAGE(PG8_SB(0, 0), cB, voffB); PG8_STAGE(PG8_SB(0, 1), cB + hstepB, voffB); PG8_STAGE(PG8_SA(0, 0), cA, voffA); PG8_STAGE_S(0, cS); PG8_STAGE(PG8_SA(0, 1), cA + hstepA, voffA);
    if (wr == 1) PG8_BAR;
    PG8_WAIT_V(2); PG8_BAR;
    PG8_STAGE(PG8_SB(1, 0), cB + kstep, voffB); PG8_STAGE(PG8_SA(1, 0), cA + kstep, voffA); PG8_STAGE(PG8_SB(1, 1), cB + hstepB + kstep, voffB); PG8_STAGE_S(1, cS + kstep);
    if constexpr (STRIP) PG8_WAIT_V(7); else PG8_WAIT_V(6);
    PG8_BAR;
    for (;;) {
        const bool has_next = S.next(ui + 1, nxt);
        const char* nA = has_next ? nxt.a : cA; const char* nB = has_next ? nxt.b : cB; const char* nS = has_next ? nxt.s : cS;
        for (int t = 0; t < nt; t += 2) {
            const bool last = (t == nt - 2);
            const char* a1 = cA + (size_t)(t + 1) * kstep;
            const char* a2 = last ? nA : cA + (size_t)(t + 2) * kstep; const char* b2 = last ? nB : cB + (size_t)(t + 2) * kstep; const char* s2 = last ? nS : cS + (size_t)(t + 2) * kstep;
            const char* a3 = a2 + kstep; const char* b3 = b2 + kstep; const char* s3 = s2 + kstep;
            PG8_LDB(B0, 0, 0); PG8_LDB(B1, 0, 1); PG8_SCHED; PG8_LDA(At, 0, 0); PG8_LDS_S(0); PG8_STAGE(PG8_SA(1, 1), a1 + hstepA, voffA);
            PG8_WAIT_VL(); PG8_WAIT_L(0); PG8_BAR; PG8_MMA(0, 0, At, B0); PG8_MMA(0, 1, At, B1); PG8_MMA_S(); PG8_BAR; PG8_SCHED;
            PG8_LDA(At, 0, 1); PG8_STAGE(PG8_SB(0, 0), b2, voffB); PG8_STAGE(PG8_SB(0, 1), b2 + hstepB, voffB); PG8_STAGE(PG8_SA(0, 0), a2, voffA); PG8_STAGE_S(0, s2);
            PG8_WAIT_VL(); PG8_WAIT_L(0); PG8_BAR; PG8_MMA(1, 0, At, B0); PG8_MMA(1, 1, At, B1); PG8_BAR; PG8_SCHED;
            PG8_LDB(B0, 1, 0); PG8_LDB(B1, 1, 1); PG8_SCHED; PG8_LDA(At, 1, 0); PG8_LDS_S(1); PG8_STAGE(PG8_SA(0, 1), a2 + hstepA, voffA);
            PG8_WAIT_VL(); PG8_WAIT_L(0); PG8_BAR; PG8_MMA(0, 0, At, B0); PG8_MMA(0, 1, At, B1); PG8_MMA_S(); PG8_BAR; PG8_SCHED;
            PG8_LDA(At, 1, 1); PG8_STAGE(PG8_SB(1, 0), b3, voffB); PG8_STAGE(PG8_SB(1, 1), b3 + hstepB, voffB); PG8_STAGE(PG8_SA(1, 0), a3, voffA); PG8_STAGE_S(1, s3);
            PG8_WAIT_VL(); PG8_WAIT_L(0); PG8_BAR; PG8_MMA(1, 0, At, B0); PG8_MMA(1, 1, At, B1); PG8_BAR; PG8_SCHED;
        }
        if constexpr (ALIGN_EPI) { if (wr == 0) PG8_BAR; }
        if constexpr (!Epi::AFTER_DRAIN) { E(acc, cur, wr, wc, fr, fq); if constexpr (STRIP) { if (cur.srow >= 0) E.strip(sacc, cur, wr, wc, fr, fq); } }
        if (!has_next) break;
#pragma unroll
        for (int a = 0; a < 2; ++a)
#pragma unroll
            for (int b = 0; b < 2; ++b)
#pragma unroll
                for (int m = 0; m < 4; ++m)
#pragma unroll
                    for (int n = 0; n < 2; ++n) acc[a][b][m][n] = (f32x4){0.f, 0.f, 0.f, 0.f};
        sacc[0] = (f32x4){0.f, 0.f, 0.f, 0.f}; sacc[1] = (f32x4){0.f, 0.f, 0.f, 0.f};
        cur = nxt; cA = nA; cB = nB; cS = nS; ++ui;
        if constexpr (ALIGN_EPI) { if (wr == 1) PG8_BAR; }
    }
    PG8_WAIT_V(0);
    if constexpr (!ALIGN_EPI) { if (wr == 0) PG8_BAR; }
    PG8_BAR;
    if constexpr (Epi::AFTER_DRAIN) { E.fused(acc, sacc, cur, wr, wc, fr, fq, lds, wid, lane); }
#undef PG8_SA
#undef PG8_SB
#undef PG8_STAGE
#undef PG8_STAGE_S
#undef PG8_LDS_S
#undef PG8_LDA
#undef PG8_LDB
#undef PG8_MMA
#undef PG8_MMA_S
#undef PG8_WAIT_V
#undef PG8_WAIT_VL
#undef PG8_WAIT_L
#undef PG8_BAR
#undef PG8_SCHED
}
typedef f32x4 Acc[2][2][4][2];

__device__ __forceinline__ void st_bf16x8(bf16_t* p, f32x4 v0, f32x4 v1) {
    u32x4 w; w.x = cvt_pk_bf16(v0[0], v0[1]); w.y = cvt_pk_bf16(v0[2], v0[3]); w.z = cvt_pk_bf16(v1[0], v1[1]); w.w = cvt_pk_bf16(v1[2], v1[3]); *(u32x4*)p = w;
}
__device__ __forceinline__ void st_bf16x4(bf16_t* p, f32x4 v) { u32x2 w; w.x = cvt_pk_bf16(v[0], v[1]); w.y = cvt_pk_bf16(v[2], v[3]); *(u32x2*)p = w; }
typedef f32x4 SAcc[2];
struct EpiInKv {
    static constexpr bool AFTER_DRAIN = false;
    bf16_t* P; float* out; bf16_t* KB; bf16_t* VT;
    __device__ __forceinline__ void operator()(const Acc& acc, const Unit& u, int wr, int wc, int fr, int fq) const {
        if (u.job == 0) {
#pragma unroll
            for (int ai = 0; ai < 2; ++ai)
#pragma unroll
                for (int m = 0; m < 4; ++m) {
                    const int row = u.pm * 256 + ai * 128 + wr * 64 + m * 16 + fr;
                    float* pbp = nullptr;
                    if (u.pn < 4) {
                        if (row < MP) { const int t = row & (SEQ - 1); if (t >= SEQ - PBUF) pbp = out + OUT_PBP + ((size_t)(row >> 11) * PBUF + (t - (SEQ - PBUF))) * PW; }
                        else { const int rs = row - MP; pbp = out + OUT_PBS + ((size_t)(rs >> 2) * PBUF + 11 + (rs & 3)) * PW; }
                    }
#pragma unroll
                    for (int bj = 0; bj < 2; ++bj) {
                        const int col = u.pn * 256 + bj * 128 + wc * 32 + 8 * fq;
                        const f32x4 v0 = acc[ai][bj][m][0], v1 = acc[ai][bj][m][1];
                        st_bf16x8(P + (size_t)row * D + col, v0, v1);
                        if (pbp) { *(f32x4*)(pbp + col) = v0; *(f32x4*)(pbp + col + 4) = v1; }
                    }
                }
        } else {
#pragma unroll
            for (int ai = 0; ai < 2; ++ai)
#pragma unroll
                for (int m = 0; m < 4; ++m) {
                    const int row = u.pm * 256 + ai * 128 + wr * 64 + m * 16 + fr;
#pragma unroll
                    for (int bj = 0; bj < 2; ++bj) {
                        const int col = u.pn * 256 + bj * 128 + wc * 32 + 8 * fq;
                        const f32x4 v0 = acc[ai][bj][m][0], v1 = acc[ai][bj][m][1];
                        if (col < D) {
                            float* o = out + OUT_MK + (size_t)row * D + col; *(f32x4*)o = v0; *(f32x4*)(o + 4) = v1;
                            st_bf16x8(KB + (size_t)row * D + col, v0, v1);
                        } else {
                            const int c = col - D;
                            float* o = out + OUT_MV + (size_t)row * D + c; *(f32x4*)o = v0; *(f32x4*)(o + 4) = v1;
#pragma unroll
                            for (int i = 0; i < 4; ++i) { VT[(size_t)(c + i) * 1024 + row] = (bf16_t)(cvt_pk_bf16(v0[i], 0.f) & 0xffffu); VT[(size_t)(c + 4 + i) * 1024 + row] = (bf16_t)(cvt_pk_bf16(v1[i], 0.f) & 0xffffu); }
                        }
                    }
                }
        }
    }
    __device__ __forceinline__ void strip(const SAcc& sacc, const Unit& u, int wr, int wc, int fr, int fq) const {
        const int row = u.srow + fr, rs = row - MP;
        float* pbp = (u.pn < 4) ? out + OUT_PBS + ((size_t)(rs >> 2) * PBUF + 11 + (rs & 3)) * PW : nullptr;
#pragma unroll
        for (int bj = 0; bj < 2; ++bj) {
            const int col = u.pn * 256 + bj * 128 + wc * 32 + 8 * fq + 4 * wr;
            st_bf16x4(P + (size_t)row * D + col, sacc[bj]);
            if (pbp) *(f32x4*)(pbp + col) = sacc[bj];
        }
    }
};
struct EpiPool {
    static constexpr bool AFTER_DRAIN = false;
    bf16_t* MIX; const float* scale;
    __device__ __forceinline__ void operator()(const Acc& acc, const Unit& u, int wr, int wc, int fr, int fq) const {
#pragma unroll
        for (int bj = 0; bj < 2; ++bj) {
            const int col = u.pn * 256 + bj * 128 + wc * 32 + 8 * fq;
            const f32x4 s0 = *(const f32x4*)(scale + col), s1 = *(const f32x4*)(scale + col + 4);
#pragma unroll
            for (int ai = 0; ai < 2; ++ai)
#pragma unroll
                for (int m = 0; m < 4; ++m) {
                    const int row = u.pm * 256 + ai * 128 + wr * 64 + m * 16 + fr;
                    st_bf16x8(MIX + (size_t)row * D + col, acc[ai][bj][m][0] * s0, acc[ai][bj][m][1] * s1);
                }
        }
    }
    __device__ __forceinline__ void strip(const SAcc& sacc, const Unit& u, int wr, int wc, int fr, int fq) const {
        const int row = u.srow + fr;
#pragma unroll
        for (int bj = 0; bj < 2; ++bj) {
            const int col = u.pn * 256 + bj * 128 + wc * 32 + 8 * fq + 4 * wr;
            st_bf16x4(MIX + (size_t)row * D + col, sacc[bj] * *(const f32x4*)(scale + col));
        }
    }
};
struct EpiGlu {
    static constexpr bool AFTER_DRAIN = false;
    bf16_t* MIX; const bf16_t* G; const float* bias;
    __device__ __forceinline__ void operator()(const Acc& acc, const Unit& u, int wr, int wc, int fr, int fq) const {
#pragma unroll
        for (int bj = 0; bj < 2; ++bj) {
            const int col = u.pn * 256 + bj * 128 + wc * 32 + 8 * fq;
            const f32x4 b0 = *(const f32x4*)(bias + col), b1 = *(const f32x4*)(bias + col + 4);
#pragma unroll
            for (int ai = 0; ai < 2; ++ai)
#pragma unroll
                for (int m = 0; m < 4; ++m) {
                    const int row = u.pm * 256 + ai * 128 + wr * 64 + m * 16 + fr;
                    const u32x4 gw = *(const u32x4*)(G + (size_t)row * 1024 + col);
                    const f32x4 x0 = acc[ai][bj][m][0] + b0, x1 = acc[ai][bj][m][1] + b1;
                    f32x4 o0, o1;
                    o0[0] = bf_lo(gw.x) * fast_sigmoid(x0[0]); o0[1] = bf_hi(gw.x) * fast_sigmoid(x0[1]); o0[2] = bf_lo(gw.y) * fast_sigmoid(x0[2]); o0[3] = bf_hi(gw.y) * fast_sigmoid(x0[3]);
                    o1[0] = bf_lo(gw.z) * fast_sigmoid(x1[0]); o1[1] = bf_hi(gw.z) * fast_sigmoid(x1[1]); o1[2] = bf_lo(gw.w) * fast_sigmoid(x1[2]); o1[3] = bf_hi(gw.w) * fast_sigmoid(x1[3]);
                    st_bf16x8(MIX + (size_t)row * D + 1024 + col, o0, o1);
                }
        }
    }
    __device__ __forceinline__ void strip(const SAcc& sacc, const Unit& u, int wr, int wc, int fr, int fq) const {
        const int row = u.srow + fr;
#pragma unroll
        for (int bj = 0; bj < 2; ++bj) {
            const int col = u.pn * 256 + bj * 128 + wc * 32 + 8 * fq + 4 * wr;
            const u32x2 gw = *(const u32x2*)(G + (size_t)row * 1024 + col);
            const f32x4 x = sacc[bj] + *(const f32x4*)(bias + col);
            f32x4 o; o[0] = bf_lo(gw.x) * fast_sigmoid(x[0]); o[1] = bf_hi(gw.x) * fast_sigmoid(x[1]); o[2] = bf_lo(gw.y) * fast_sigmoid(x[2]); o[3] = bf_hi(gw.y) * fast_sigmoid(x[3]);
            st_bf16x4(MIX + (size_t)row * D + 1024 + col, o);
        }
    }
};
__device__ __forceinline__ void ld_res8(const float* p, f32x4& a, f32x4& b) { a = *(const f32x4*)p; b = *(const f32x4*)(p + 4); }
__device__ __forceinline__ void ld_res8(const bf16_t* p, f32x4& a, f32x4& b) { const u32x4 w = *(const u32x4*)p; a = (f32x4){bf_lo(w.x), bf_hi(w.x), bf_lo(w.y), bf_hi(w.y)}; b = (f32x4){bf_lo(w.z), bf_hi(w.z), bf_lo(w.w), bf_hi(w.w)}; }
__device__ __forceinline__ f32x4 ld_res4(const float* p) { return *(const f32x4*)p; }
__device__ __forceinline__ f32x4 ld_res4(const bf16_t* p) { const u32x2 w = *(const u32x2*)p; return (f32x4){bf_lo(w.x), bf_hi(w.x), bf_lo(w.y), bf_hi(w.y)}; }
template <class RT>
struct EpiRes {
    static constexpr bool AFTER_DRAIN = false;
    const RT* xin_p; const RT* xin_s; float* xo; bf16_t* xb; float* ss;
    __device__ __forceinline__ void operator()(const Acc& acc, const Unit& u, int wr, int wc, int fr, int fq) const {
        const RT* xin = xin_p;
#pragma unroll
        for (int ai = 0; ai < 2; ++ai)
#pragma unroll
            for (int m = 0; m < 4; ++m) {
                const int row = u.pm * 256 + ai * 128 + wr * 64 + m * 16 + fr;
                float sq = 0.f;
#pragma unroll
                for (int bj = 0; bj < 2; ++bj) {
                    const int col = u.pn * 256 + bj * 128 + wc * 32 + 8 * fq;
                    const size_t off = (size_t)row * D + col;
                    f32x4 r0, r1; ld_res8(xin + off, r0, r1);
                    const f32x4 v0 = acc[ai][bj][m][0] + r0, v1 = acc[ai][bj][m][1] + r1;
                    if (xo) { *(f32x4*)(xo + off) = v0; *(f32x4*)(xo + off + 4) = v1; }
                    if (xb) st_bf16x8(xb + off, v0, v1);
                    sq += (v0[0] * v0[0] + v0[1] * v0[1]) + (v0[2] * v0[2] + v0[3] * v0[3]) + (v1[0] * v1[0] + v1[1] * v1[1]) + (v1[2] * v1[2] + v1[3] * v1[3]);
                }
                sq += __shfl_xor(sq, 16); sq += __shfl_xor(sq, 32);
                if (fq == 0) atomicAdd(ss + row, sq);
            }
    }
    __device__ __forceinline__ void strip(const SAcc& sacc, const Unit& u, int wr, int wc, int fr, int fq) const {
        const int row = u.srow + fr; const RT* xin = xin_s - (size_t)MP * D;
        float sq = 0.f;
#pragma unroll
        for (int bj = 0; bj < 2; ++bj) {
            const int col = u.pn * 256 + bj * 128 + wc * 32 + 8 * fq + 4 * wr;
            const size_t off = (size_t)row * D + col;
            const f32x4 v = sacc[bj] + ld_res4(xin + off);
            if (xo) *(f32x4*)(xo + off) = v;
            if (xb) st_bf16x4(xb + off, v);
            sq += (v[0] * v[0] + v[1] * v[1]) + (v[2] * v[2] + v[3] * v[3]);
        }
        sq += __shfl_xor(sq, 16); sq += __shfl_xor(sq, 32);
        if (fq == 0) atomicAdd(ss + row, sq);
    }
};
struct EpiFinal {
    static constexpr bool AFTER_DRAIN = true;
    const bf16_t* xin; float* out; float* ss; unsigned* cnt; const float* gf;
    __device__ __forceinline__ void operator()(const Acc&, const Unit&, int, int, int, int) const {}
    __device__ __forceinline__ void fused(Acc& acc, f32x4 (&sacc)[2], const Unit& u, int wr, int wc, int fr, int fq, LAS unsigned char* lds, int wid, int lane) const {
#pragma unroll
        for (int ai = 0; ai < 2; ++ai)
#pragma unroll
            for (int m = 0; m < 4; ++m) {
                const int row = u.pm * 256 + ai * 128 + wr * 64 + m * 16 + fr;
                float sq = 0.f;
#pragma unroll
                for (int bj = 0; bj < 2; ++bj) {
                    const size_t off = (size_t)row * D + u.pn * 256 + bj * 128 + wc * 32 + 8 * fq;
                    f32x4 r0, r1; ld_res8(xin + off, r0, r1);
                    const f32x4 v0 = acc[ai][bj][m][0] + r0, v1 = acc[ai][bj][m][1] + r1; acc[ai][bj][m][0] = v0; acc[ai][bj][m][1] = v1;
                    sq += (v0[0] * v0[0] + v0[1] * v0[1]) + (v0[2] * v0[2] + v0[3] * v0[3]) + (v1[0] * v1[0] + v1[1] * v1[1]) + (v1[2] * v1[2] + v1[3] * v1[3]);
                }
                sq += __shfl_xor(sq, 16); sq += __shfl_xor(sq, 32);
                if (fq == 0) { const float old = atomicAdd(ss + row, sq); asm volatile("" :: "v"(old)); }
            }
        const int srow = u.srow + fr;
        {
            float sq = 0.f;
#pragma unroll
            for (int bj = 0; bj < 2; ++bj) {
                const size_t off = (size_t)srow * D + u.pn * 256 + bj * 128 + wc * 32 + 8 * fq + 4 * wr;
                const f32x4 v = sacc[bj] + ld_res4(xin + off); sacc[bj] = v;
                sq += (v[0] * v[0] + v[1] * v[1]) + (v[2] * v[2] + v[3] * v[3]);
            }
            sq += __shfl_xor(sq, 16); sq += __shfl_xor(sq, 32);
            if (fq == 0) { const float old = atomicAdd(ss + srow, sq); asm volatile("" :: "v"(old)); }
        }
        asm volatile("s_waitcnt vmcnt(0)" ::: "memory");
        __builtin_amdgcn_s_barrier();
        if (wid == 0 && lane == 0) {
            unsigned* cw = cnt + 64 * u.pm;
            __hip_atomic_fetch_add(cw, 1u, __ATOMIC_RELEASE, __HIP_MEMORY_SCOPE_AGENT);
            unsigned sp = 0;
            while (__hip_atomic_load(cw, __ATOMIC_RELAXED, __HIP_MEMORY_SCOPE_AGENT) < 8u) { __builtin_amdgcn_s_sleep(1); if (++sp > (1u << 22)) break; }
            __builtin_amdgcn_fence(__ATOMIC_ACQUIRE, "agent");
            asm volatile("s_waitcnt vmcnt(0)" ::: "memory");
        }
        __builtin_amdgcn_s_barrier(); asm volatile("" ::: "memory");
        f32x4 g0[2], g1[2];
#pragma unroll
        for (int bj = 0; bj < 2; ++bj) { const int col = u.pn * 256 + bj * 128 + wc * 32 + 8 * fq; g0[bj] = *(const f32x4*)(gf + col); g1[bj] = *(const f32x4*)(gf + col + 4); }
#pragma unroll
        for (int ai = 0; ai < 2; ++ai)
#pragma unroll
            for (int m = 0; m < 4; ++m) {
                const int row = u.pm * 256 + ai * 128 + wr * 64 + m * 16 + fr;
                const float rs = rsqrtf(__hip_atomic_load(ss + row, __ATOMIC_RELAXED, __HIP_MEMORY_SCOPE_AGENT) * (1.0f / D) + EPS);
#pragma unroll
                for (int bj = 0; bj < 2; ++bj) {
                    const size_t off = (size_t)row * D + u.pn * 256 + bj * 128 + wc * 32 + 8 * fq;
                    *(f32x4*)(out + off) = acc[ai][bj][m][0] * rs * g0[bj]; *(f32x4*)(out + off + 4) = acc[ai][bj][m][1] * rs * g1[bj];
                }
            }
        {
            const float rs = rsqrtf(__hip_atomic_load(ss + srow, __ATOMIC_RELAXED, __HIP_MEMORY_SCOPE_AGENT) * (1.0f / D) + EPS);
#pragma unroll
            for (int bj = 0; bj < 2; ++bj) {
                const int col = u.pn * 256 + bj * 128 + wc * 32 + 8 * fq + 4 * wr;
                *(f32x4*)(out + (size_t)srow * D + col) = sacc[bj] * rs * *(const f32x4*)(gf + col);
            }
        }
    }
};
struct EpiQ {
    static constexpr bool AFTER_DRAIN = false;
    bf16_t* Q; const float* ss;
    __device__ __forceinline__ void operator()(const Acc& acc, const Unit& u, int wr, int wc, int fr, int fq) const {
#pragma unroll
        for (int ai = 0; ai < 2; ++ai)
#pragma unroll
            for (int m = 0; m < 4; ++m) {
                const int row = u.pm * 256 + ai * 128 + wr * 64 + m * 16 + fr;
                const float rs = rsqrtf(ss[row] * (1.0f / D) + EPS);
#pragma unroll
                for (int bj = 0; bj < 2; ++bj) {
                    const int col = u.pn * 256 + bj * 128 + wc * 32 + 8 * fq;
                    st_bf16x8(Q + (size_t)row * D + col, acc[ai][bj][m][0] * rs, acc[ai][bj][m][1] * rs);
                }
            }
    }
    __device__ __forceinline__ void strip(const SAcc& sacc, const Unit& u, int wr, int wc, int fr, int fq) const {
        const int row = u.srow + fr; const float rs = rsqrtf(ss[row] * (1.0f / D) + EPS);
#pragma unroll
        for (int bj = 0; bj < 2; ++bj) st_bf16x4(Q + (size_t)row * D + u.pn * 256 + bj * 128 + wc * 32 + 8 * fq + 4 * wr, sacc[bj] * rs);
    }
};
struct EpiGateUp {
    static constexpr bool AFTER_DRAIN = false;
    bf16_t* H; const float* ss;
    __device__ __forceinline__ void operator()(const Acc& acc, const Unit& u, int wr, int wc, int fr, int fq) const {
        const int col = u.pn * 128 + wc * 32 + 8 * fq;
#pragma unroll
        for (int ai = 0; ai < 2; ++ai)
#pragma unroll
            for (int m = 0; m < 4; ++m) {
                const int row = u.pm * 256 + ai * 128 + wr * 64 + m * 16 + fr;
                const float rs = rsqrtf(ss[row] * (1.0f / D) + EPS);
                f32x4 o[2];
#pragma unroll
                for (int n = 0; n < 2; ++n)
#pragma unroll
                    for (int j = 0; j < 4; ++j) { const float gt = acc[ai][0][m][n][j] * rs, up = acc[ai][1][m][n][j] * rs; o[n][j] = gt * fast_sigmoid(gt) * up; }
                st_bf16x8(H + (size_t)row * FF + col, o[0], o[1]);
            }
    }
    __device__ __forceinline__ void strip(const SAcc& sacc, const Unit& u, int wr, int wc, int fr, int fq) const {
        const int row = u.srow + fr; const float rs = rsqrtf(ss[row] * (1.0f / D) + EPS);
        f32x4 o;
#pragma unroll
        for (int j = 0; j < 4; ++j) { const float gt = sacc[0][j] * rs, up = sacc[1][j] * rs; o[j] = gt * fast_sigmoid(gt) * up; }
        st_bf16x4(H + (size_t)row * FF + u.pn * 128 + wc * 32 + 8 * fq + 4 * wr, o);
    }
};
struct EpiPV {
    static constexpr bool AFTER_DRAIN = false;
    bf16_t* ATT;
    __device__ __forceinline__ void operator()(const Acc& acc, const Unit& u, int wr, int wc, int fr, int fq) const {
#pragma unroll
        for (int ai = 0; ai < 2; ++ai)
#pragma unroll
            for (int m = 0; m < 4; ++m) {
                const int row = u.pm * 256 + ai * 128 + wr * 64 + m * 16 + fr;
#pragma unroll
                for (int bj = 0; bj < 2; ++bj) {
                    const int col = u.pn * 256 + bj * 128 + wc * 32 + 8 * fq;
                    st_bf16x8(ATT + (size_t)row * D + col, acc[ai][bj][m][0], acc[ai][bj][m][1]);
                }
            }
    }
};
struct EpiSoftmax {
    static constexpr bool AFTER_DRAIN = true;
    bf16_t* PR;
    __device__ __forceinline__ void operator()(const Acc&, const Unit&, int, int, int, int) const {}
    __device__ __forceinline__ void fused(Acc& acc, f32x4 (&)[2], const Unit& u, int wr, int wc, int fr, int fq, LAS unsigned char* lds, int wid, int lane) const {
        LAS float* MX = (LAS float*)lds;
        LAS float* SM = (LAS float*)(lds + 4096);
#pragma unroll
        for (int ai = 0; ai < 2; ++ai)
#pragma unroll
            for (int m = 0; m < 4; ++m) {
                float mx = -3.0e38f;
#pragma unroll
                for (int bj = 0; bj < 2; ++bj)
#pragma unroll
                    for (int n = 0; n < 2; ++n)
#pragma unroll
                        for (int j = 0; j < 4; ++j) mx = fmaxf(mx, acc[ai][bj][m][n][j]);
                mx = fmaxf(mx, __shfl_xor(mx, 16)); mx = fmaxf(mx, __shfl_xor(mx, 32));
                if (fq == 0) MX[(ai * 128 + wr * 64 + m * 16 + fr) * 4 + wc] = mx;
            }
        LDS_WAIT(); __builtin_amdgcn_s_barrier(); asm volatile("" ::: "memory");
#pragma unroll
        for (int ai = 0; ai < 2; ++ai)
#pragma unroll
            for (int m = 0; m < 4; ++m) {
                const int r = ai * 128 + wr * 64 + m * 16 + fr;
                const f32x4 mv = *(const LAS f32x4*)(MX + r * 4);
                const float mx = fmaxf(fmaxf(mv[0], mv[1]), fmaxf(mv[2], mv[3]));
                float sm = 0.f;
#pragma unroll
                for (int bj = 0; bj < 2; ++bj)
#pragma unroll
                    for (int n = 0; n < 2; ++n)
#pragma unroll
                        for (int j = 0; j < 4; ++j) { const float e = __expf(acc[ai][bj][m][n][j] - mx); acc[ai][bj][m][n][j] = e; sm += e; }
                sm += __shfl_xor(sm, 16); sm += __shfl_xor(sm, 32);
                if (fq == 0) SM[r * 4 + wc] = sm;
            }
        LDS_WAIT(); __builtin_amdgcn_s_barrier(); asm volatile("" ::: "memory");
#pragma unroll
        for (int ai = 0; ai < 2; ++ai)
#pragma unroll
            for (int m = 0; m < 4; ++m) {
                const int r = ai * 128 + wr * 64 + m * 16 + fr;
                const f32x4 sv = *(const LAS f32x4*)(SM + r * 4);
                const float inv = __builtin_amdgcn_rcpf((sv[0] + sv[1]) + (sv[2] + sv[3]));
#pragma unroll
                for (int bj = 0; bj < 2; ++bj) {
                    const int col = bj * 128 + wc * 32 + 8 * fq;
                    st_bf16x8(PR + ((size_t)u.job * SEQ + u.pm * 256 + r) * 256 + col, acc[ai][bj][m][0] * inv, acc[ai][bj][m][1] * inv);
                }
            }
        LDS_WAIT(); __builtin_amdgcn_s_barrier(); asm volatile("" ::: "memory");
    }
};
}
using pg8::Unit;

enum { I_XP = 0, I_XS = 1, I_MEM = 2, I_PBUF = 3, I_SRE = 4, I_SIM = 5, I_CK = 6, I_CV = 7, I_GMIX = 8, I_WIN = 9, I_WPOOL = 10, I_PSCALE = 11,
       I_LRE = 12, I_LIM = 13, I_LSTEP = 14, I_BRE = 15, I_BIM = 16, I_CRE = 17, I_CIM = 18, I_SSMD = 19, I_WGLU = 20, I_BGLU = 21, I_WOUT = 22,
       I_GCROSS = 23, I_GMEM = 24, I_WQ = 25, I_WK = 26, I_WV = 27, I_WO = 28, I_GFFN = 29, I_WGATE = 30, I_WUP = 31, I_WDOWN = 32, I_GFINAL = 33 };
struct Args {
    const float* in[34];
    float* out; unsigned char* ws;
};

struct CvItem { const float* src; bf16_t* dst; const float* gk; float sc; int N, ldt; };
__device__ __forceinline__ void cv_load(const CvItem& it, f32x4 (&v)[8], float (&g)[8], int lane) {
#pragma unroll
    for (int i = 0; i < 8; ++i) { const int kk = (lane >> 3) + 8 * i; v[i] = *(const f32x4*)(it.src + (size_t)kk * it.N + 4 * (lane & 7)); g[i] = it.gk ? it.gk[kk] : 1.0f; }
}
__device__ __forceinline__ void cv_finish(const CvItem& it, const f32x4 (&v)[8], const float (&g)[8], LAS float* scr, int lane) {
#pragma unroll
    for (int i = 0; i < 8; ++i) { const int kk = (lane >> 3) + 8 * i; const float m = g[i] * it.sc; LAS float* d = scr + kk * 33 + 4 * (lane & 7);
        d[0] = v[i][0] * m; d[1] = v[i][1] * m; d[2] = v[i][2] * m; d[3] = v[i][3] * m; }
    LDS_WAIT(); __builtin_amdgcn_wave_barrier();
    const int c = lane & 7;
#pragma unroll
    for (int j = 0; j < 4; ++j) { const int n = (lane >> 3) + 8 * j; const LAS float* q = scr + (8 * c) * 33 + n;
        u32x4 o; o.x = cvt_pk_bf16(q[0 * 33], q[1 * 33]); o.y = cvt_pk_bf16(q[2 * 33], q[3 * 33]); o.z = cvt_pk_bf16(q[4 * 33], q[5 * 33]); o.w = cvt_pk_bf16(q[6 * 33], q[7 * 33]);
        *(u32x4*)(it.dst + (size_t)n * it.ldt + 8 * c) = o; }
    LDS_WAIT(); __builtin_amdgcn_wave_barrier();
}
__device__ __forceinline__ void rms_row_to_bf16(const float* xrow, const float* g, bf16_t* orow, int lane) {
    const f32x4* xr = (const f32x4*)xrow + lane; const f32x4* gr = (const f32x4*)g + lane;
    f32x4 v[8]; float s = 0.f;
#pragma unroll
    for (int j = 0; j < 8; ++j) { v[j] = xr[64 * j]; s += (v[j][0] * v[j][0] + v[j][1] * v[j][1]) + (v[j][2] * v[j][2] + v[j][3] * v[j][3]); }
    const float rstd = rsqrtf(wave_sum(s) * (1.0f / D) + EPS);
    u32x2* o8 = (u32x2*)orow + lane;
#pragma unroll
    for (int j = 0; j < 8; ++j) { const f32x4 gg = gr[64 * j]; u32x2 w; w.x = cvt_pk_bf16(v[j][0] * rstd * gg[0], v[j][1] * rstd * gg[1]); w.y = cvt_pk_bf16(v[j][2] * rstd * gg[2], v[j][3] * rstd * gg[3]); o8[64 * j] = w; }
}
__device__ __forceinline__ void cmul(float ar, float ai, float br, float bi, float& cr, float& ci) { cr = ar * br - ai * bi; ci = ar * bi + ai * br; }

__device__ __forceinline__ void ssm_chan(const float* lam_re, const float* lam_im, float delta, int g, int ch, float& ar, float& ai, float& kr, float& ki) {
    const float lr = lam_re[g * 64 + ch], li = lam_im[g * 64 + ch];
    const float mag = expf(lr * delta);
    double rev = (double)li * (double)delta * 0.15915494309189535; rev -= __builtin_rint(rev);
    const float rv = (float)rev;
    ar = mag * __builtin_amdgcn_cosf(rv); ai = mag * __builtin_amdgcn_sinf(rv);
    const float nr = ar - 1.0f, ni = ai, den = 1.0f / (lr * lr + li * li);
    kr = (nr * lr + ni * li) * den; ki = (ni * lr - nr * li) * den;
}

__device__ __forceinline__ void ssm_tables(const Args& A, int g, int lane) {
    const float* lam_re = A.in[I_LRE]; const float* lam_im = A.in[I_LIM]; const float* log_step = A.in[I_LSTEP];
    const float* b_re = A.in[I_BRE]; const float* b_im = A.in[I_BIM]; const float* c_re = A.in[I_CRE]; const float* c_im = A.in[I_CIM];
    float* ABAR = (float*)(A.ws + O_ABAR); bf16_t* BB = (bf16_t*)(A.ws + O_BB); bf16_t* CM = (bf16_t*)(A.ws + O_CM);
    const float delta = expf(log_step[g]);
    {
        float ar, ai, kr, ki; ssm_chan(lam_re, lam_im, delta, g, lane, ar, ai, kr, ki);
        float pr = ar, pi = ai;
#pragma unroll
        for (int s = 0; s < 7; ++s) { float tr, ti; cmul(pr, pi, pr, pi, tr, ti); pr = tr; pi = ti; }
        *(f32x4*)(ABAR + ((size_t)g * 64 + lane) * 4) = (f32x4){ar, ai, pr, pi};
    }
    {
        const int j = lane & 31, hi = lane >> 5;
#pragma unroll
        for (int half = 0; half < 2; ++half) {
            const int ch = j + 32 * half; float ar, ai, kr, ki; ssm_chan(lam_re, lam_im, delta, g, ch, ar, ai, kr, ki);
            float vr[8], vi[8];
#pragma unroll
            for (int i = 0; i < 8; ++i) { const int c = 8 * hi + i; const float br = b_re[((size_t)g * 64 + ch) * 16 + c], bi = b_im[((size_t)g * 64 + ch) * 16 + c]; cmul(kr, ki, br, bi, vr[i], vi[i]); }
            u32x4 wr_, wi_;
            wr_.x = cvt_pk_bf16(vr[0], vr[1]); wr_.y = cvt_pk_bf16(vr[2], vr[3]); wr_.z = cvt_pk_bf16(vr[4], vr[5]); wr_.w = cvt_pk_bf16(vr[6], vr[7]);
            wi_.x = cvt_pk_bf16(vi[0], vi[1]); wi_.y = cvt_pk_bf16(vi[2], vi[3]); wi_.z = cvt_pk_bf16(vi[4], vi[5]); wi_.w = cvt_pk_bf16(vi[6], vi[7]);
            *(u32x4*)(BB + (((size_t)g * 4 + half) * 64 + lane) * 8) = wr_;
            *(u32x4*)(BB + (((size_t)g * 4 + 2 + half) * 64 + lane) * 8) = wi_;
        }
    }
    {
        const int c = lane & 15, fq = lane >> 4;
#pragma unroll
        for (int ks = 0; ks < 4; ++ks) {
            float v[8];
#pragma unroll
            for (int i = 0; i < 8; ++i) { const int k = 32 * ks + 8 * fq + i, jj = k >> 2, sel = k & 3, ch = jj + 32 * (sel >> 1);
                v[i] = (sel & 1) ? -c_im[((size_t)g * 16 + c) * 64 + ch] : c_re[((size_t)g * 16 + c) * 64 + ch]; }
            u32x4 w; w.x = cvt_pk_bf16(v[0], v[1]); w.y = cvt_pk_bf16(v[2], v[3]); w.z = cvt_pk_bf16(v[4], v[5]); w.w = cvt_pk_bf16(v[6], v[7]);
            *(u32x4*)(CM + (((size_t)g * 4 + ks) * 64 + lane) * 8) = w;
        }
    }
}

constexpr int I_SQ = (D / 64) * (D / 32);
constexpr int I_POOL = 4 * (256 / 64) * (256 / 32);
constexpr int I_GLU = (1024 / 64) * (1024 / 32);
constexpr int I_FF = (D / 64) * (FF / 32);
constexpr int I_DN = (FF / 64) * (D / 32);
constexpr int NITEMS = 6 * I_SQ + I_POOL + I_GLU + 2 * I_FF + I_DN, NEARLY = 3 * I_SQ;
__device__ __forceinline__ CvItem cv_decode(const Args& A, int r) {
    unsigned char* ws = A.ws; CvItem it; it.gk = nullptr; it.sc = 1.f;
    const float* W; bf16_t* WT; int N, ldt, k0, n0, row0; const float* gkb = nullptr;
    if (r < 6 * I_SQ) {
        const int mtx = r / I_SQ; r -= mtx * I_SQ; const int kb = r / (D / 32), nb = r % (D / 32);
        N = D; ldt = D; k0 = 64 * kb; n0 = 32 * nb; row0 = n0;
        switch (mtx) {
            case 0: W = A.in[I_WIN]; WT = (bf16_t*)(ws + O_WIN); break;
            case 1: W = A.in[I_WK]; WT = (bf16_t*)(ws + O_WKV); break;
            case 2: W = A.in[I_WV]; WT = (bf16_t*)(ws + O_WKV); row0 += D; break;
            case 3: W = A.in[I_WOUT]; WT = (bf16_t*)(ws + O_WOUT); break;
            case 4: W = A.in[I_WQ]; WT = (bf16_t*)(ws + O_WQ); gkb = A.in[I_GCROSS]; it.sc = 0.04419417382415922f; break;
            default: W = A.in[I_WO]; WT = (bf16_t*)(ws + O_WO); break;
        }
    } else if ((r -= 6 * I_SQ) < I_POOL) {
        const int gg = r / 32, q = r % 32, kb = q / 8, nb = q % 8;
        W = A.in[I_WPOOL] + (size_t)gg * 65536; WT = (bf16_t*)(ws + O_WPOOL); N = 256; ldt = 256; k0 = 64 * kb; n0 = 32 * nb; row0 = gg * 256 + n0;
    } else if ((r -= I_POOL) < I_GLU) {
        const int kb = r / 32, nb = r % 32; W = A.in[I_WGLU]; WT = (bf16_t*)(ws + O_WGLU); N = 1024; ldt = 1024; k0 = 64 * kb; n0 = 32 * nb; row0 = n0;
    } else if ((r -= I_GLU) < 2 * I_FF) {
        const int up = r / I_FF; r -= up * I_FF; const int kb = r / (FF / 32), nb = r % (FF / 32);
        W = up ? A.in[I_WUP] : A.in[I_WGATE]; WT = (bf16_t*)(ws + O_WGU); N = FF; ldt = D; k0 = 64 * kb; n0 = 32 * nb; row0 = (n0 >> 7) * 256 + up * 128 + (n0 & 127); gkb = A.in[I_GFFN];
    } else {
        r -= 2 * I_FF; const int kb = r / (D / 32), nb = r % (D / 32);
        W = A.in[I_WDOWN]; WT = (bf16_t*)(ws + O_WDN); N = D; ldt = FF; k0 = 64 * kb; n0 = 32 * nb; row0 = n0;
    }
    it.src = W + (size_t)k0 * N + n0; it.dst = WT + (size_t)row0 * ldt + k0; it.gk = gkb ? gkb + k0 : nullptr; it.N = N; it.ldt = ldt;
    return it;
}
__device__ __forceinline__ void convert_weights(const Args& A, LAS unsigned char* lds, int lo, int hi, int gw, int NGW, const int wv) {
    const int tid = opaque_tid(wv), lane = tid & 63, wave = __builtin_amdgcn_readfirstlane(tid >> 6);
    LAS float* scr = (LAS float*)(lds + wave * 16384);
    if (gw < 0) return;
    int it = lo + gw; if (it >= hi) return;
    CvItem cur = cv_decode(A, it); f32x4 va[8]; float ga[8]; cv_load(cur, va, ga, lane);
    for (;;) {
        const int nit = it + NGW; const bool hn = nit < hi;
        CvItem nx = cur; f32x4 vb[8]; float gb[8];
        if (hn) { nx = cv_decode(A, nit); cv_load(nx, vb, gb, lane); }
        cv_finish(cur, va, ga, scr, lane);
        if (!hn) break;
        cur = nx; it = nit;
#pragma unroll
        for (int i = 0; i < 8; ++i) { va[i] = vb[i]; ga[i] = gb[i]; }
    }
}
__device__ __forceinline__ void phase0_rest(const Args& A, int G, const int wv) {
    const int tid = opaque_tid(wv), lane = tid & 63, wave = __builtin_amdgcn_readfirstlane(tid >> 6);
    const int gw = blockIdx.x * 8 + wave, NGW = G * 8;
    unsigned char* ws = A.ws;
    for (int m = gw; m < M + 1024; m += NGW) {
        if (m < MP) rms_row_to_bf16(A.in[I_XP] + (size_t)m * D, A.in[I_GMIX], (bf16_t*)(ws + O_HMIX) + (size_t)m * D, lane);
        else if (m < M) rms_row_to_bf16(A.in[I_XS] + (size_t)(m - MP) * D, A.in[I_GMIX], (bf16_t*)(ws + O_HMIX) + (size_t)m * D, lane);
        else rms_row_to_bf16(A.in[I_MEM] + (size_t)(m - M) * D, A.in[I_GMEM], (bf16_t*)(ws + O_MN) + (size_t)(m - M) * D, lane);
    }
    for (int g = gw; g < NG; g += NGW) ssm_tables(A, g, lane);
    {
        const f32x4* src = (const f32x4*)A.in[I_PBUF]; f32x4* dst = (f32x4*)(A.out + OUT_PBS);
        const int total = DB * 11 * (PW / 4);
        for (int i = blockIdx.x * 512 + tid; i < total; i += G * 512) { const int b = i / (11 * 256), r = i % (11 * 256); dst[(size_t)b * (15 * 256) + r] = src[(size_t)b * (15 * 256) + 4 * 256 + r]; }
    }
}

__device__ __forceinline__ void acc8(float (&s)[8], u32x4 w) {
    s[0] += bf_lo(w.x); s[1] += bf_hi(w.x); s[2] += bf_lo(w.y); s[3] += bf_hi(w.y); s[4] += bf_lo(w.z); s[5] += bf_hi(w.z); s[6] += bf_lo(w.w); s[7] += bf_hi(w.w);
}
template <int W>
__device__ __forceinline__ void pooled_prompt_item(const bf16_t* P, bf16_t* PO, int row0, int col) {
    const int t0 = row0 & (SEQ - 1);
    u32x4 z[W + 7];
#pragma unroll
    for (int i = 0; i < W + 7; ++i) {
        const int t = t0 - (W - 1) + i;
        z[i] = (u32x4){0u, 0u, 0u, 0u};
        if (t >= 0) z[i] = *(const u32x4*)(P + (size_t)(row0 - (W - 1) + i) * D + col);
    }
    float s[8] = {0.f, 0.f, 0.f, 0.f, 0.f, 0.f, 0.f, 0.f};
#pragma unroll
    for (int i = 0; i < W - 1; ++i) acc8(s, z[i]);
#pragma unroll
    for (int o = 0; o < 8; ++o) {
        const u32x4 uw = z[o + W - 1];
        acc8(s, uw);
        const int n = (t0 + o + 1 < W) ? t0 + o + 1 : W; const float ic = 1.0f / (float)n;
        u32x4 ow;
        ow.x = cvt_pk_bf16(s[0] * ic - bf_lo(uw.x), s[1] * ic - bf_hi(uw.x)); ow.y = cvt_pk_bf16(s[2] * ic - bf_lo(uw.y), s[3] * ic - bf_hi(uw.y));
        ow.z = cvt_pk_bf16(s[4] * ic - bf_lo(uw.z), s[5] * ic - bf_hi(uw.z)); ow.w = cvt_pk_bf16(s[6] * ic - bf_lo(uw.w), s[7] * ic - bf_hi(uw.w));
        *(u32x4*)(PO + (size_t)(row0 + o) * 1024 + col) = ow;
        const u32x4 zo = z[o];
        s[0] -= bf_lo(zo.x); s[1] -= bf_hi(zo.x); s[2] -= bf_lo(zo.y); s[3] -= bf_hi(zo.y); s[4] -= bf_lo(zo.z); s[5] -= bf_hi(zo.z); s[6] -= bf_lo(zo.w); s[7] -= bf_hi(zo.w);
    }
}
template <int W>
__device__ __forceinline__ void pooled_sample_item(const bf16_t* P, bf16_t* PO, const float* sbuf, int b, int col) {
    float h[W - 1][8];
#pragma unroll
    for (int i = 0; i < W - 1; ++i) { const float* q = sbuf + ((size_t)b * PBUF + (PBUF - (W - 1) + i)) * PW + col; const f32x4 a = *(const f32x4*)q, c = *(const f32x4*)(q + 4);
        h[i][0] = a[0]; h[i][1] = a[1]; h[i][2] = a[2]; h[i][3] = a[3]; h[i][4] = c[0]; h[i][5] = c[1]; h[i][6] = c[2]; h[i][7] = c[3]; }
    u32x4 z[4];
#pragma unroll
    for (int t = 0; t < 4; ++t) z[t] = *(const u32x4*)(P + ((size_t)MP + b * 4 + t) * D + col);
    float s[8] = {0.f, 0.f, 0.f, 0.f, 0.f, 0.f, 0.f, 0.f};
#pragma unroll
    for (int i = 0; i < W - 1; ++i)
#pragma unroll
        for (int j = 0; j < 8; ++j) s[j] += h[i][j];
    const float ic = 1.0f / (float)W;
#pragma unroll
    for (int t = 0; t < 4; ++t) {
        const u32x4 uw = z[t];
        acc8(s, uw);
        u32x4 o;
        o.x = cvt_pk_bf16(s[0] * ic - bf_lo(uw.x), s[1] * ic - bf_hi(uw.x)); o.y = cvt_pk_bf16(s[2] * ic - bf_lo(uw.y), s[3] * ic - bf_hi(uw.y));
        o.z = cvt_pk_bf16(s[4] * ic - bf_lo(uw.z), s[5] * ic - bf_hi(uw.z)); o.w = cvt_pk_bf16(s[6] * ic - bf_lo(uw.w), s[7] * ic - bf_hi(uw.w));
        *(u32x4*)(PO + ((size_t)MP + b * 4 + t) * 1024 + col) = o;
        if (t < W - 1) {
#pragma unroll
            for (int j = 0; j < 8; ++j) s[j] -= h[t < W - 1 ? t : 0][j];
        } else {
            const u32x4 zo = z[t - (W - 1) >= 0 ? t - (W - 1) : 0];
            s[0] -= bf_lo(zo.x); s[1] -= bf_hi(zo.x); s[2] -= bf_lo(zo.y); s[3] -= bf_hi(zo.y); s[4] -= bf_lo(zo.z); s[5] -= bf_hi(zo.z); s[6] -= bf_lo(zo.w); s[7] -= bf_hi(zo.w);
        }
    }
}
__device__ __forceinline__ void pooled_phase(const Args& A, int G, const int wv) {
    const bf16_t* P = (const bf16_t*)(A.ws + O_P); bf16_t* PO = (bf16_t*)(A.ws + O_POOLED); const float* sbuf = A.in[I_PBUF];
    const int tid0 = blockIdx.x * 512 + opaque_tid(wv);
    for (int it = tid0; it < 4 * 1024 * 32; it += G * 512) {
        const int g = it >> 15, rb = (it >> 5) & 1023, col = g * 256 + (it & 31) * 8, row0 = rb * 8;
        if (g == 0) pooled_prompt_item<2>(P, PO, row0, col); else if (g == 1) pooled_prompt_item<4>(P, PO, row0, col);
        else if (g == 2) pooled_prompt_item<8>(P, PO, row0, col); else pooled_prompt_item<16>(P, PO, row0, col);
    }
    for (int it = tid0; it < 4 * DB * 32; it += G * 512) {
        const int g = it >> 12, b = (it >> 5) & (DB - 1), col = g * 256 + (it & 31) * 8;
        if (g == 0) pooled_sample_item<2>(P, PO, sbuf, b, col); else if (g == 1) pooled_sample_item<4>(P, PO, sbuf, b, col);
        else if (g == 2) pooled_sample_item<8>(P, PO, sbuf, b, col); else pooled_sample_item<16>(P, PO, sbuf, b, col);
    }
}

struct SsmCtx {
    bf16x8 BB[4], CMf[4];
    float a[4];
    float dsk[4];
    float s[4];
};
template <int MODE>
__device__ __forceinline__ void ssm_sub(SsmCtx& cx, const bf16_t* P, bf16_t* Gout, int g, const bf16x8 af  ,
                                        const size_t (&yrow)[2]  , LAS unsigned char* tile, int lane,
                                        const float* h_re, const float* h_im, float* o_re, float* o_im, int sbatch0  ) {
    const int j = lane & 31, hi = lane >> 5, fr = lane & 15, fq = lane >> 4;
    u32x2 uwp[2] = {(u32x2){0u, 0u}, (u32x2){0u, 0u}};
    if (MODE != 0) { uwp[0] = *(const u32x2*)(P + yrow[0] * D + 1024 + 16 * g + 4 * fq); uwp[1] = *(const u32x2*)(P + yrow[1] * D + 1024 + 16 * g + 4 * fq); }
    const f32x16 z = {0.f, 0.f, 0.f, 0.f, 0.f, 0.f, 0.f, 0.f, 0.f, 0.f, 0.f, 0.f, 0.f, 0.f, 0.f, 0.f};
    const f32x16 r0 = __builtin_amdgcn_mfma_f32_32x32x16_bf16(af, cx.BB[0], z, 0, 0, 0);
    const f32x16 r1 = __builtin_amdgcn_mfma_f32_32x32x16_bf16(af, cx.BB[1], z, 0, 0, 0);
    const f32x16 i0 = __builtin_amdgcn_mfma_f32_32x32x16_bf16(af, cx.BB[2], z, 0, 0, 0);
    const f32x16 i1 = __builtin_amdgcn_mfma_f32_32x32x16_bf16(af, cx.BB[3], z, 0, 0, 0);
    float sr0 = cx.s[0], si0 = cx.s[1], sr1 = cx.s[2], si1 = cx.s[3];
    const float ar0 = cx.a[0], ai0 = cx.a[1], ar1 = cx.a[2], ai1 = cx.a[3];
#pragma unroll
    for (int r = 0; r < 16; ++r) {
        if (MODE == 2 && (r & 3) == 0) {
            const size_t o = ((size_t)(sbatch0 + (r >> 2)) * NG + g) * 64 + j;
            sr0 = h_re[o]; si0 = h_im[o]; sr1 = h_re[o + 32]; si1 = h_im[o + 32];
        }
        const float nr0 = fmaf(ar0, sr0, fmaf(-ai0, si0, r0[r])), ni0 = fmaf(ar0, si0, fmaf(ai0, sr0, i0[r]));
        const float nr1 = fmaf(ar1, sr1, fmaf(-ai1, si1, r1[r])), ni1 = fmaf(ar1, si1, fmaf(ai1, sr1, i1[r]));
        sr0 = nr0; si0 = ni0; sr1 = nr1; si1 = ni1;
        if (MODE != 0) { u32x2 w; w.x = cvt_pk_bf16(sr0, si0); w.y = cvt_pk_bf16(sr1, si1); *(LAS u32x2*)(tile + (16 * hi + r) * 272 + 8 * j) = w; }
        if (MODE == 2 && (r & 3) == 3) {
            const size_t o = ((size_t)(sbatch0 + (r >> 2)) * NG + g) * 64 + j;
            o_re[o] = sr0; o_im[o] = si0; o_re[o + 32] = sr1; o_im[o + 32] = si1;
        }
    }
    cx.s[0] = sr0; cx.s[1] = si0; cx.s[2] = sr1; cx.s[3] = si1;
    if (MODE != 0) {
        LDS_WAIT(); __builtin_amdgcn_wave_barrier();
#pragma unroll
        for (int tg = 0; tg < 2; ++tg) {
            f32x4 y = {0.f, 0.f, 0.f, 0.f};
#pragma unroll
            for (int ks = 0; ks < 4; ++ks) {
                const bf16x8 sf = *(const LAS bf16x8*)(tile + (16 * tg + fr) * 272 + (32 * ks + 8 * fq) * 2);
                y = __builtin_amdgcn_mfma_f32_16x16x32_bf16(cx.CMf[ks], sf, y, 0, 0, 0);
            }
            const u32x2 uw = uwp[tg];
            const float y0 = gelu_tanh(y[0] + cx.dsk[0] * bf_lo(uw.x)), y1 = gelu_tanh(y[1] + cx.dsk[1] * bf_hi(uw.x));
            const float y2 = gelu_tanh(y[2] + cx.dsk[2] * bf_lo(uw.y)), y3 = gelu_tanh(y[3] + cx.dsk[3] * bf_hi(uw.y));
            u32x2 o; o.x = cvt_pk_bf16(y0, y1); o.y = cvt_pk_bf16(y2, y3);
            *(u32x2*)(Gout + yrow[tg] * 1024 + 16 * g + 4 * fq) = o;
        }
    }
}

__device__ __forceinline__ void ssm_load_ctx(SsmCtx& cx, const Args& A, int g, int lane) {
    const bf16_t* BB = (const bf16_t*)(A.ws + O_BB); const bf16_t* CM = (const bf16_t*)(A.ws + O_CM); const float* ABAR = (const float*)(A.ws + O_ABAR);
    const int j = lane & 31, fq = lane >> 4;
#pragma unroll
    for (int i = 0; i < 4; ++i) { cx.BB[i] = *(const bf16x8*)(BB + (((size_t)g * 4 + i) * 64 + lane) * 8); cx.CMf[i] = *(const bf16x8*)(CM + (((size_t)g * 4 + i) * 64 + lane) * 8); }
    const f32x4 a0 = *(const f32x4*)(ABAR + ((size_t)g * 64 + j) * 4), a1 = *(const f32x4*)(ABAR + ((size_t)g * 64 + j + 32) * 4);
    cx.a[0] = a0[0]; cx.a[1] = a0[1]; cx.a[2] = a1[0]; cx.a[3] = a1[1];
    const f32x4 dv = *(const f32x4*)(A.in[I_SSMD] + 16 * g + 4 * fq);
    cx.dsk[0] = dv[0]; cx.dsk[1] = dv[1]; cx.dsk[2] = dv[2]; cx.dsk[3] = dv[3];
}

__device__ __forceinline__ void ssm_phase(const Args& A, LAS unsigned char* lds, int G, const int wv) {
    const int tid = opaque_tid(wv), lane = tid & 63, w = __builtin_amdgcn_readfirstlane(tid >> 6);
    const int j = lane & 31, hi = lane >> 5, fr = lane & 15;
    const bf16_t* P = (const bf16_t*)(A.ws + O_P); bf16_t* Gout = (bf16_t*)(A.ws + O_G);
    const float* ABAR = (const float*)(A.ws + O_ABAR);
    LAS unsigned char* tile = lds + w * 8704;
    LAS f32x4* EL = (LAS f32x4*)(lds + 8 * 8704);
    const int arow_i = lane & 31, own = (arow_i >> 2) & 1, rloc = 4 * (arow_i >> 3) + (arow_i & 3);
    for (int un = blockIdx.x; un < NB * NG; un += G) {
        const int b = un >> 6, g = un & 63;
        SsmCtx cx; ssm_load_ctx(cx, A, g, lane);
        const f32x4 p0 = *(const f32x4*)(ABAR + ((size_t)g * 64 + j) * 4), p1 = *(const f32x4*)(ABAR + ((size_t)g * 64 + j + 32) * 4);
        const size_t rowb = (size_t)b * SEQ;
        size_t yrow[2];
        cx.s[0] = cx.s[1] = cx.s[2] = cx.s[3] = 0.f;
        const bf16_t* abase = P + (rowb + (2 * w + own) * 128 + rloc) * D + 1024 + 16 * g + 8 * hi;
        bf16x8 af = *(const bf16x8*)abase;
        for (int k = 0; k < 8; ++k) {
            const bf16x8 afn = *(const bf16x8*)(abase + (size_t)(16 * ((k + 1) & 7)) * D);
            yrow[0] = 0; yrow[1] = 0;
            ssm_sub<0>(cx, P, Gout, g, af, yrow, tile, lane, nullptr, nullptr, nullptr, nullptr, 0);
            af = afn;
        }
        EL[(2 * w + hi) * 32 + j] = (f32x4){cx.s[0], cx.s[1], cx.s[2], cx.s[3]};
        LDS_WAIT(); __syncthreads();
        {
            float sr0 = 0.f, si0 = 0.f, sr1 = 0.f, si1 = 0.f; const int wk = 2 * w + hi;
            for (int q = 0; q < 15; ++q) {
                if (q < wk) { const f32x4 e = EL[q * 32 + j]; float tr, ti;
                    cmul(p0[2], p0[3], sr0, si0, tr, ti); sr0 = tr + e[0]; si0 = ti + e[1];
                    cmul(p1[2], p1[3], sr1, si1, tr, ti); sr1 = tr + e[2]; si1 = ti + e[3]; }
            }
            cx.s[0] = sr0; cx.s[1] = si0; cx.s[2] = sr1; cx.s[3] = si1;
        }
        for (int k = 0; k < 8; ++k) {
            const bf16x8 afn = *(const bf16x8*)(abase + (size_t)(16 * ((k + 1) & 7)) * D);
            yrow[0] = rowb + (2 * w) * 128 + 16 * k + fr; yrow[1] = rowb + (2 * w + 1) * 128 + 16 * k + fr;
            ssm_sub<1>(cx, P, Gout, g, af, yrow, tile, lane, nullptr, nullptr, nullptr, nullptr, 0);
            af = afn;
        }
        if (w == 7 && hi == 1) {
            const size_t o = ((size_t)b * NG + g) * 64 + j;
            A.out[OUT_REP + o] = cx.s[0]; A.out[OUT_IMP + o] = cx.s[1]; A.out[OUT_REP + o + 32] = cx.s[2]; A.out[OUT_IMP + o + 32] = cx.s[3];
        }
        LDS_WAIT(); __syncthreads();
    }
    for (int un = (int)blockIdx.x; un < 2 * NG; un += G) {
        const int g = un >> 1, bh = un & 1;
        SsmCtx cx; ssm_load_ctx(cx, A, g, lane);
        cx.s[0] = cx.s[1] = cx.s[2] = cx.s[3] = 0.f;
        const int bbase = bh * 64 + w * 8;
        const size_t arow = (size_t)MP + (size_t)(bbase + own * 4 + (arow_i >> 3)) * 4 + (arow_i & 3);
        size_t yrow[2];
        yrow[0] = (size_t)MP + (size_t)(bbase + (fr >> 2)) * 4 + (fr & 3); yrow[1] = (size_t)MP + (size_t)(bbase + 4 + (fr >> 2)) * 4 + (fr & 3);
        const bf16x8 af = *(const bf16x8*)(P + arow * D + 1024 + 16 * g + 8 * hi);
        ssm_sub<2>(cx, P, Gout, g, af, yrow, tile, lane, A.in[I_SRE], A.in[I_SIM], A.out + OUT_RES, A.out + OUT_IMS, bbase + hi * 4);
    }
}

template <int WPU>
__device__ __forceinline__ void sample_attn_units(const Args& A, LAS unsigned char* lds, int su0, const int wv) {
    constexpr int KPW = 256 / WPU, NB = KPW / 8, NKG = KPW / 16;
    const int tid = opaque_tid(wv), lane = tid & 63, w = __builtin_amdgcn_readfirstlane(tid >> 6), fr = lane & 15, fq = lane >> 4;
    const int su = su0 + (WPU == 4 ? (w >> 2) : 0), b = su >> 2, h = su & 3, kq = (WPU == 4) ? (w & 3) : w;
    const bf16_t* Q = (const bf16_t*)(A.ws + O_Q); bf16_t* ATT = (bf16_t*)(A.ws + O_ATT);
    const float* Kc = A.in[I_CK] + (((size_t)b * NMEM + KPW * kq) * NH + h) * HD;
    const float* Vc = A.in[I_CV] + (((size_t)b * NMEM + KPW * kq) * NH + h) * HD;
    LAS bf16_t* QSw = (LAS bf16_t*)(lds + w * 4096);
    LAS float* PLw = (LAS float*)(lds + 32768 + w * 1024);
    LAS float* ML = (LAS float*)(lds + 40960);
    LAS float* RED = (LAS float*)(lds + 49152);
#pragma unroll
    for (int t = 0; t < 4; ++t) *(LAS u32x4*)(QSw + t * 512 + lane * 8) = *(const u32x4*)(Q + ((size_t)MP + b * 4 + t) * D + h * HD + lane * 8);
    f32x4 ra[16], rb[16];
#define KLOAD(dst, bi) do { const float* kp_ = Kc + (size_t)(16 * ((bi) >> 1) + fr) * (NH * HD) + 4 * fq + 256 * ((bi) & 1); \
        _Pragma("unroll") for (int i = 0; i < 8; ++i) { dst[2 * i] = *(const f32x4*)(kp_ + 32 * i); dst[2 * i + 1] = *(const f32x4*)(kp_ + 32 * i + 16); } } while (0)
#define KUSE(src, bi) do { _Pragma("unroll") for (int i = 0; i < 8; ++i) { const int kd = 8 * ((bi) & 1) + i; const f32x4 k0 = src[2 * i], k1 = src[2 * i + 1]; \
        u32x4 kw; kw.x = cvt_pk_bf16(k0[0], k0[1]); kw.y = cvt_pk_bf16(k0[2], k0[3]); kw.z = cvt_pk_bf16(k1[0], k1[1]); kw.w = cvt_pk_bf16(k1[2], k1[3]); \
        u32x4 qw = {0u, 0u, 0u, 0u}; \
        if (fr < 4) { const u32x2 qa = *(const LAS u32x2*)(QSw + fr * 512 + 32 * kd + 4 * fq), qb = *(const LAS u32x2*)(QSw + fr * 512 + 32 * kd + 16 + 4 * fq); qw.x = qa.x; qw.y = qa.y; qw.z = qb.x; qw.w = qb.y; } \
        sc[(bi) >> 1] = __builtin_amdgcn_mfma_f32_16x16x32_bf16(__builtin_bit_cast(bf16x8, kw), __builtin_bit_cast(bf16x8, qw), sc[(bi) >> 1], 0, 0, 0); } } while (0)
#define VLOAD(dst, vb) do { const float* vp_ = Vc + (size_t)(8 * (vb)) * (NH * HD) + 4 * lane; \
        _Pragma("unroll") for (int k = 0; k < 8; ++k) { dst[2 * k] = __builtin_nontemporal_load((const f32x4*)(vp_ + (size_t)k * (NH * HD))); dst[2 * k + 1] = __builtin_nontemporal_load((const f32x4*)(vp_ + (size_t)k * (NH * HD) + 256)); } } while (0)
#define VUSE(src, vb) do { _Pragma("unroll") for (int k = 0; k < 8; ++k) { const f32x4 p = *(const LAS f32x4*)(PLw + (8 * (vb) + k) * 4); \
        _Pragma("unroll") for (int t = 0; t < 4; ++t) { o[t][0] += src[2 * k] * p[t]; o[t][1] += src[2 * k + 1] * p[t]; } } } while (0)
#define SB() __builtin_amdgcn_sched_barrier(0)
    KLOAD(ra, 0); KLOAD(rb, 1);
    LDS_WAIT(); __builtin_amdgcn_wave_barrier();
    f32x4 sc[NKG];
#pragma unroll
    for (int i = 0; i < NKG; ++i) sc[i] = (f32x4){0.f, 0.f, 0.f, 0.f};
    SB(); KUSE(ra, 0); SB(); KLOAD(ra, 2); SB(); KUSE(rb, 1); SB(); KLOAD(rb, 3); SB();
    if constexpr (NB == 8) {
        KUSE(ra, 2); SB(); KLOAD(ra, 4); SB(); KUSE(rb, 3); SB(); KLOAD(rb, 5); SB();
        KUSE(ra, 4); SB(); KLOAD(ra, 6); SB(); KUSE(rb, 5); SB(); KLOAD(rb, 7); SB();
        KUSE(ra, 6); SB(); VLOAD(ra, 0); SB(); KUSE(rb, 7); SB(); VLOAD(rb, 1); SB();
    } else {
        KUSE(ra, 2); SB(); VLOAD(ra, 0); SB(); KUSE(rb, 3); SB(); VLOAD(rb, 1); SB();
    }
    float mt = -3.0e38f;
#pragma unroll
    for (int kg = 0; kg < NKG; ++kg) mt = fmaxf(mt, fmaxf(fmaxf(sc[kg][0], sc[kg][1]), fmaxf(sc[kg][2], sc[kg][3])));
    mt = fmaxf(mt, __shfl_xor(mt, 16)); mt = fmaxf(mt, __shfl_xor(mt, 32));
    float lt = 0.f;
#pragma unroll
    for (int kg = 0; kg < NKG; ++kg)
#pragma unroll
        for (int r = 0; r < 4; ++r) { const float e = __expf(sc[kg][r] - mt); lt += e; if (fr < 4) PLw[(16 * kg + 4 * fq + r) * 4 + fr] = e; }
    lt += __shfl_xor(lt, 16); lt += __shfl_xor(lt, 32);
    if (fr < 4 && fq == 0) { ML[(w * 4 + fr) * 2] = mt; ML[(w * 4 + fr) * 2 + 1] = lt; }
    LDS_WAIT(); __builtin_amdgcn_wave_barrier();
    f32x4 o[4][2];
#pragma unroll
    for (int t = 0; t < 4; ++t) { o[t][0] = (f32x4){0.f, 0.f, 0.f, 0.f}; o[t][1] = (f32x4){0.f, 0.f, 0.f, 0.f}; }
    SB(); VUSE(ra, 0); SB(); VLOAD(ra, 2); SB(); VUSE(rb, 1); SB(); VLOAD(rb, 3); SB();
    if constexpr (NB == 8) {
        VUSE(ra, 2); SB(); VLOAD(ra, 4); SB(); VUSE(rb, 3); SB(); VLOAD(rb, 5); SB();
        VUSE(ra, 4); SB(); VLOAD(ra, 6); SB(); VUSE(rb, 5); SB(); VLOAD(rb, 7); SB();
        VUSE(ra, 6); SB(); VUSE(rb, 7);
    } else {
        VUSE(ra, 2); SB(); VUSE(rb, 3);
    }
#undef KLOAD
#undef KUSE
#undef VLOAD
#undef VUSE
#undef SB
#pragma unroll
    for (int t = 0; t < 4; ++t) { *(LAS f32x4*)(RED + (w * 4 + t) * 512 + 4 * lane) = o[t][0]; *(LAS f32x4*)(RED + (w * 4 + t) * 512 + 256 + 4 * lane) = o[t][1]; }
    LDS_WAIT(); __syncthreads();
    if constexpr (WPU == 4) {
        const int uh = tid >> 8, t = (tid >> 6) & 3, c = (tid & 63) * 8;
        float m4[4], l4[4], Mx = -3.0e38f;
#pragma unroll
        for (int q = 0; q < 4; ++q) { m4[q] = ML[((uh * 4 + q) * 4 + t) * 2]; l4[q] = ML[((uh * 4 + q) * 4 + t) * 2 + 1]; Mx = fmaxf(Mx, m4[q]); }
        f32x4 s0 = {0.f, 0.f, 0.f, 0.f}, s1 = {0.f, 0.f, 0.f, 0.f}; float L = 0.f;
#pragma unroll
        for (int q = 0; q < 4; ++q) { const float f = __expf(m4[q] - Mx); L += l4[q] * f;
            s0 += *(const LAS f32x4*)(RED + ((uh * 4 + q) * 4 + t) * 512 + c) * f; s1 += *(const LAS f32x4*)(RED + ((uh * 4 + q) * 4 + t) * 512 + c + 4) * f; }
        const float iv = 1.0f / L; const int su2 = su0 + uh, b2 = su2 >> 2, h2 = su2 & 3;
        pg8::st_bf16x8(ATT + ((size_t)MP + b2 * 4 + t) * D + h2 * HD + c, s0 * iv, s1 * iv);
    } else {
        const int t = tid >> 7, c = (tid & 127) * 4;
        float m8[8], l8[8], Mx = -3.0e38f;
#pragma unroll
        for (int q = 0; q < 8; ++q) { m8[q] = ML[(q * 4 + t) * 2]; l8[q] = ML[(q * 4 + t) * 2 + 1]; Mx = fmaxf(Mx, m8[q]); }
        f32x4 s0 = {0.f, 0.f, 0.f, 0.f}; float L = 0.f;
#pragma unroll
        for (int q = 0; q < 8; ++q) { const float f = __expf(m8[q] - Mx); L += l8[q] * f; s0 += *(const LAS f32x4*)(RED + (q * 4 + t) * 512 + c) * f; }
        const float iv = 1.0f / L; const int b2 = su0 >> 2, h2 = su0 & 3;
        pg8::st_bf16x4(ATT + ((size_t)MP + b2 * 4 + t) * D + h2 * HD + c, s0 * iv);
    }
    LDS_WAIT(); __syncthreads();
}

constexpr int MTP = MP / 256;
struct SchedGrid {
    int G, c, nM, nN; const char* A; const char* B; size_t ta, tb; const char* Sb; size_t ts;
    __device__ __forceinline__ bool next(int i, Unit& u) const {
        const int L = i * G + c; if (L >= nM * nN) return false;
        u.pm = L % nM; u.pn = L / nM; u.job = 0; u.a = A + (size_t)u.pm * ta; u.b = B + (size_t)u.pn * tb; u.s = Sb + (size_t)u.pm * ts; u.srow = MP + 16 * u.pm; return true;
    }
};
struct Sched1 {
    int G, c; const char* hmix; const char* win; const char* mn; const char* wkv;
    __device__ __forceinline__ bool next(int i, Unit& u) const {
        int L = i * G + c;
        if (L < MTP * 8) { u.job = 0; u.pm = L % MTP; u.pn = L / MTP; u.a = hmix + (size_t)u.pm * 256 * D * 2; u.b = win + (size_t)u.pn * 256 * D * 2;
            u.s = hmix + ((size_t)MP + 16 * u.pm) * D * 2; u.srow = MP + 16 * u.pm; return true; }
        L -= MTP * 8;
        if (L < 64) { u.job = 1; u.pm = L & 3; u.pn = L >> 2; u.a = mn + (size_t)u.pm * 256 * D * 2; u.b = wkv + (size_t)u.pn * 256 * D * 2; u.s = u.a; u.srow = -1; return true; }
        return false;
    }
};
struct SchedGU {
    int G, c; const char* A; const char* B;
    __device__ __forceinline__ bool next(int i, Unit& u) const {
        const int L = i * G + c;
        if (L < MTP * 44) { u.pm = L % MTP; u.pn = L / MTP; }
        else if (L < (MTP + 2) * 44) { const int r = L - MTP * 44; u.pm = MTP + (r & 1); u.pn = r >> 1; }
        else return false;
        u.job = 0; u.a = A + (size_t)u.pm * 256 * D * 2; u.b = B + (size_t)u.pn * 256 * D * 2; u.s = u.a; u.srow = -1; return true;
    }
};
struct SchedPool {
    int G, c; const char* pooled; const char* wp;
    __device__ __forceinline__ bool next(int i, Unit& u) const {
        const int L = i * G + c; if (L >= MTP * 4) return false;
        u.job = 0; u.pm = L % MTP; u.pn = L / MTP; u.a = pooled + ((size_t)u.pm * 256 * 1024 + u.pn * 256) * 2; u.b = wp + (size_t)u.pn * 256 * 256 * 2;
        u.s = pooled + (((size_t)MP + 16 * u.pm) * 1024 + u.pn * 256) * 2; u.srow = MP + 16 * u.pm; return true;
    }
};
struct SchedScores {
    int c; const char* Q; const char* KB;
    __device__ __forceinline__ bool next(int i, Unit& u) const {
        if (i > 0 || c >= 128) return false;
        const int bh = c >> 3, qb = c & 7, b = bh >> 2, h = bh & 3;
        u.job = bh; u.pm = qb; u.pn = 0; u.a = Q + (((size_t)b * SEQ + qb * 256) * D + h * HD) * 2; u.b = KB + ((size_t)b * NMEM * D + h * HD) * 2; u.s = u.a; u.srow = -1; return true;
    }
};
struct SchedPVown {
    int c; const char* PR; const char* VT;
    __device__ __forceinline__ bool next(int i, Unit& u) const {
        if (i > 1 || c >= 128) return false;
        const int bh = c >> 3, qb = c & 7, pn = i, b = bh >> 2, h = bh & 3;
        u.job = 0; u.pm = b * 8 + qb; u.pn = h * 2 + pn;
        u.a = PR + ((size_t)bh * SEQ + qb * 256) * 256 * 2; u.b = VT + (((size_t)h * HD + pn * 256) * 1024 + b * 256) * 2; u.s = u.a; u.srow = -1; return true;
    }
};
struct SchedPV {
    int G, c; const char* PR; const char* VT;
    __device__ __forceinline__ bool next(int i, Unit& u) const {
        const int L = i * G + c; if (L >= 256) return false;
        const int bh = L >> 4, rem = L & 15, qb = rem >> 1, pn = rem & 1, b = bh >> 2, h = bh & 3;
        u.job = 0; u.pm = b * 8 + qb; u.pn = h * 2 + pn;
        u.a = PR + ((size_t)bh * SEQ + qb * 256) * 256 * 2; u.b = VT + (((size_t)h * HD + pn * 256) * 1024 + b * 256) * 2; u.s = u.a; u.srow = -1; return true;
    }
};


#define XB_TMO      128
#define XB_XCNT(j)  (256  + 64 * (j))
#define XB_XSUB(j)  (1280 + 64 * (j))
#define XB_XGEN(j)  (2304 + 64 * (j))
#define XB_TOP      3328
#define XB_TOPGEN   3392
#define XCD_BAR_WORDS 3456
#define XB_SPIN_CAP (1u << 18)
__device__ __forceinline__ unsigned xb_ld(unsigned* p)              { return __hip_atomic_load(p, __ATOMIC_RELAXED, __HIP_MEMORY_SCOPE_AGENT); }
__device__ __forceinline__ unsigned xb_add(unsigned* p, unsigned v) { return __hip_atomic_fetch_add(p, v, __ATOMIC_RELAXED, __HIP_MEMORY_SCOPE_AGENT); }
__device__ __forceinline__ unsigned xb_xcc_id() { return (unsigned)__builtin_amdgcn_s_getreg((3 << 11) | 20) & 0xFu; }
#define XB_SPIN(cond, bar) do { unsigned _sp = 0; while (cond) { __builtin_amdgcn_s_sleep(1); \
    if ((++_sp & 255u) == 0u) { if (xb_ld(&(bar)[XB_TMO])) break; if (_sp > XB_SPIN_CAP) { atomicAdd(&(bar)[XB_TMO], 1u); break; } } } } while (0)
struct XcdBarrier { unsigned* bar; unsigned x; volatile LAS unsigned* st; };
__device__ __forceinline__ XcdBarrier xcd_barrier_post(unsigned* bar, volatile LAS unsigned* st) {
    XcdBarrier b; b.bar = bar; b.x = xb_xcc_id(); b.st = st;
    if (threadIdx.x == 0) (void)xb_add(&bar[XB_XCNT(b.x)], 1u);
    return b;
}
__device__ __forceinline__ void xcd_barrier_complete(unsigned* bar, unsigned x, unsigned& nloc, unsigned& nx) {
    const unsigned G = gridDim.x * gridDim.y * gridDim.z;
    unsigned sum, cnt, mine, sp = 0u;
    for (;;) {
        sum = 0u; cnt = 0u; mine = 0u;
#pragma unroll
        for (unsigned j = 0; j < 16; ++j) { const unsigned c = xb_ld(&bar[XB_XCNT(j)]); sum += c; cnt += (c > 0u) ? 1u : 0u; mine = (j == x) ? c : mine; }
        if (sum == G) break;
        __builtin_amdgcn_s_sleep(1);
        if ((++sp & 255u) == 0u) { if (xb_ld(&bar[XB_TMO])) break; if (sp > XB_SPIN_CAP) { atomicAdd(&bar[XB_TMO], 1u); break; } }
    }
    nloc = mine > 0u ? mine : 1u; nx = cnt > 0u ? cnt : 1u;
}
__device__ __forceinline__ void xcd_barrier(const XcdBarrier& b, const int wv) {
    asm volatile("s_waitcnt vmcnt(0)" ::: "memory");
    __syncthreads();
    if (opaque_tid(wv) == 0) {
        unsigned* bar = b.bar;
        __builtin_amdgcn_s_waitcnt(0);
        unsigned nloc = b.st[0], nx = b.st[1];
        if (nloc == 0u) { xcd_barrier_complete(bar, b.x, nloc, nx); b.st[0] = nloc; b.st[1] = nx; }
        const unsigned old = xb_add(&bar[XB_XSUB(b.x)], 1u);
        const unsigned gen = old / nloc;
        if (old + 1u == (gen + 1u) * nloc) {
            __builtin_amdgcn_fence(__ATOMIC_RELEASE, "agent");
            asm volatile("s_waitcnt vmcnt(0)" ::: "memory");
            __builtin_amdgcn_fence(__ATOMIC_RELEASE, "agent");
            asm volatile("s_waitcnt vmcnt(0)" ::: "memory");
            const unsigned og = xb_add(&bar[XB_TOP], 1u);
            const unsigned tg = og / nx;
            if (og + 1u == (tg + 1u) * nx) xb_add(&bar[XB_TOPGEN], 1u);
            else XB_SPIN(xb_ld(&bar[XB_TOPGEN]) == tg, bar);
            __builtin_amdgcn_fence(__ATOMIC_ACQUIRE, "agent");
            xb_add(&bar[XB_XGEN(b.x)], 1u);
            asm volatile("s_waitcnt vmcnt(0)" ::: "memory");
        } else {
            XB_SPIN(xb_ld(&bar[XB_XGEN(b.x)]) == gen, bar);
            __builtin_amdgcn_fence(__ATOMIC_ACQUIRE, "agent");
            asm volatile("s_waitcnt vmcnt(0)" ::: "memory");
        }
    }
    __syncthreads();
}

#ifndef REP_PHASE
#define REP_PHASE -1
#endif
#define REPEAT(k) for (int rep_ = 0; rep_ < ((REP_PHASE == (k)) ? 2 : 1); ++rep_)
__global__ void __launch_bounds__(512, 2) hymba_fwd(Args A) {
    extern __shared__ __attribute__((aligned(16))) unsigned char lds_raw[];
    LAS unsigned char* lds = (LAS unsigned char*)lds_raw;
    cg::grid_group grid = cg::this_grid();
    const int G = gridDim.x, c = blockIdx.x, wv = __builtin_amdgcn_readfirstlane((int)threadIdx.x >> 6);
    unsigned char* ws = A.ws;
    float* SS1 = (float*)(ws + O_SS1); float* SS2 = (float*)(ws + O_SS2); float* SS3 = (float*)(ws + O_SS3); float* SSD = (float*)(ws + O_BAR + 16384);
    volatile LAS unsigned* bst = (volatile LAS unsigned*)(lds + RING_BYTES + 8192);
    if (threadIdx.x < 4) bst[threadIdx.x] = 0u;
    __syncthreads();
    const XcdBarrier xbar = xcd_barrier_post((unsigned*)(ws + O_BAR), bst);
#define SEAM() xcd_barrier(xbar, wv)

    REPEAT(0) {
    {
        convert_weights(A, lds, 0, NEARLY, c * 8 + wv, G * 8, wv);
        phase0_rest(A, G, wv);
    }
    if (A.ws == nullptr) grid.sync();
    SEAM();
    }
    REPEAT(1) {
    {
        Sched1 S{G, c, (const char*)(ws + O_HMIX), (const char*)(ws + O_WIN), (const char*)(ws + O_MN), (const char*)(ws + O_WKV)};
        pg8::EpiInKv E{(bf16_t*)(ws + O_P), A.out, (bf16_t*)(ws + O_KB), (bf16_t*)(ws + O_VT)};
        pg8::gemm_phase<pg8::EpiInKv, Sched1, true, true>(lds, pg8::Dims{D, D, D}, S, E, wv);
        __syncthreads();
        const int skip = (G > 128) ? 64 : 0;
        convert_weights(A, lds, NEARLY, NITEMS, (c >= skip) ? (c - skip) * 8 + wv : -1, (G - skip) * 8, wv);
    }
    SEAM();
    }
    REPEAT(2) {
    ssm_phase(A, lds, G, wv);
    pooled_phase(A, G, wv);
    SEAM();
    }
    REPEAT(3) {
    {
        SchedPool S{G, c, (const char*)(ws + O_POOLED), (const char*)(ws + O_WPOOL)};
        pg8::EpiPool E{(bf16_t*)(ws + O_MIX), A.in[I_PSCALE]};
        pg8::gemm_phase<pg8::EpiPool, SchedPool, true, true>(lds, pg8::Dims{1024, 256, 256}, S, E, wv);
        SchedGrid S2{G, G - 1 - c, MTP, 4, (const char*)(ws + O_G), (const char*)(ws + O_WGLU), (size_t)256 * 1024 * 2, (size_t)256 * 1024 * 2, (const char*)(ws + O_G) + (size_t)MP * 1024 * 2, (size_t)16 * 1024 * 2};
        pg8::EpiGlu E2{(bf16_t*)(ws + O_MIX), (const bf16_t*)(ws + O_G), A.in[I_BGLU]};
        pg8::gemm_phase<pg8::EpiGlu, SchedGrid, true, true>(lds, pg8::Dims{1024, 1024, 1024}, S2, E2, wv);
    }
    SEAM();
    }
    REPEAT(4) {
    {
        SchedGrid S{G, c, MTP, 8, (const char*)(ws + O_MIX), (const char*)(ws + O_WOUT), (size_t)256 * D * 2, (size_t)256 * D * 2, (const char*)(ws + O_MIX) + (size_t)MP * D * 2, (size_t)16 * D * 2};
        pg8::EpiRes<float> E{A.in[I_XP], A.in[I_XS], nullptr, (bf16_t*)(ws + O_XB), rep_ ? SSD : SS1};
        pg8::gemm_phase<pg8::EpiRes<float>, SchedGrid, true, true>(lds, pg8::Dims{D, D, D}, S, E, wv);
    }
    SEAM();
    }
    REPEAT(5) {
    {
        SchedGrid S{G, c, MTP, 8, (const char*)(ws + O_XB), (const char*)(ws + O_WQ), (size_t)256 * D * 2, (size_t)256 * D * 2, (const char*)(ws + O_XB) + (size_t)MP * D * 2, (size_t)16 * D * 2};
        pg8::EpiQ E{(bf16_t*)(ws + O_Q), SS1};
        pg8::gemm_phase<pg8::EpiQ, SchedGrid, true, true>(lds, pg8::Dims{D, D, D}, S, E, wv);
    }
    SEAM();
    }
    REPEAT(6) {
    {
        if (G == 256) {
            if (c < 128) {
                { SchedScores S{c, (const char*)(ws + O_Q), (const char*)(ws + O_KB)};
                  pg8::EpiSoftmax E{(bf16_t*)(ws + O_PR)};
                  pg8::gemm_phase<pg8::EpiSoftmax, SchedScores, false, false>(lds, pg8::Dims{D, D, HD}, S, E, wv); }
                asm volatile("s_waitcnt vmcnt(0)" ::: "memory"); __syncthreads();
                { SchedPVown S{c, (const char*)(ws + O_PR), (const char*)(ws + O_VT)};
                  pg8::EpiPV E{(bf16_t*)(ws + O_ATT)};
                  pg8::gemm_phase<pg8::EpiPV, SchedPVown, true, false>(lds, pg8::Dims{256, 1024, 256}, S, E, wv); }
                __syncthreads();
                sample_attn_units<8>(A, lds, c, wv);
            } else {
                sample_attn_units<4>(A, lds, 128 + 2 * (c - 128), wv);
                sample_attn_units<8>(A, lds, 384 + (c - 128), wv);
            }
        } else {
            for (int base = 0; base < 128; base += G) {
                SchedScores S{c + base, (const char*)(ws + O_Q), (const char*)(ws + O_KB)};
                pg8::EpiSoftmax E{(bf16_t*)(ws + O_PR)};
                pg8::gemm_phase<pg8::EpiSoftmax, SchedScores, false, false>(lds, pg8::Dims{D, D, HD}, S, E, wv);
            }
            __syncthreads();
            for (int du = c; du < 256; du += G) sample_attn_units<4>(A, lds, 2 * du, wv);
        }
    }
    SEAM();
    }
    if (G != 256) {
        SchedPV S{G, c, (const char*)(ws + O_PR), (const char*)(ws + O_VT)};
        pg8::EpiPV E{(bf16_t*)(ws + O_ATT)};
        pg8::gemm_phase<pg8::EpiPV, SchedPV, true, false>(lds, pg8::Dims{256, 1024, 256}, S, E, wv);
        SEAM();
    }
    REPEAT(8) {
    {
        SchedGrid S{G, c, MTP, 8, (const char*)(ws + O_ATT), (const char*)(ws + O_WO), (size_t)256 * D * 2, (size_t)256 * D * 2, (const char*)(ws + O_ATT) + (size_t)MP * D * 2, (size_t)16 * D * 2};
        pg8::EpiRes<bf16_t> E{(const bf16_t*)(ws + O_XB), (const bf16_t*)(ws + O_XB) + (size_t)MP * D, nullptr, (bf16_t*)(ws + O_XB), SS2};
        pg8::gemm_phase<pg8::EpiRes<bf16_t>, SchedGrid, true, true>(lds, pg8::Dims{D, D, D}, S, E, wv);
    }
    SEAM();
    }
    REPEAT(9) {
    {
        SchedGU S{G, c, (const char*)(ws + O_XB), (const char*)(ws + O_WGU)};
        pg8::EpiGateUp E{(bf16_t*)(ws + O_H), SS2};
        pg8::gemm_phase<pg8::EpiGateUp, SchedGU, true, false>(lds, pg8::Dims{D, D, D}, S, E, wv);
    }
    SEAM();
    }
    if (G == 256) {
        SchedGrid S{G, c, MTP, 8, (const char*)(ws + O_H), (const char*)(ws + O_WDN), (size_t)256 * FF * 2, (size_t)256 * FF * 2, (const char*)(ws + O_H) + (size_t)MP * FF * 2, (size_t)16 * FF * 2};
        pg8::EpiFinal E{(const bf16_t*)(ws + O_XB), A.out + OUT_Y, SS3, (unsigned*)(ws + O_PCNT), A.in[I_GFINAL]};
        pg8::gemm_phase<pg8::EpiFinal, SchedGrid, false, true>(lds, pg8::Dims{FF, FF, FF}, S, E, wv);
    } else {
        {
            SchedGrid S{G, c, MTP, 8, (const char*)(ws + O_H), (const char*)(ws + O_WDN), (size_t)256 * FF * 2, (size_t)256 * FF * 2, (const char*)(ws + O_H) + (size_t)MP * FF * 2, (size_t)16 * FF * 2};
            pg8::EpiRes<bf16_t> E{(const bf16_t*)(ws + O_XB), (const bf16_t*)(ws + O_XB) + (size_t)MP * D, A.out + OUT_Y, nullptr, SS3};
            pg8::gemm_phase<pg8::EpiRes<bf16_t>, SchedGrid, true, true>(lds, pg8::Dims{FF, FF, FF}, S, E, wv);
        }
        SEAM();
        const float* gf = A.in[I_GFINAL]; const int tid = opaque_tid(wv), lane = tid & 63, wave = wv;
        for (int m = c * 8 + wave; m < M; m += G * 8) {
            const float rs = rsqrtf(SS3[m] * (1.0f / D) + EPS);
            f32x4* row = (f32x4*)(A.out + OUT_Y + (size_t)m * D) + lane; const f32x4* gr = (const f32x4*)gf + lane;
#pragma unroll
            for (int jj = 0; jj < 8; ++jj) row[64 * jj] = row[64 * jj] * rs * gr[64 * jj];
        }
    }
}

extern "C" void kernel_launch(void* const* d_in, const int* in_sizes, int n_in, void* d_out, int out_size, void* d_ws, size_t ws_size, hipStream_t stream) {
    static int grid = 0;
    if (grid == 0) {
        if (n_in != 34 || ws_size < WS_END) { fprintf(stderr, "kernel_launch: unexpected inputs (n_in %d, ws %zu, need %zu)\n", n_in, ws_size, (size_t)WS_END); grid = -1; return; }
        int dev = 0, cus = 0, per_cu = 0;
        hipGetDevice(&dev);
        hipDeviceGetAttribute(&cus, hipDeviceAttributeMultiprocessorCount, dev);
        if (hipFuncSetAttribute((const void*)hymba_fwd, hipFuncAttributeMaxDynamicSharedMemorySize, LDS_BYTES) != hipSuccess) { fprintf(stderr, "kernel_launch: hipFuncSetAttribute failed\n"); grid = -1; return; }
        if (hipOccupancyMaxActiveBlocksPerMultiprocessor(&per_cu, (const void*)hymba_fwd, 512, LDS_BYTES) != hipSuccess || per_cu < 1) { fprintf(stderr, "kernel_launch: occupancy query failed (%d)\n", per_cu); per_cu = 1; }
        (void)hipGetLastError();
        grid = cus * per_cu;
    }
    if (grid < 0) return;
    hipMemsetAsync(d_ws, 0, CTL_BYTES, stream);
    Args a{};
    for (int i = 0; i < 34; ++i) a.in[i] = (const float*)d_in[i];
    a.out = (float*)d_out; a.ws = (unsigned char*)d_ws;
    void* args[] = {&a};
    hipError_t e = hipLaunchCooperativeKernel((const void*)hymba_fwd, dim3(grid), dim3(512), args, LDS_BYTES, stream);
    if (e != hipSuccess) fprintf(stderr, "cooperative launch failed: %s (grid %d)\n", hipGetErrorString(e), grid);
}
```

```cpp
#include <hip/hip_runtime.h>
#include <hip/hip_cooperative_groups.h>
#include <cstdio>
#include <cstdint>
namespace cg = cooperative_groups;

#define LAS __attribute__((address_space(3)))
typedef unsigned short bf16_t;
typedef short bf16x8 __attribute__((ext_vector_type(8)));
typedef float f32x4 __attribute__((ext_vector_type(4)));
typedef float f32x16 __attribute__((ext_vector_type(16)));
typedef unsigned u32x4 __attribute__((ext_vector_type(4)));
typedef unsigned u32x2 __attribute__((ext_vector_type(2)));

constexpr int D = 2048, SEQ = 2048, NB = 4, MP = NB * SEQ, DB = 128, DS = 4, MS = DB * DS, M = MP + MS;
constexpr int PW = 1024, NG = 64, NMEM = 256, NH = 4, HD = 512, FF = 5632, PBUF = 15;
constexpr float EPS = 1e-6f;

constexpr size_t OUT_Y = 0;
constexpr size_t OUT_PBP = (size_t)M * D;
constexpr size_t OUT_REP = OUT_PBP + (size_t)NB * PBUF * PW;
constexpr size_t OUT_IMP = OUT_REP + (size_t)NB * NG * 64;
constexpr size_t OUT_MK = OUT_IMP + (size_t)NB * NG * 64;
constexpr size_t OUT_MV = OUT_MK + (size_t)NB * NMEM * D;
constexpr size_t OUT_PBS = OUT_MV + (size_t)NB * NMEM * D;
constexpr size_t OUT_RES = OUT_PBS + (size_t)DB * PBUF * PW;
constexpr size_t OUT_IMS = OUT_RES + (size_t)DB * NG * 64;

constexpr size_t CTL_BYTES = 256 * 1024;
constexpr size_t O_SS1 = 0, O_SS2 = 64 * 1024, O_SS3 = 128 * 1024, O_BAR = 192 * 1024, O_PCNT = 248 * 1024;
constexpr size_t O_WIN = 1 << 20;
constexpr size_t O_WKV = O_WIN + (size_t)D * D * 2;
constexpr size_t O_WPOOL = O_WKV + (size_t)2 * D * D * 2;
constexpr size_t O_WGLU = O_WPOOL + (size_t)4 * 256 * 256 * 2;
constexpr size_t O_WOUT = O_WGLU + (size_t)1024 * 1024 * 2;
constexpr size_t O_WQ = O_WOUT + (size_t)D * D * 2;
constexpr size_t O_WO = O_WQ + (size_t)D * D * 2;
constexpr size_t O_WGU = O_WO + (size_t)D * D * 2;
constexpr size_t O_WDN = O_WGU + (size_t)2 * FF * D * 2;
constexpr size_t O_TAB = O_WDN + (size_t)D * FF * 2;
constexpr size_t O_ABAR = O_TAB, O_BB = O_ABAR + 64 * 64 * 16, O_CM = O_BB + 64 * 4096;
constexpr size_t O_HMIX = O_CM + 64 * 4096;
constexpr size_t O_MN = O_HMIX + (size_t)M * D * 2;
constexpr size_t O_P = O_MN + (size_t)1024 * D * 2;
constexpr size_t O_POOLED = O_P + (size_t)M * D * 2;
constexpr size_t O_G = O_POOLED + (size_t)M * 1024 * 2;
constexpr size_t O_MIX = O_G + (size_t)M * 1024 * 2;
constexpr size_t O_X1 = O_MIX + (size_t)M * D * 2;
constexpr size_t O_XB = O_X1 + (size_t)M * D * 4;
constexpr size_t O_Q = O_XB + (size_t)M * D * 2;
constexpr size_t O_KB = O_Q + (size_t)M * D * 2;
constexpr size_t O_VT = O_KB + (size_t)1024 * D * 2;
constexpr size_t O_PR = O_VT + (size_t)D * 1024 * 2;
constexpr size_t O_ATT = O_PR + (size_t)16 * 2048 * 256 * 2;
constexpr size_t O_H = O_ATT + (size_t)M * D * 2;
constexpr size_t WS_END = O_H + (size_t)M * FF * 2;

constexpr int RING_BYTES = 131072, LDS_BYTES = 147456;

__device__ __forceinline__ unsigned cvt_pk_bf16(float lo, float hi) { unsigned r; asm volatile("v_cvt_pk_bf16_f32 %0, %1, %2" : "=v"(r) : "v"(lo), "v"(hi)); return r; }
__device__ __forceinline__ float bf_lo(unsigned w) { return __uint_as_float(w << 16); }
__device__ __forceinline__ float bf_hi(unsigned w) { return __uint_as_float(w & 0xffff0000u); }
__device__ __forceinline__ float wave_sum(float v) {
#pragma unroll
    for (int o = 1; o < 64; o <<= 1) v += __shfl_xor(v, o);
    return v;
}
__device__ __forceinline__ float wave_max(float v) {
#pragma unroll
    for (int o = 1; o < 64; o <<= 1) v = fmaxf(v, __shfl_xor(v, o));
    return v;
}
__device__ __forceinline__ float fast_sigmoid(float x) { return __builtin_amdgcn_rcpf(1.0f + __expf(-x)); }
__device__ __forceinline__ float gelu_tanh(float y) { const float t = 1.5957691216f * (y + 0.044715f * y * y * y); return y * fast_sigmoid(t); }
#define LDS_WAIT() asm volatile("s_waitcnt lgkmcnt(0)" ::: "memory")
__device__ __forceinline__ int opaque_tid(int wv) { int t; asm volatile("v_mbcnt_lo_u32_b32 %0, -1, 0\n\tv_mbcnt_hi_u32_b32 %0, -1, %0\n\tv_lshl_add_u32 %0, %1, 6, %0" : "=&v"(t) : "s"(wv)); return t; }

namespace pg8 {
constexpr int BM = 256, BK = 64, HALF = 128, HTB = HALF * BK * 2;
__device__ __forceinline__ int lds_byte(int r, int c) { const int st = (r >> 4) * 2 + (c >> 5), rr = r & 15, cc = c & 31, ob = rr * 64 + cc * 2; return st * 1024 + (ob ^ (((ob >> 9) & 1) << 5)); }
__device__ __forceinline__ void stage_rc(int b, int& R, int& C) { const int st = b / 1024, sb = b % 1024, swz = sb ^ (((sb >> 9) & 1) << 5); R = (st >> 1) * 16 + swz / 64; C = (st & 1) * 32 + (swz % 64) / 2; }
__device__ __forceinline__ int perm32(int rho) { const int n = rho >> 4, i = rho & 15; return 8 * (i >> 2) + 4 * n + (i & 3); }

struct Unit { const char* a; const char* b; const char* s; int pm, pn, job, srow; };
struct Dims { int lda, ldb, K; };

constexpr int SBUF_OFF = 131072;
template <class Epi, class Sched, bool ALIGN_EPI, bool STRIP>
__device__ __forceinline__ void gemm_phase(LAS unsigned char* lds, const Dims g, const Sched& S, const Epi& E, const int wv) {
    const int tid = opaque_tid(wv), wid = __builtin_amdgcn_readfirstlane(tid >> 6), lane = tid & 63, wr = wid >> 2, wc = wid & 3, fr = lane & 15, fq = lane >> 4;
    int nt = g.K / BK; asm volatile("" : "+s"(nt));
    unsigned voffA[2], voffB[2];
#pragma unroll
    for (int i = 0; i < 2; ++i) { int R, C; stage_rc(tid * 16 + i * 8192, R, C); const int Rb = (R & ~31) + perm32(R & 31);
        voffA[i] = (unsigned)(R * g.lda + C) * 2u; voffB[i] = (unsigned)(Rb * g.ldb + C) * 2u; }
    const unsigned voffS = (unsigned)((2 * wid + (lane >> 5)) * g.lda * 2 + (((((lane & 31) >> 2) ^ wid) & 7) * 16) + (lane & 3) * 4);
    const int soff = fr * 128 + ((fq ^ ((fr >> 1) & 7)) * 16);
    const size_t kstep = (size_t)(BK * 2);
    const size_t hstepA = (size_t)HALF * g.lda * 2, hstepB = (size_t)HALF * g.ldb * 2;
    const unsigned ldsw = (unsigned)wid * 1024u;
    const int aoff = lds_byte(wr * 64 + fr, fq * 8), boff = lds_byte(wc * 32 + fr, fq * 8);
#define PG8_SA(b, h) (((b) * 2 + (h)) * HTB)
#define PG8_SB(b, h) ((4 + (b) * 2 + (h)) * HTB)
#define PG8_STAGE(bufoff, gbase, voff) do { _Pragma("unroll") for (int _i = 0; _i < 2; ++_i) \
        __builtin_amdgcn_global_load_lds((const unsigned*)((const char*)(gbase) + (voff)[_i]), (LAS unsigned*)(lds + (bufoff) + ldsw + _i * 8192), 16, 0, 0); } while (0)
#define PG8_STAGE_S(b, gbase) do { if constexpr (STRIP) __builtin_amdgcn_global_load_lds((const unsigned*)((const char*)(gbase) + voffS), (LAS unsigned*)(lds + SBUF_OFF + (b) * 2048 + wid * 256), 4, 0, 0); } while (0)
#define PG8_LDS_S(b) do { if constexpr (STRIP) { As[0] = *(const LAS bf16x8*)(lds + SBUF_OFF + (b) * 2048 + soff); As[1] = *(const LAS bf16x8*)(lds + SBUF_OFF + (b) * 2048 + (soff ^ 64)); } } while (0)
#define PG8_LDA(dst, b, h) do { _Pragma("unroll") for (int m = 0; m < 4; ++m) _Pragma("unroll") for (int k = 0; k < 2; ++k) dst[m][k] = *(const LAS bf16x8*)(lds + PG8_SA(b, h) + aoff + m * 2048 + k * 1024); } while (0)
#define PG8_LDB(dst, b, h) do { _Pragma("unroll") for (int n = 0; n < 2; ++n) _Pragma("unroll") for (int k = 0; k < 2; ++k) dst[n][k] = *(const LAS bf16x8*)(lds + PG8_SB(b, h) + boff + n * 2048 + k * 1024); } while (0)
#define PG8_MMA(ai, bj, At, Bt) do { __builtin_amdgcn_s_setprio(1); _Pragma("unroll") for (int m = 0; m < 4; ++m) _Pragma("unroll") for (int n = 0; n < 2; ++n) _Pragma("unroll") for (int k = 0; k < 2; ++k) \
        acc[ai][bj][m][n] = __builtin_amdgcn_mfma_f32_16x16x32_bf16(Bt[n][k], At[m][k], acc[ai][bj][m][n], 0, 0, 0); __builtin_amdgcn_s_setprio(0); } while (0)
#define PG8_MMA_S() do { if constexpr (STRIP) { __builtin_amdgcn_s_setprio(1); \
        if (wr == 0) { _Pragma("unroll") for (int k = 0; k < 2; ++k) { sacc[0] = __builtin_amdgcn_mfma_f32_16x16x32_bf16(B0[0][k], As[k], sacc[0], 0, 0, 0); sacc[1] = __builtin_amdgcn_mfma_f32_16x16x32_bf16(B1[0][k], As[k], sacc[1], 0, 0, 0); } } \
        else         { _Pragma("unroll") for (int k = 0; k < 2; ++k) { sacc[0] = __builtin_amdgcn_mfma_f32_16x16x32_bf16(B0[1][k], As[k], sacc[0], 0, 0, 0); sacc[1] = __builtin_amdgcn_mfma_f32_16x16x32_bf16(B1[1][k], As[k], sacc[1], 0, 0, 0); } } \
        __builtin_amdgcn_s_setprio(0); } } while (0)
#define PG8_WAIT_V(n) asm volatile("s_waitcnt vmcnt(" #n ")" ::: "memory")
#define PG8_WAIT_VL() do { if constexpr (STRIP) PG8_WAIT_V(9); else PG8_WAIT_V(8); } while (0)
#define PG8_WAIT_L(n) asm volatile("s_waitcnt lgkmcnt(" #n ")" ::: "memory")
#define PG8_BAR __builtin_amdgcn_s_barrier()
#define PG8_SCHED __builtin_amdgcn_sched_barrier(0)
    Unit cur, nxt; int ui = 0;
    if (!S.next(0, cur)) return;
    f32x4 acc[2][2][4][2];
#pragma unroll
    for (int a = 0; a < 2; ++a)
#pragma unroll
        for (int b = 0; b < 2; ++b)
#pragma unroll
            for (int m = 0; m < 4; ++m)
#pragma unroll
                for (int n = 0; n < 2; ++n) acc[a][b][m][n] = (f32x4){0.f, 0.f, 0.f, 0.f};
    f32x4 sacc[2]; sacc[0] = (f32x4){0.f, 0.f, 0.f, 0.f}; sacc[1] = (f32x4){0.f, 0.f, 0.f, 0.f};
    bf16x8 At[4][2], B0[2][2], B1[2][2], As[2];
    const char* cA = cur.a; const char* cB = cur.b; const char* cS = cur.s;
    PG8_STAGE(PG8_SB(0, 0), cB, voffB); PG8_STAGE(PG8_SB(0, 1), cB + hstepB, voffB); PG8_STAGE(PG8_SA(0, 0), cA, voffA); PG8_STAGE_S(0, cS); PG8_STAGE(PG8_SA(0, 1), cA + hstepA, voffA);
    if (wr == 1) PG8_BAR;
    PG8_WAIT_V(2); PG8_BAR;
    PG8_STAGE(PG8_SB(1, 0), cB + kstep, voffB); PG8_STAGE(PG8_SA(1, 0), cA + kstep, voffA); PG8_STAGE(PG8_SB(1, 1), cB + hstepB + kstep, voffB); PG8_STAGE_S(1, cS + kstep);
    if constexpr (STRIP) PG8_WAIT_V(7); else PG8_WAIT_V(6);
    PG8_BAR;
    for (;;) {
        const bool has_next = S.next(ui + 1, nxt);
        const char* nA = has_next ? nxt.a : cA; const char* nB = has_next ? nxt.b : cB; const char* nS = has_next ? nxt.s : cS;
        for (int t = 0; t < nt; t += 2) {
            const bool last = (t == nt - 2);
            const char* a1 = cA + (size_t)(t + 1) * kstep;
            const char* a2 = last ? nA : cA + (size_t)(t + 2) * kstep; const char* b2 = last ? nB : cB + (size_t)(t + 2) * kstep; const char* s2 = last ? nS : cS + (size_t)(t + 2) * kstep;
            const char* a3 = a2 + kstep; const char* b3 = b2 + kstep; const char* s3 = s2 + kstep;
            PG8_LDB(B0, 0, 0); PG8_LDB(B1, 0, 1); PG8_SCHED; PG8_LDA(At, 0, 0); PG8_LDS_S(0); PG8_STAGE(PG8_SA(1, 1), a1 + hstepA, voffA);
            PG8_WAIT_VL(); PG8_WAIT_L(0); PG8_BAR; PG8_MMA(0, 0, At, B0); PG8_MMA(0, 1, At, B1); PG8_MMA_S(); PG8_BAR; PG8_SCHED;
            PG8_LDA(At, 0, 1); PG8_STAGE(PG8_SB(0, 0), b2, voffB); PG8_STAGE(PG8_SB(0, 1), b2 + hstepB, voffB); PG8_STAGE(PG8_SA(0, 0), a2, voffA); PG8_STAGE_S(0, s2);
            PG8_WAIT_VL(); PG8_WAIT_L(0); PG8_BAR; PG8_MMA(1, 0, At, B0); PG8_MMA(1, 1, At, B1); PG8_BAR; PG8_SCHED;
            PG8_LDB(B0, 1, 0); PG8_LDB(B1, 1, 1); PG8_SCHED; PG8_LDA(At, 1, 0); PG8_LDS_S(1); PG8_STAGE(PG8_SA(0, 1), a2 + hstepA, voffA);
            PG8_WAIT_VL(); PG8_WAIT_L(0); PG8_BAR; PG8_MMA(0, 0, At, B0); PG8_MMA(0, 1, At, B1); PG8_MMA_S(); PG8_BAR; PG8_SCHED;
            PG8_LDA(At, 1, 1); PG8_STAGE(PG8_SB(1, 0), b3, voffB); PG8_STAGE(PG8_SB(1, 1), b3 + hstepB, voffB); PG8_STAGE(PG8_SA(1, 0), a3, voffA); PG8_STAGE_S(1, s3);
            PG8_WAIT_VL(); PG8_WAIT_L(0); PG8_BAR; PG8_MMA(1, 0, At, B0); PG8_MMA(1, 1, At, B1); PG8_BAR; PG8_SCHED;
        }
        if constexpr (ALIGN_EPI) { if (wr == 0) PG8_BAR; }
        if constexpr (!Epi::AFTER_DRAIN) { E(acc, cur, wr, wc, fr, fq); if constexpr (STRIP) { if (cur.srow >= 0) E.strip(sacc, cur, wr, wc, fr, fq); } }
        if (!has_next) break;
#pragma unroll
        for (int a = 0; a < 2; ++a)
#pragma unroll
            for (int b = 0; b < 2; ++b)
#pragma unroll
                for (int m = 0; m < 4; ++m)
#pragma unroll
                    for (int n = 0; n < 2; ++n) acc[a][b][m][n] = (f32x4){0.f, 0.f, 0.f, 0.f};
        sacc[0] = (f32x4){0.f, 0.f, 0.f, 0.f}; sacc[1] = (f32x4){0.f, 0.f, 0.f, 0.f};
        cur = nxt; cA = nA; cB = nB; cS = nS; ++ui;
        if constexpr (ALIGN_EPI) { if (wr == 1) PG8_BAR; }
    }
    PG8_WAIT_V(0);
    if constexpr (!ALIGN_EPI) { if (wr == 0) PG8_BAR; }
    PG8_BAR;
    if constexpr (Epi::AFTER_DRAIN) { E.fused(acc, sacc, cur, wr, wc, fr, fq, lds, wid, lane); }
#undef PG8_SA
#undef PG8_SB
#undef PG8_STAGE
#undef PG8_STAGE_S
#undef PG8_LDS_S
#undef PG8_LDA
#undef PG8_LDB
#undef PG8_MMA
#undef PG8_MMA_S
#undef PG8_WAIT_V
#undef PG8_WAIT_VL
#undef PG8_WAIT_L
#undef PG8_BAR
#undef PG8_SCHED
}
typedef f32x4 Acc[2][2][4][2];

__device__ __forceinline__ void st_bf16x8(bf16_t* p, f32x4 v0, f32x4 v1) {
    u32x4 w; w.x = cvt_pk_bf16(v0[0], v0[1]); w.y = cvt_pk_bf16(v0[2], v0[3]); w.z = cvt_pk_bf16(v1[0], v1[1]); w.w = cvt_pk_bf16(v1[2], v1[3]); *(u32x4*)p = w;
}
__device__ __forceinline__ void st_bf16x4(bf16_t* p, f32x4 v) { u32x2 w; w.x = cvt_pk_bf16(v[0], v[1]); w.y = cvt_pk_bf16(v[2], v[3]); *(u32x2*)p = w; }
typedef f32x4 SAcc[2];
struct EpiInKv {
    static constexpr bool AFTER_DRAIN = false;
    bf16_t* P; float* out; bf16_t* KB; bf16_t* VT;
    __device__ __forceinline__ void operator()(const Acc& acc, const Unit& u, int wr, int wc, int fr, int fq) const {
        if (u.job == 0) {
#pragma unroll
            for (int ai = 0; ai < 2; ++ai)
#pragma unroll
                for (int m = 0; m < 4; ++m) {
                    const int row = u.pm * 256 + ai * 128 + wr * 64 + m * 16 + fr;
                    float* pbp = nullptr;
                    if (u.pn < 4) {
                        if (row < MP) { const int t = row & (SEQ - 1); if (t >= SEQ - PBUF) pbp = out + OUT_PBP + ((size_t)(row >> 11) * PBUF + (t - (SEQ - PBUF))) * PW; }
                        else { const int rs = row - MP; pbp = out + OUT_PBS + ((size_t)(rs >> 2) * PBUF + 11 + (rs & 3)) * PW; }
                    }
#pragma unroll
                    for (int bj = 0; bj < 2; ++bj) {
                        const int col = u.pn * 256 + bj * 128 + wc * 32 + 8 * fq;
                        const f32x4 v0 = acc[ai][bj][m][0], v1 = acc[ai][bj][m][1];
                        st_bf16x8(P + (size_t)row * D + col, v0, v1);
                        if (pbp) { *(f32x4*)(pbp + col) = v0; *(f32x4*)(pbp + col + 4) = v1; }
                    }
                }
        } else {
#pragma unroll
            for (int ai = 0; ai < 2; ++ai)
#pragma unroll
                for (int m = 0; m < 4; ++m) {
                    const int row = u.pm * 256 + ai * 128 + wr * 64 + m * 16 + fr;
#pragma unroll
                    for (int bj = 0; bj < 2; ++bj) {
                        const int col = u.pn * 256 + bj * 128 + wc * 32 + 8 * fq;
                        const f32x4 v0 = acc[ai][bj][m][0], v1 = acc[ai][bj][m][1];
                        if (col < D) {
                            float* o = out + OUT_MK + (size_t)row * D + col; *(f32x4*)o = v0; *(f32x4*)(o + 4) = v1;
                            st_bf16x8(KB + (size_t)row * D + col, v0, v1);
                        } else {
                            const int c = col - D;
                            float* o = out + OUT_MV + (size_t)row * D + c; *(f32x4*)o = v0; *(f32x4*)(o + 4) = v1;
#pragma unroll
                            for (int i = 0; i < 4; ++i) { VT[(size_t)(c + i) * 1024 + row] = (bf16_t)(cvt_pk_bf16(v0[i], 0.f) & 0xffffu); VT[(size_t)(c + 4 + i) * 1024 + row] = (bf16_t)(cvt_pk_bf16(v1[i], 0.f) & 0xffffu); }
                        }
                    }
                }
        }
    }
    __device__ __forceinline__ void strip(const SAcc& sacc, const Unit& u, int wr, int wc, int fr, int fq) const {
        const int row = u.srow + fr, rs = row - MP;
        float* pbp = (u.pn < 4) ? out + OUT_PBS + ((size_t)(rs >> 2) * PBUF + 11 + (rs & 3)) * PW : nullptr;
#pragma unroll
        for (int bj = 0; bj < 2; ++bj) {
            const int col = u.pn * 256 + bj * 128 + wc * 32 + 8 * fq + 4 * wr;
            st_bf16x4(P + (size_t)row * D + col, sacc[bj]);
            if (pbp) *(f32x4*)(pbp + col) = sacc[bj];
        }
    }
};
struct EpiPool {
    static constexpr bool AFTER_DRAIN = false;
    bf16_t* MIX; const float* scale;
    __device__ __forceinline__ void operator()(const Acc& acc, const Unit& u, int wr, int wc, int fr, int fq) const {
#pragma unroll
        for (int bj = 0; bj < 2; ++bj) {
            const int col = u.pn * 256 + bj * 128 + wc * 32 + 8 * fq;
            const f32x4 s0 = *(const f32x4*)(scale + col), s1 = *(const f32x4*)(scale + col + 4);
#pragma unroll
            for (int ai = 0; ai < 2; ++ai)
#pragma unroll
                for (int m = 0; m < 4; ++m) {
                    const int row = u.pm * 256 + ai * 128 + wr * 64 + m * 16 + fr;
                    st_bf16x8(MIX + (size_t)row * D + col, acc[ai][bj][m][0] * s0, acc[ai][bj][m][1] * s1);
                }
        }
    }
    __device__ __forceinline__ void strip(const SAcc& sacc, const Unit& u, int wr, int wc, int fr, int fq) const {
        const int row = u.srow + fr;
#pragma unroll
        for (int bj = 0; bj < 2; ++bj) {
            const int col = u.pn * 256 + bj * 128 + wc * 32 + 8 * fq + 4 * wr;
            st_bf16x4(MIX + (size_t)row * D + col, sacc[bj] * *(const f32x4*)(scale + col));
        }
    }
};
struct EpiGlu {
    static constexpr bool AFTER_DRAIN = false;
    bf16_t* MIX; const bf16_t* G; const float* bias;
    __device__ __forceinline__ void operator()(const Acc& acc, const Unit& u, int wr, int wc, int fr, int fq) const {
#pragma unroll
        for (int bj = 0; bj < 2; ++bj) {
            const int col = u.pn * 256 + bj * 128 + wc * 32 + 8 * fq;
            const f32x4 b0 = *(const f32x4*)(bias + col), b1 = *(const f32x4*)(bias + col + 4);
#pragma unroll
            for (int ai = 0; ai < 2; ++ai)
#pragma unroll
                for (int m = 0; m < 4; ++m) {
                    const int row = u.pm * 256 + ai * 128 + wr * 64 + m * 16 + fr;
                    const u32x4 gw = *(const u32x4*)(G + (size_t)row * 1024 + col);
                    const f32x4 x0 = acc[ai][bj][m][0] + b0, x1 = acc[ai][bj][m][1] + b1;
                    f32x4 o0, o1;
                    o0[0] = bf_lo(gw.x) * fast_sigmoid(x0[0]); o0[1] = bf_hi(gw.x) * fast_sigmoid(x0[1]); o0[2] = bf_lo(gw.y) * fast_sigmoid(x0[2]); o0[3] = bf_hi(gw.y) * fast_sigmoid(x0[3]);
                    o1[0] = bf_lo(gw.z) * fast_sigmoid(x1[0]); o1[1] = bf_hi(gw.z) * fast_sigmoid(x1[1]); o1[2] = bf_lo(gw.w) * fast_sigmoid(x1[2]); o1[3] = bf_hi(gw.w) * fast_sigmoid(x1[3]);
                    st_bf16x8(MIX + (size_t)row * D + 1024 + col, o0, o1);
                }
        }
    }
    __device__ __forceinline__ void strip(const SAcc& sacc, const Unit& u, int wr, int wc, int fr, int fq) const {
        const int row = u.srow + fr;
#pragma unroll
        for (int bj = 0; bj < 2; ++bj) {
            const int col = u.pn * 256 + bj * 128 + wc * 32 + 8 * fq + 4 * wr;
            const u32x2 gw = *(const u32x2*)(G + (size_t)row * 1024 + col);
            const f32x4 x = sacc[bj] + *(const f32x4*)(bias + col);
            f32x4 o; o[0] = bf_lo(gw.x) * fast_sigmoid(x[0]); o[1] = bf_hi(gw.x) * fast_sigmoid(x[1]); o[2] = bf_lo(gw.y) * fast_sigmoid(x[2]); o[3] = bf_hi(gw.y) * fast_sigmoid(x[3]);
            st_bf16x4(MIX + (size_t)row * D + 1024 + col, o);
        }
    }
};
__device__ __forceinline__ void ld_res8(const float* p, f32x4& a, f32x4& b) { a = *(const f32x4*)p; b = *(const f32x4*)(p + 4); }
__device__ __forceinline__ void ld_res8(const bf16_t* p, f32x4& a, f32x4& b) { const u32x4 w = *(const u32x4*)p; a = (f32x4){bf_lo(w.x), bf_hi(w.x), bf_lo(w.y), bf_hi(w.y)}; b = (f32x4){bf_lo(w.z), bf_hi(w.z), bf_lo(w.w), bf_hi(w.w)}; }
__device__ __forceinline__ f32x4 ld_res4(const float* p) { return *(const f32x4*)p; }
__device__ __forceinline__ f32x4 ld_res4(const bf16_t* p) { const u32x2 w = *(const u32x2*)p; return (f32x4){bf_lo(w.x), bf_hi(w.x), bf_lo(w.y), bf_hi(w.y)}; }
template <class RT>
struct EpiRes {
    static constexpr bool AFTER_DRAIN = false;
    const RT* xin_p; const RT* xin_s; float* xo; bf16_t* xb; float* ss;
    __device__ __forceinline__ void operator()(const Acc& acc, const Unit& u, int wr, int wc, int fr, int fq) const {
        const RT* xin = xin_p;
#pragma unroll
        for (int ai = 0; ai < 2; ++ai)
#pragma unroll
            for (int m = 0; m < 4; ++m) {
                const int row = u.pm * 256 + ai * 128 + wr * 64 + m * 16 + fr;
                float sq = 0.f;
#pragma unroll
                for (int bj = 0; bj < 2; ++bj) {
                    const int col = u.pn * 256 + bj * 128 + wc * 32 + 8 * fq;
                    const size_t off = (size_t)row * D + col;
                    f32x4 r0, r1; ld_res8(xin + off, r0, r1);
                    const f32x4 v0 = acc[ai][bj][m][0] + r0, v1 = acc[ai][bj][m][1] + r1;
                    if (xo) { *(f32x4*)(xo + off) = v0; *(f32x4*)(xo + off + 4) = v1; }
                    if (xb) st_bf16x8(xb + off, v0, v1);
                    sq += (v0[0] * v0[0] + v0[1] * v0[1]) + (v0[2] * v0[2] + v0[3] * v0[3]) + (v1[0] * v1[0] + v1[1] * v1[1]) + (v1[2] * v1[2] + v1[3] * v1[3]);
                }
                sq += __shfl_xor(sq, 16); sq += __shfl_xor(sq, 32);
                if (fq == 0) atomicAdd(ss + row, sq);
            }
    }
    __device__ __forceinline__ void strip(const SAcc& sacc, const Unit& u, int wr, int wc, int fr, int fq) const {
        const int row = u.srow + fr; const RT* xin = xin_s - (size_t)MP * D;
        float sq = 0.f;
#pragma unroll
        for (int bj = 0; bj < 2; ++bj) {
            const int col = u.pn * 256 + bj * 128 + wc * 32 + 8 * fq + 4 * wr;
            const size_t off = (size_t)row * D + col;
            const f32x4 v = sacc[bj] + ld_res4(xin + off);
            if (xo) *(f32x4*)(xo + off) = v;
            if (xb) st_bf16x4(xb + off, v);
            sq += (v[0] * v[0] + v[1] * v[1]) + (v[2] * v[2] + v[3] * v[3]);
        }
        sq += __shfl_xor(sq, 16); sq += __shfl_xor(sq, 32);
        if (fq == 0) atomicAdd(ss + row, sq);
    }
};
struct EpiFinal {
    static constexpr bool AFTER_DRAIN = true;
    const bf16_t* xin; float* out; float* ss; unsigned* cnt; const float* gf;
    __device__ __forceinline__ void operator()(const Acc&, const Unit&, int, int, int, int) const {}
    __device__ __forceinline__ void fused(Acc& acc, f32x4 (&sacc)[2], const Unit& u, int wr, int wc, int fr, int fq, LAS unsigned char* lds, int wid, int lane) const {
#pragma unroll
        for (int ai = 0; ai < 2; ++ai)
#pragma unroll
            for (int m = 0; m < 4; ++m) {
                const int row = u.pm * 256 + ai * 128 + wr * 64 + m * 16 + fr;
                float sq = 0.f;
#pragma unroll
                for (int bj = 0; bj < 2; ++bj) {
                    const size_t off = (size_t)row * D + u.pn * 256 + bj * 128 + wc * 32 + 8 * fq;
                    f32x4 r0, r1; ld_res8(xin + off, r0, r1);
                    const f32x4 v0 = acc[ai][bj][m][0] + r0, v1 = acc[ai][bj][m][1] + r1; acc[ai][bj][m][0] = v0; acc[ai][bj][m][1] = v1;
                    sq += (v0[0] * v0[0] + v0[1] * v0[1]) + (v0[2] * v0[2] + v0[3] * v0[3]) + (v1[0] * v1[0] + v1[1] * v1[1]) + (v1[2] * v1[2] + v1[3] * v1[3]);
                }
                sq += __shfl_xor(sq, 16); sq += __shfl_xor(sq, 32);
                if (fq == 0) { const float old = atomicAdd(ss + row, sq); asm volatile("" :: "v"(old)); }
            }
        const int srow = u.srow + fr;
        {
            float sq = 0.f;
#pragma unroll
            for (int bj = 0; bj < 2; ++bj) {
                const size_t off = (size_t)srow * D + u.pn * 256 + bj * 128 + wc * 32 + 8 * fq + 4 * wr;
                const f32x4 v = sacc[bj] + ld_res4(xin + off); sacc[bj] = v;
                sq += (v[0] * v[0] + v[1] * v[1]) + (v[2] * v[2] + v[3] * v[3]);
            }
            sq += __shfl_xor(sq, 16); sq += __shfl_xor(sq, 32);
            if (fq == 0) { const float old = atomicAdd(ss + srow, sq); asm volatile("" :: "v"(old)); }
        }
        asm volatile("s_waitcnt vmcnt(0)" ::: "memory");
        __builtin_amdgcn_s_barrier();
        if (wid == 0 && lane == 0) {
            unsigned* cw = cnt + 64 * u.pm;
            __hip_atomic_fetch_add(cw, 1u, __ATOMIC_RELEASE, __HIP_MEMORY_SCOPE_AGENT);
            unsigned sp = 0;
            while (__hip_atomic_load(cw, __ATOMIC_RELAXED, __HIP_MEMORY_SCOPE_AGENT) < 8u) { __builtin_amdgcn_s_sleep(1); if (++sp > (1u << 22)) break; }
            __builtin_amdgcn_fence(__ATOMIC_ACQUIRE, "agent");
            asm volatile("s_waitcnt vmcnt(0)" ::: "memory");
        }
        __builtin_amdgcn_s_barrier(); asm volatile("" ::: "memory");
        f32x4 g0[2], g1[2];
#pragma unroll
        for (int bj = 0; bj < 2; ++bj) { const int col = u.pn * 256 + bj * 128 + wc * 32 + 8 * fq; g0[bj] = *(const f32x4*)(gf + col); g1[bj] = *(const f32x4*)(gf + col + 4); }
#pragma unroll
        for (int ai = 0; ai < 2; ++ai)
#pragma unroll
            for (int m = 0; m < 4; ++m) {
                const int row = u.pm * 256 + ai * 128 + wr * 64 + m * 16 + fr;
                const float rs = rsqrtf(__hip_atomic_load(ss + row, __ATOMIC_RELAXED, __HIP_MEMORY_SCOPE_AGENT) * (1.0f / D) + EPS);
#pragma unroll
                for (int bj = 0; bj < 2; ++bj) {
                    const size_t off = (size_t)row * D + u.pn * 256 + bj * 128 + wc * 32 + 8 * fq;
                    *(f32x4*)(out + off) = acc[ai][bj][m][0] * rs * g0[bj]; *(f32x4*)(out + off + 4) = acc[ai][bj][m][1] * rs * g1[bj];
                }
            }
        {
            const float rs = rsqrtf(__hip_atomic_load(ss + srow, __ATOMIC_RELAXED, __HIP_MEMORY_SCOPE_AGENT) * (1.0f / D) + EPS);
#pragma unroll
            for (int bj = 0; bj < 2; ++bj) {
                const int col = u.pn * 256 + bj * 128 + wc * 32 + 8 * fq + 4 * wr;
                *(f32x4*)(out + (size_t)srow * D + col) = sacc[bj] * rs * *(const f32x4*)(gf + col);
            }
        }
    }
};
struct EpiQ {
    static constexpr bool AFTER_DRAIN = false;
    bf16_t* Q; const float* ss;
    __device__ __forceinline__ void operator()(const Acc& acc, const Unit& u, int wr, int wc, int fr, int fq) const {
#pragma unroll
        for (int ai = 0; ai < 2; ++ai)
#pragma unroll
            for (int m = 0; m < 4; ++m) {
                const int row = u.pm * 256 + ai * 128 + wr * 64 + m * 16 + fr;
                const float rs = rsqrtf(ss[row] * (1.0f / D) + EPS);
#pragma unroll
                for (int bj = 0; bj < 2; ++bj) {
                    const int col = u.pn * 256 + bj * 128 + wc * 32 + 8 * fq;
                    st_bf16x8(Q + (size_t)row * D + col, acc[ai][bj][m][0] * rs, acc[ai][bj][m][1] * rs);
                }
            }
    }
    __device__ __forceinline__ void strip(const SAcc& sacc, const Unit& u, int wr, int wc, int fr, int fq) const {
        const int row = u.srow + fr; const float rs = rsqrtf(ss[row] * (1.0f / D) + EPS);
#pragma unroll
        for (int bj = 0; bj < 2; ++bj) st_bf16x4(Q + (size_t)row * D + u.pn * 256 + bj * 128 + wc * 32 + 8 * fq + 4 * wr, sacc[bj] * rs);
    }
};
struct EpiGateUp {
    static constexpr bool AFTER_DRAIN = false;
    bf16_t* H; const float* ss;
    __device__ __forceinline__ void operator()(const Acc& acc, const Unit& u, int wr, int wc, int fr, int fq) const {
        const int col = u.pn * 128 + wc * 32 + 8 * fq;
#pragma unroll
        for (int ai = 0; ai < 2; ++ai)
#pragma unroll
            for (int m = 0; m < 4; ++m) {
                const int row = u.pm * 256 + ai * 128 + wr * 64 + m * 16 + fr;
                const float rs = rsqrtf(ss[row] * (1.0f / D) + EPS);
                f32x4 o[2];
#pragma unroll
                for (int n = 0; n < 2; ++n)
#pragma unroll
                    for (int j = 0; j < 4; ++j) { const float gt = acc[ai][0][m][n][j] * rs, up = acc[ai][1][m][n][j] * rs; o[n][j] = gt * fast_sigmoid(gt) * up; }
                st_bf16x8(H + (size_t)row * FF + col, o[0], o[1]);
            }
    }
    __device__ __forceinline__ void strip(const SAcc& sacc, const Unit& u, int wr, int wc, int fr, int fq) const {
        const int row = u.srow + fr; const float rs = rsqrtf(ss[row] * (1.0f / D) + EPS);
        f32x4 o;
#pragma unroll
        for (int j = 0; j < 4; ++j) { const float gt = sacc[0][j] * rs, up = sacc[1][j] * rs; o[j] = gt * fast_sigmoid(gt) * up; }
        st_bf16x4(H + (size_t)row * FF + u.pn * 128 + wc * 32 + 8 * fq + 4 * wr, o);
    }
};
struct EpiPV {
    static constexpr bool AFTER_DRAIN = false;
    bf16_t* ATT;
    __device__ __forceinline__ void operator()(const Acc& acc, const Unit& u, int wr, int wc, int fr, int fq) const {
#pragma unroll
        for (int ai = 0; ai < 2; ++ai)
#pragma unroll
            for (int m = 0; m < 4; ++m) {
                const int row = u.pm * 256 + ai * 128 + wr * 64 + m * 16 + fr;
#pragma unroll
                for (int bj = 0; bj < 2; ++bj) {
                    const int col = u.pn * 256 + bj * 128 + wc * 32 + 8 * fq;
                    st_bf16x8(ATT + (size_t)row * D + col, acc[ai][bj][m][0], acc[ai][bj][m][1]);
                }
            }
    }
};
struct EpiSoftmax {
    static constexpr bool AFTER_DRAIN = true;
    bf16_t* PR;
    __device__ __forceinline__ void operator()(const Acc&, const Unit&, int, int, int, int) const {}
    __device__ __forceinline__ void fused(Acc& acc, f32x4 (&)[2], const Unit& u, int wr, int wc, int fr, int fq, LAS unsigned char* lds, int wid, int lane) const {
        LAS float* MX = (LAS float*)lds;
        LAS float* SM = (LAS float*)(lds + 4096);
#pragma unroll
        for (int ai = 0; ai < 2; ++ai)
#pragma unroll
            for (int m = 0; m < 4; ++m) {
                float mx = -3.0e38f;
#pragma unroll
                for (int bj = 0; bj < 2; ++bj)
#pragma unroll
                    for (int n = 0; n < 2; ++n)
#pragma unroll
                        for (int j = 0; j < 4; ++j) mx = fmaxf(mx, acc[ai][bj][m][n][j]);
                mx = fmaxf(mx, __shfl_xor(mx, 16)); mx = fmaxf(mx, __shfl_xor(mx, 32));
                if (fq == 0) MX[(ai * 128 + wr * 64 + m * 16 + fr) * 4 + wc] = mx;
            }
        LDS_WAIT(); __builtin_amdgcn_s_barrier(); asm volatile("" ::: "memory");
#pragma unroll
        for (int ai = 0; ai < 2; ++ai)
#pragma unroll
            for (int m = 0; m < 4; ++m) {
                const int r = ai * 128 + wr * 64 + m * 16 + fr;
                const f32x4 mv = *(const LAS f32x4*)(MX + r * 4);
                const float mx = fmaxf(fmaxf(mv[0], mv[1]), fmaxf(mv[2], mv[3]));
                float sm = 0.f;
#pragma unroll
                for (int bj = 0; bj < 2; ++bj)
#pragma unroll
                    for (int n = 0; n < 2; ++n)
#pragma unroll
                        for (int j = 0; j < 4; ++j) { const float e = __expf(acc[ai][bj][m][n][j] - mx); acc[ai][bj][m][n][j] = e; sm += e; }
                sm += __shfl_xor(sm, 16); sm += __shfl_xor(sm, 32);
                if (fq == 0) SM[r * 4 + wc] = sm;
            }
        LDS_WAIT(); __builtin_amdgcn_s_barrier(); asm volatile("" ::: "memory");
#pragma unroll
        for (int ai = 0; ai < 2; ++ai)
#pragma unroll
            for (int m = 0; m < 4; ++m) {
                const int r = ai * 128 + wr * 64 + m * 16 + fr;
                const f32x4 sv = *(const LAS f32x4*)(SM + r * 4);
                const float inv = __builtin_amdgcn_rcpf((sv[0] + sv[1]) + (sv[2] + sv[3]));
#pragma unroll
                for (int bj = 0; bj < 2; ++bj) {
                    const int col = bj * 128 + wc * 32 + 8 * fq;
                    st_bf16x8(PR + ((size_t)u.job * SEQ + u.pm * 256 + r) * 256 + col, acc[ai][bj][m][0] * inv, acc[ai][bj][m][1] * inv);
                }
            }
        LDS_WAIT(); __builtin_amdgcn_s_barrier(); asm volatile("" ::: "memory");
    }
};
}
using pg8::Unit;

enum { I_XP = 0, I_XS = 1, I_MEM = 2, I_PBUF = 3, I_SRE = 4, I_SIM = 5, I_CK = 6, I_CV = 7, I_GMIX = 8, I_WIN = 9, I_WPOOL = 10, I_PSCALE = 11,
       I_LRE = 12, I_LIM = 13, I_LSTEP = 14, I_BRE = 15, I_BIM = 16, I_CRE = 17, I_CIM = 18, I_SSMD = 19, I_WGLU = 20, I_BGLU = 21, I_WOUT = 22,
       I_GCROSS = 23, I_GMEM = 24, I_WQ = 25, I_WK = 26, I_WV = 27, I_WO = 28, I_GFFN = 29, I_WGATE = 30, I_WUP = 31, I_WDOWN = 32, I_GFINAL = 33 };
struct Args {
    const float* in[34];
    float* out; unsigned char* ws;
};

struct CvItem { const float* src; bf16_t* dst; const float* gk; float sc; int N, ldt; };
__device__ __forceinline__ void cv_load(const CvItem& it, f32x4 (&v)[8], float (&g)[8], int lane) {
#pragma unroll
    for (int i = 0; i < 8; ++i) { const int kk = (lane >> 3) + 8 * i; v[i] = *(const f32x4*)(it.src + (size_t)kk * it.N + 4 * (lane & 7)); g[i] = it.gk ? it.gk[kk] : 1.0f; }
}
__device__ __forceinline__ void cv_finish(const CvItem& it, const f32x4 (&v)[8], const float (&g)[8], LAS float* scr, int lane) {
#pragma unroll
    for (int i = 0; i < 8; ++i) { const int kk = (lane >> 3) + 8 * i; const float m = g[i] * it.sc; LAS float* d = scr + kk * 33 + 4 * (lane & 7);
        d[0] = v[i][0] * m; d[1] = v[i][1] * m; d[2] = v[i][2] * m; d[3] = v[i][3] * m; }
    LDS_WAIT(); __builtin_amdgcn_wave_barrier();
    const int c = lane & 7;
#pragma unroll
    for (int j = 0; j < 4; ++j) { const int n = (lane >> 3) + 8 * j; const LAS float* q = scr + (8 * c) * 33 + n;
        u32x4 o; o.x = cvt_pk_bf16(q[0 * 33], q[1 * 33]); o.y = cvt_pk_bf16(q[2 * 33], q[3 * 33]); o.z = cvt_pk_bf16(q[4 * 33], q[5 * 33]); o.w = cvt_pk_bf16(q[6 * 33], q[7 * 33]);
        *(u32x4*)(it.dst + (size_t)n * it.ldt + 8 * c) = o; }
    LDS_WAIT(); __builtin_amdgcn_wave_barrier();
}
__device__ __forceinline__ void rms_row_to_bf16(const float* xrow, const float* g, bf16_t* orow, int lane) {
    const f32x4* xr = (const f32x4*)xrow + lane; const f32x4* gr = (const f32x4*)g + lane;
    f32x4 v[8]; float s = 0.f;
#pragma unroll
    for (int j = 0; j < 8; ++j) { v[j] = xr[64 * j]; s += (v[j][0] * v[j][0] + v[j][1] * v[j][1]) + (v[j][2] * v[j][2] + v[j][3] * v[j][3]); }
    const float rstd = rsqrtf(wave_sum(s) * (1.0f / D) + EPS);
    u32x2* o8 = (u32x2*)orow + lane;
#pragma unroll
    for (int j = 0; j < 8; ++j) { const f32x4 gg = gr[64 * j]; u32x2 w; w.x = cvt_pk_bf16(v[j][0] * rstd * gg[0], v[j][1] * rstd * gg[1]); w.y = cvt_pk_bf16(v[j][2] * rstd * gg[2], v[j][3] * rstd * gg[3]); o8[64 * j] = w; }
}
__device__ __forceinline__ void cmul(float ar, float ai, float br, float bi, float& cr, float& ci) { cr = ar * br - ai * bi; ci = ar * bi + ai * br; }

__device__ __forceinline__ void ssm_chan(const float* lam_re, const float* lam_im, float delta, int g, int ch, float& ar, float& ai, float& kr, float& ki) {
    const float lr = lam_re[g * 64 + ch], li = lam_im[g * 64 + ch];
    const float mag = expf(lr * delta);
    double rev = (double)li * (double)delta * 0.15915494309189535; rev -= __builtin_rint(rev);
    const float rv = (float)rev;
    ar = mag * __builtin_amdgcn_cosf(rv); ai = mag * __builtin_amdgcn_sinf(rv);
    const float nr = ar - 1.0f, ni = ai, den = 1.0f / (lr * lr + li * li);
    kr = (nr * lr + ni * li) * den; ki = (ni * lr - nr * li) * den;
}

__device__ __forceinline__ void ssm_tables(const Args& A, int g, int lane) {
    const float* lam_re = A.in[I_LRE]; const float* lam_im = A.in[I_LIM]; const float* log_step = A.in[I_LSTEP];
    const float* b_re = A.in[I_BRE]; const float* b_im = A.in[I_BIM]; const float* c_re = A.in[I_CRE]; const float* c_im = A.in[I_CIM];
    float* ABAR = (float*)(A.ws + O_ABAR); bf16_t* BB = (bf16_t*)(A.ws + O_BB); bf16_t* CM = (bf16_t*)(A.ws + O_CM);
    const float delta = expf(log_step[g]);
    {
        float ar, ai, kr, ki; ssm_chan(lam_re, lam_im, delta, g, lane, ar, ai, kr, ki);
        float pr = ar, pi = ai;
#pragma unroll
        for (int s = 0; s < 7; ++s) { float tr, ti; cmul(pr, pi, pr, pi, tr, ti); pr = tr; pi = ti; }
        *(f32x4*)(ABAR + ((size_t)g * 64 + lane) * 4) = (f32x4){ar, ai, pr, pi};
    }
    {
        const int j = lane & 31, hi = lane >> 5;
#pragma unroll
        for (int half = 0; half < 2; ++half) {
            const int ch = j + 32 * half; float ar, ai, kr, ki; ssm_chan(lam_re, lam_im, delta, g, ch, ar, ai, kr, ki);
            float vr[8], vi[8];
#pragma unroll
            for (int i = 0; i < 8; ++i) { const int c = 8 * hi + i; const float br = b_re[((size_t)g * 64 + ch) * 16 + c], bi = b_im[((size_t)g * 64 + ch) * 16 + c]; cmul(kr, ki, br, bi, vr[i], vi[i]); }
            u32x4 wr_, wi_;
            wr_.x = cvt_pk_bf16(vr[0], vr[1]); wr_.y = cvt_pk_bf16(vr[2], vr[3]); wr_.z = cvt_pk_bf16(vr[4], vr[5]); wr_.w = cvt_pk_bf16(vr[6], vr[7]);
            wi_.x = cvt_pk_bf16(vi[0], vi[1]); wi_.y = cvt_pk_bf16(vi[2], vi[3]); wi_.z = cvt_pk_bf16(vi[4], vi[5]); wi_.w = cvt_pk_bf16(vi[6], vi[7]);
            *(u32x4*)(BB + (((size_t)g * 4 + half) * 64 + lane) * 8) = wr_;
            *(u32x4*)(BB + (((size_t)g * 4 + 2 + half) * 64 + lane) * 8) = wi_;
        }
    }
    {
        const int c = lane & 15, fq = lane >> 4;
#pragma unroll
        for (int ks = 0; ks < 4; ++ks) {
            float v[8];
#pragma unroll
            for (int i = 0; i < 8; ++i) { const int k = 32 * ks + 8 * fq + i, jj = k >> 2, sel = k & 3, ch = jj + 32 * (sel >> 1);
                v[i] = (sel & 1) ? -c_im[((size_t)g * 16 + c) * 64 + ch] : c_re[((size_t)g * 16 + c) * 64 + ch]; }
            u32x4 w; w.x = cvt_pk_bf16(v[0], v[1]); w.y = cvt_pk_bf16(v[2], v[3]); w.z = cvt_pk_bf16(v[4], v[5]); w.w = cvt_pk_bf16(v[6], v[7]);
            *(u32x4*)(CM + (((size_t)g * 4 + ks) * 64 + lane) * 8) = w;
        }
    }
}

constexpr int I_SQ = (D / 64) * (D / 32);
constexpr int I_POOL = 4 * (256 / 64) * (256 / 32);
constexpr int I_GLU = (1024 / 64) * (1024 / 32);
constexpr int I_FF = (D / 64) * (FF / 32);
constexpr int I_DN = (FF / 64) * (D / 32);
constexpr int NITEMS = 6 * I_SQ + I_POOL + I_GLU + 2 * I_FF + I_DN, NEARLY = 3 * I_SQ;
__device__ __forceinline__ CvItem cv_decode(const Args& A, int r) {
    unsigned char* ws = A.ws; CvItem it; it.gk = nullptr; it.sc = 1.f;
    const float* W; bf16_t* WT; int N, ldt, k0, n0, row0; const float* gkb = nullptr;
    if (r < 6 * I_SQ) {
        const int mtx = r / I_SQ; r -= mtx * I_SQ; const int kb = r / (D / 32), nb = r % (D / 32);
        N = D; ldt = D; k0 = 64 * kb; n0 = 32 * nb; row0 = n0;
        switch (mtx) {
            case 0: W = A.in[I_WIN]; WT = (bf16_t*)(ws + O_WIN); break;
            case 1: W = A.in[I_WK]; WT = (bf16_t*)(ws + O_WKV); break;
            case 2: W = A.in[I_WV]; WT = (bf16_t*)(ws + O_WKV); row0 += D; break;
            case 3: W = A.in[I_WOUT]; WT = (bf16_t*)(ws + O_WOUT); break;
            case 4: W = A.in[I_WQ]; WT = (bf16_t*)(ws + O_WQ); gkb = A.in[I_GCROSS]; it.sc = 0.04419417382415922f; break;
            default: W = A.in[I_WO]; WT = (bf16_t*)(ws + O_WO); break;
        }
    } else if ((r -= 6 * I_SQ) < I_POOL) {
        const int gg = r / 32, q = r % 32, kb = q / 8, nb = q % 8;
        W = A.in[I_WPOOL] + (size_t)gg * 65536; WT = (bf16_t*)(ws + O_WPOOL); N = 256; ldt = 256; k0 = 64 * kb; n0 = 32 * nb; row0 = gg * 256 + n0;
    } else if ((r -= I_POOL) < I_GLU) {
        const int kb = r / 32, nb = r % 32; W = A.in[I_WGLU]; WT = (bf16_t*)(ws + O_WGLU); N = 1024; ldt = 1024; k0 = 64 * kb; n0 = 32 * nb; row0 = n0;
    } else if ((r -= I_GLU) < 2 * I_FF) {
        const int up = r / I_FF; r -= up * I_FF; const int kb = r / (FF / 32), nb = r % (FF / 32);
        W = up ? A.in[I_WUP] : A.in[I_WGATE]; WT = (bf16_t*)(ws + O_WGU); N = FF; ldt = D; k0 = 64 * kb; n0 = 32 * nb; row0 = (n0 >> 7) * 256 + up * 128 + (n0 & 127); gkb = A.in[I_GFFN];
    } else {
        r -= 2 * I_FF; const int kb = r / (D / 32), nb = r % (D / 32);
        W = A.in[I_WDOWN]; WT = (bf16_t*)(ws + O_WDN); N = D; ldt = FF; k0 = 64 * kb; n0 = 32 * nb; row0 = n0;
    }
    it.src = W + (size_t)k0 * N + n0; it.dst = WT + (size_t)row0 * ldt + k0; it.gk = gkb ? gkb + k0 : nullptr; it.N = N; it.ldt = ldt;
    return it;
}
__device__ __forceinline__ void convert_weights(const Args& A, LAS unsigned char* lds, int lo, int hi, int gw, int NGW, const int wv) {
    const int tid = opaque_tid(wv), lane = tid & 63, wave = __builtin_amdgcn_readfirstlane(tid >> 6);
    LAS float* scr = (LAS float*)(lds + wave * 16384);
    if (gw < 0) return;
    int it = lo + gw; if (it >= hi) return;
    CvItem cur = cv_decode(A, it); f32x4 va[8]; float ga[8]; cv_load(cur, va, ga, lane);
    for (;;) {
        const int nit = it + NGW; const bool hn = nit < hi;
        CvItem nx = cur; f32x4 vb[8]; float gb[8];
        if (hn) { nx = cv_decode(A, nit); cv_load(nx, vb, gb, lane); }
        cv_finish(cur, va, ga, scr, lane);
        if (!hn) break;
        cur = nx; it = nit;
#pragma unroll
        for (int i = 0; i < 8; ++i) { va[i] = vb[i]; ga[i] = gb[i]; }
    }
}
__device__ __forceinline__ const float* p0_src(const Args& A, int m) { return m < MP ? A.in[I_XP] + (size_t)m * D : (m < M ? A.in[I_XS] + (size_t)(m - MP) * D : A.in[I_MEM] + (size_t)(m - M) * D); }
__device__ __forceinline__ void phase0_rest(const Args& A, int G, const int wv) {
    const int tid = opaque_tid(wv), lane = tid & 63, wave = __builtin_amdgcn_readfirstlane(tid >> 6);
    const int gw = blockIdx.x * 8 + wave, NGW = G * 8;
    unsigned char* ws = A.ws;
    {
        int m = gw;
        if (m < M + 1024) {
            f32x4 v[8];
            { const f32x4* xr = (const f32x4*)p0_src(A, m) + lane;
#pragma unroll
              for (int jj = 0; jj < 8; ++jj) v[jj] = xr[64 * jj]; }
            for (;;) {
                const int nm = m + NGW; const bool hn = nm < M + 1024;
                f32x4 nv[8];
                if (hn) { const f32x4* xr = (const f32x4*)p0_src(A, nm) + lane;
#pragma unroll
                    for (int jj = 0; jj < 8; ++jj) nv[jj] = xr[64 * jj]; }
                float sq = 0.f;
#pragma unroll
                for (int jj = 0; jj < 8; ++jj) sq += (v[jj][0] * v[jj][0] + v[jj][1] * v[jj][1]) + (v[jj][2] * v[jj][2] + v[jj][3] * v[jj][3]);
                const float rstd = rsqrtf(wave_sum(sq) * (1.0f / D) + EPS);
                const f32x4* gr = (const f32x4*)(m < M ? A.in[I_GMIX] : A.in[I_GMEM]) + lane;
                u32x2* o8 = (u32x2*)(m < M ? (bf16_t*)(ws + O_HMIX) + (size_t)m * D : (bf16_t*)(ws + O_MN) + (size_t)(m - M) * D) + lane;
#pragma unroll
                for (int jj = 0; jj < 8; ++jj) { const f32x4 gg = gr[64 * jj]; u32x2 wq; wq.x = cvt_pk_bf16(v[jj][0] * rstd * gg[0], v[jj][1] * rstd * gg[1]); wq.y = cvt_pk_bf16(v[jj][2] * rstd * gg[2], v[jj][3] * rstd * gg[3]); o8[64 * jj] = wq; }
                if (!hn) break;
#pragma unroll
                for (int jj = 0; jj < 8; ++jj) v[jj] = nv[jj];
                m = nm;
            }
        }
    }
    for (int g = gw; g < NG; g += NGW) ssm_tables(A, g, lane);
    {
        const f32x4* src = (const f32x4*)A.in[I_PBUF]; f32x4* dst = (f32x4*)(A.out + OUT_PBS);
        const int total = DB * 11 * (PW / 4);
        for (int i = blockIdx.x * 512 + tid; i < total; i += G * 512) { const int b = i / (11 * 256), r = i % (11 * 256); dst[(size_t)b * (15 * 256) + r] = src[(size_t)b * (15 * 256) + 4 * 256 + r]; }
    }
}

__device__ __forceinline__ void acc8(float (&s)[8], u32x4 w) {
    s[0] += bf_lo(w.x); s[1] += bf_hi(w.x); s[2] += bf_lo(w.y); s[3] += bf_hi(w.y); s[4] += bf_lo(w.z); s[5] += bf_hi(w.z); s[6] += bf_lo(w.w); s[7] += bf_hi(w.w);
}
template <int W>
__device__ __forceinline__ void pooled_prompt_item(const bf16_t* P, bf16_t* PO, int row0, int col) {
    const int t0 = row0 & (SEQ - 1);
    u32x4 z[W + 7];
#pragma unroll
    for (int i = 0; i < W + 7; ++i) {
        const int t = t0 - (W - 1) + i;
        z[i] = (u32x4){0u, 0u, 0u, 0u};
        if (t >= 0) z[i] = *(const u32x4*)(P + (size_t)(row0 - (W - 1) + i) * D + col);
    }
    float s[8] = {0.f, 0.f, 0.f, 0.f, 0.f, 0.f, 0.f, 0.f};
#pragma unroll
    for (int i = 0; i < W - 1; ++i) acc8(s, z[i]);
#pragma unroll
    for (int o = 0; o < 8; ++o) {
        const u32x4 uw = z[o + W - 1];
        acc8(s, uw);
        const int n = (t0 + o + 1 < W) ? t0 + o + 1 : W; const float ic = 1.0f / (float)n;
        u32x4 ow;
        ow.x = cvt_pk_bf16(s[0] * ic - bf_lo(uw.x), s[1] * ic - bf_hi(uw.x)); ow.y = cvt_pk_bf16(s[2] * ic - bf_lo(uw.y), s[3] * ic - bf_hi(uw.y));
        ow.z = cvt_pk_bf16(s[4] * ic - bf_lo(uw.z), s[5] * ic - bf_hi(uw.z)); ow.w = cvt_pk_bf16(s[6] * ic - bf_lo(uw.w), s[7] * ic - bf_hi(uw.w));
        *(u32x4*)(PO + (size_t)(row0 + o) * 1024 + col) = ow;
        const u32x4 zo = z[o];
        s[0] -= bf_lo(zo.x); s[1] -= bf_hi(zo.x); s[2] -= bf_lo(zo.y); s[3] -= bf_hi(zo.y); s[4] -= bf_lo(zo.z); s[5] -= bf_hi(zo.z); s[6] -= bf_lo(zo.w); s[7] -= bf_hi(zo.w);
    }
}
template <int W>
__device__ __forceinline__ void pooled_sample_item(const bf16_t* P, bf16_t* PO, const float* sbuf, int b, int col) {
    float h[W - 1][8];
#pragma unroll
    for (int i = 0; i < W - 1; ++i) { const float* q = sbuf + ((size_t)b * PBUF + (PBUF - (W - 1) + i)) * PW + col; const f32x4 a = *(const f32x4*)q, c = *(const f32x4*)(q + 4);
        h[i][0] = a[0]; h[i][1] = a[1]; h[i][2] = a[2]; h[i][3] = a[3]; h[i][4] = c[0]; h[i][5] = c[1]; h[i][6] = c[2]; h[i][7] = c[3]; }
    u32x4 z[4];
#pragma unroll
    for (int t = 0; t < 4; ++t) z[t] = *(const u32x4*)(P + ((size_t)MP + b * 4 + t) * D + col);
    float s[8] = {0.f, 0.f, 0.f, 0.f, 0.f, 0.f, 0.f, 0.f};
#pragma unroll
    for (int i = 0; i < W - 1; ++i)
#pragma unroll
        for (int j = 0; j < 8; ++j) s[j] += h[i][j];
    const float ic = 1.0f / (float)W;
#pragma unroll
    for (int t = 0; t < 4; ++t) {
        const u32x4 uw = z[t];
        acc8(s, uw);
        u32x4 o;
        o.x = cvt_pk_bf16(s[0] * ic - bf_lo(uw.x), s[1] * ic - bf_hi(uw.x)); o.y = cvt_pk_bf16(s[2] * ic - bf_lo(uw.y), s[3] * ic - bf_hi(uw.y));
        o.z = cvt_pk_bf16(s[4] * ic - bf_lo(uw.z), s[5] * ic - bf_hi(uw.z)); o.w = cvt_pk_bf16(s[6] * ic - bf_lo(uw.w), s[7] * ic - bf_hi(uw.w));
        *(u32x4*)(PO + ((size_t)MP + b * 4 + t) * 1024 + col) = o;
        if (t < W - 1) {
#pragma unroll
            for (int j = 0; j < 8; ++j) s[j] -= h[t < W - 1 ? t : 0][j];
        } else {
            const u32x4 zo = z[t - (W - 1) >= 0 ? t - (W - 1) : 0];
            s[0] -= bf_lo(zo.x); s[1] -= bf_hi(zo.x); s[2] -= bf_lo(zo.y); s[3] -= bf_hi(zo.y); s[4] -= bf_lo(zo.z); s[5] -= bf_hi(zo.z); s[6] -= bf_lo(zo.w); s[7] -= bf_hi(zo.w);
        }
    }
}
__device__ __forceinline__ void pooled_phase(const Args& A, int G, const int wv) {
    const bf16_t* P = (const bf16_t*)(A.ws + O_P); bf16_t* PO = (bf16_t*)(A.ws + O_POOLED); const float* sbuf = A.in[I_PBUF];
    const int tid0 = blockIdx.x * 512 + opaque_tid(wv);
    for (int it = tid0; it < 4 * 1024 * 32; it += G * 512) {
        const int g = it >> 15, rb = (it >> 5) & 1023, col = g * 256 + (it & 31) * 8, row0 = rb * 8;
        if (g == 0) pooled_prompt_item<2>(P, PO, row0, col); else if (g == 1) pooled_prompt_item<4>(P, PO, row0, col);
        else if (g == 2) pooled_prompt_item<8>(P, PO, row0, col); else pooled_prompt_item<16>(P, PO, row0, col);
    }
    for (int it = tid0; it < 4 * DB * 32; it += G * 512) {
        const int g = it >> 12, b = (it >> 5) & (DB - 1), col = g * 256 + (it & 31) * 8;
        if (g == 0) pooled_sample_item<2>(P, PO, sbuf, b, col); else if (g == 1) pooled_sample_item<4>(P, PO, sbuf, b, col);
        else if (g == 2) pooled_sample_item<8>(P, PO, sbuf, b, col); else pooled_sample_item<16>(P, PO, sbuf, b, col);
    }
}

struct SsmCtx {
    bf16x8 BB[4], CMf[4];
    float a[4];
    float dsk[4];
    float s[4];
};
template <int MODE>
__device__ __forceinline__ void ssm_sub(SsmCtx& cx, const bf16_t* P, bf16_t* Gout, int g, const bf16x8 af  ,
                                        const size_t (&yrow)[2]  , LAS unsigned char* tile, int lane,
                                        const float* h_re, const float* h_im, float* o_re, float* o_im, int sbatch0  ) {
    const int j = lane & 31, hi = lane >> 5, fr = lane & 15, fq = lane >> 4;
    u32x2 uwp[2] = {(u32x2){0u, 0u}, (u32x2){0u, 0u}};
    if (MODE != 0) { uwp[0] = *(const u32x2*)(P + yrow[0] * D + 1024 + 16 * g + 4 * fq); uwp[1] = *(const u32x2*)(P + yrow[1] * D + 1024 + 16 * g + 4 * fq); }
    float hs[4][4];
    if (MODE == 2) {
#pragma unroll
        for (int q = 0; q < 4; ++q) { const size_t o = ((size_t)(sbatch0 + q) * NG + g) * 64 + j; hs[q][0] = h_re[o]; hs[q][1] = h_im[o]; hs[q][2] = h_re[o + 32]; hs[q][3] = h_im[o + 32]; }
    }
    const f32x16 z = {0.f, 0.f, 0.f, 0.f, 0.f, 0.f, 0.f, 0.f, 0.f, 0.f, 0.f, 0.f, 0.f, 0.f, 0.f, 0.f};
    const f32x16 r0 = __builtin_amdgcn_mfma_f32_32x32x16_bf16(af, cx.BB[0], z, 0, 0, 0);
    const f32x16 r1 = __builtin_amdgcn_mfma_f32_32x32x16_bf16(af, cx.BB[1], z, 0, 0, 0);
    const f32x16 i0 = __builtin_amdgcn_mfma_f32_32x32x16_bf16(af, cx.BB[2], z, 0, 0, 0);
    const f32x16 i1 = __builtin_amdgcn_mfma_f32_32x32x16_bf16(af, cx.BB[3], z, 0, 0, 0);
    float sr0 = cx.s[0], si0 = cx.s[1], sr1 = cx.s[2], si1 = cx.s[3];
    const float ar0 = cx.a[0], ai0 = cx.a[1], ar1 = cx.a[2], ai1 = cx.a[3];
#pragma unroll
    for (int r = 0; r < 16; ++r) {
        if (MODE == 2 && (r & 3) == 0) { sr0 = hs[r >> 2][0]; si0 = hs[r >> 2][1]; sr1 = hs[r >> 2][2]; si1 = hs[r >> 2][3]; }
        const float nr0 = fmaf(ar0, sr0, fmaf(-ai0, si0, r0[r])), ni0 = fmaf(ar0, si0, fmaf(ai0, sr0, i0[r]));
        const float nr1 = fmaf(ar1, sr1, fmaf(-ai1, si1, r1[r])), ni1 = fmaf(ar1, si1, fmaf(ai1, sr1, i1[r]));
        sr0 = nr0; si0 = ni0; sr1 = nr1; si1 = ni1;
        if (MODE != 0) { u32x2 w; w.x = cvt_pk_bf16(sr0, si0); w.y = cvt_pk_bf16(sr1, si1); *(LAS u32x2*)(tile + (16 * hi + r) * 272 + 8 * j) = w; }
        if (MODE == 2 && (r & 3) == 3) {
            const size_t o = ((size_t)(sbatch0 + (r >> 2)) * NG + g) * 64 + j;
            o_re[o] = sr0; o_im[o] = si0; o_re[o + 32] = sr1; o_im[o + 32] = si1;
        }
    }
    cx.s[0] = sr0; cx.s[1] = si0; cx.s[2] = sr1; cx.s[3] = si1;
    if (MODE != 0) {
        LDS_WAIT(); __builtin_amdgcn_wave_barrier();
#pragma unroll
        for (int tg = 0; tg < 2; ++tg) {
            f32x4 y = {0.f, 0.f, 0.f, 0.f};
#pragma unroll
            for (int ks = 0; ks < 4; ++ks) {
                const bf16x8 sf = *(const LAS bf16x8*)(tile + (16 * tg + fr) * 272 + (32 * ks + 8 * fq) * 2);
                y = __builtin_amdgcn_mfma_f32_16x16x32_bf16(cx.CMf[ks], sf, y, 0, 0, 0);
            }
            const u32x2 uw = uwp[tg];
            const float y0 = gelu_tanh(y[0] + cx.dsk[0] * bf_lo(uw.x)), y1 = gelu_tanh(y[1] + cx.dsk[1] * bf_hi(uw.x));
            const float y2 = gelu_tanh(y[2] + cx.dsk[2] * bf_lo(uw.y)), y3 = gelu_tanh(y[3] + cx.dsk[3] * bf_hi(uw.y));
            u32x2 o; o.x = cvt_pk_bf16(y0, y1); o.y = cvt_pk_bf16(y2, y3);
            *(u32x2*)(Gout + yrow[tg] * 1024 + 16 * g + 4 * fq) = o;
        }
    }
}

__device__ __forceinline__ void ssm_load_ctx(SsmCtx& cx, const Args& A, int g, int lane) {
    const bf16_t* BB = (const bf16_t*)(A.ws + O_BB); const bf16_t* CM = (const bf16_t*)(A.ws + O_CM); const float* ABAR = (const float*)(A.ws + O_ABAR);
    const int j = lane & 31, fq = lane >> 4;
#pragma unroll
    for (int i = 0; i < 4; ++i) { cx.BB[i] = *(const bf16x8*)(BB + (((size_t)g * 4 + i) * 64 + lane) * 8); cx.CMf[i] = *(const bf16x8*)(CM + (((size_t)g * 4 + i) * 64 + lane) * 8); }
    const f32x4 a0 = *(const f32x4*)(ABAR + ((size_t)g * 64 + j) * 4), a1 = *(const f32x4*)(ABAR + ((size_t)g * 64 + j + 32) * 4);
    cx.a[0] = a0[0]; cx.a[1] = a0[1]; cx.a[2] = a1[0]; cx.a[3] = a1[1];
    const f32x4 dv = *(const f32x4*)(A.in[I_SSMD] + 16 * g + 4 * fq);
    cx.dsk[0] = dv[0]; cx.dsk[1] = dv[1]; cx.dsk[2] = dv[2]; cx.dsk[3] = dv[3];
}

__device__ __forceinline__ void ssm_phase(const Args& A, LAS unsigned char* lds, int G, const int wv) {
    const int tid = opaque_tid(wv), lane = tid & 63, w = __builtin_amdgcn_readfirstlane(tid >> 6);
    const int j = lane & 31, hi = lane >> 5, fr = lane & 15;
    const bf16_t* P = (const bf16_t*)(A.ws + O_P); bf16_t* Gout = (bf16_t*)(A.ws + O_G);
    const float* ABAR = (const float*)(A.ws + O_ABAR);
    LAS unsigned char* tile = lds + w * 8704;
    LAS f32x4* EL = (LAS f32x4*)(lds + 8 * 8704);
    const int arow_i = lane & 31, own = (arow_i >> 2) & 1, rloc = 4 * (arow_i >> 3) + (arow_i & 3);
    for (int un = blockIdx.x; un < NB * NG; un += G) {
        const int b = un >> 6, g = un & 63;
        SsmCtx cx; ssm_load_ctx(cx, A, g, lane);
        const f32x4 p0 = *(const f32x4*)(ABAR + ((size_t)g * 64 + j) * 4), p1 = *(const f32x4*)(ABAR + ((size_t)g * 64 + j + 32) * 4);
        const size_t rowb = (size_t)b * SEQ;
        size_t yrow[2];
        cx.s[0] = cx.s[1] = cx.s[2] = cx.s[3] = 0.f;
        const bf16_t* abase = P + (rowb + (2 * w + own) * 128 + rloc) * D + 1024 + 16 * g + 8 * hi;
        bf16x8 af = *(const bf16x8*)abase;
        for (int k = 0; k < 8; ++k) {
            const bf16x8 afn = *(const bf16x8*)(abase + (size_t)(16 * ((k + 1) & 7)) * D);
            yrow[0] = 0; yrow[1] = 0;
            ssm_sub<0>(cx, P, Gout, g, af, yrow, tile, lane, nullptr, nullptr, nullptr, nullptr, 0);
            af = afn;
        }
        EL[(2 * w + hi) * 32 + j] = (f32x4){cx.s[0], cx.s[1], cx.s[2], cx.s[3]};
        LDS_WAIT(); __syncthreads();
        {
            float sr0 = 0.f, si0 = 0.f, sr1 = 0.f, si1 = 0.f; const int wk = 2 * w + hi;
            for (int q = 0; q < 15; ++q) {
                if (q < wk) { const f32x4 e = EL[q * 32 + j]; float tr, ti;
                    cmul(p0[2], p0[3], sr0, si0, tr, ti); sr0 = tr + e[0]; si0 = ti + e[1];
                    cmul(p1[2], p1[3], sr1, si1, tr, ti); sr1 = tr + e[2]; si1 = ti + e[3]; }
            }
            cx.s[0] = sr0; cx.s[1] = si0; cx.s[2] = sr1; cx.s[3] = si1;
        }
        for (int k = 0; k < 8; ++k) {
            const bf16x8 afn = *(const bf16x8*)(abase + (size_t)(16 * ((k + 1) & 7)) * D);
            yrow[0] = rowb + (2 * w) * 128 + 16 * k + fr; yrow[1] = rowb + (2 * w + 1) * 128 + 16 * k + fr;
            ssm_sub<1>(cx, P, Gout, g, af, yrow, tile, lane, nullptr, nullptr, nullptr, nullptr, 0);
            af = afn;
        }
        if (w == 7 && hi == 1) {
            const size_t o = ((size_t)b * NG + g) * 64 + j;
            A.out[OUT_REP + o] = cx.s[0]; A.out[OUT_IMP + o] = cx.s[1]; A.out[OUT_REP + o + 32] = cx.s[2]; A.out[OUT_IMP + o + 32] = cx.s[3];
        }
        LDS_WAIT(); __syncthreads();
    }
    for (int un = (G == 256) ? (int)blockIdx.x - 128 : (int)blockIdx.x; un < 2 * NG; un += G) {
        if (un < 0) continue;
        const int g = un >> 1, bh = un & 1;
        SsmCtx cx; ssm_load_ctx(cx, A, g, lane);
        cx.s[0] = cx.s[1] = cx.s[2] = cx.s[3] = 0.f;
        const int bbase = bh * 64 + w * 8;
        const size_t arow = (size_t)MP + (size_t)(bbase + own * 4 + (arow_i >> 3)) * 4 + (arow_i & 3);
        size_t yrow[2];
        yrow[0] = (size_t)MP + (size_t)(bbase + (fr >> 2)) * 4 + (fr & 3); yrow[1] = (size_t)MP + (size_t)(bbase + 4 + (fr >> 2)) * 4 + (fr & 3);
        const bf16x8 af = *(const bf16x8*)(P + arow * D + 1024 + 16 * g + 8 * hi);
        ssm_sub<2>(cx, P, Gout, g, af, yrow, tile, lane, A.in[I_SRE], A.in[I_SIM], A.out + OUT_RES, A.out + OUT_IMS, bbase + hi * 4);
    }
}

template <int WPU>
__device__ __forceinline__ void sample_attn_units(const Args& A, LAS unsigned char* lds, int su0, const int wv) {
    constexpr int KPW = 256 / WPU, NB = KPW / 8, NKG = KPW / 16;
    const int tid = opaque_tid(wv), lane = tid & 63, w = __builtin_amdgcn_readfirstlane(tid >> 6), fr = lane & 15, fq = lane >> 4;
    const int su = su0 + (WPU == 4 ? (w >> 2) : 0), b = su >> 2, h = su & 3, kq = (WPU == 4) ? (w & 3) : w;
    const bf16_t* Q = (const bf16_t*)(A.ws + O_Q); bf16_t* ATT = (bf16_t*)(A.ws + O_ATT);
    const float* Kc = A.in[I_CK] + (((size_t)b * NMEM + KPW * kq) * NH + h) * HD;
    const float* Vc = A.in[I_CV] + (((size_t)b * NMEM + KPW * kq) * NH + h) * HD;
    LAS bf16_t* QSw = (LAS bf16_t*)(lds + w * 4096);
    LAS float* PLw = (LAS float*)(lds + 32768 + w * 1024);
    LAS float* ML = (LAS float*)(lds + 40960);
    LAS float* RED = (LAS float*)(lds + 49152);
#pragma unroll
    for (int t = 0; t < 4; ++t) *(LAS u32x4*)(QSw + t * 512 + lane * 8) = *(const u32x4*)(Q + ((size_t)MP + b * 4 + t) * D + h * HD + lane * 8);
    f32x4 ra[16], rb[16];
#define KLOAD(dst, bi) do { const float* kp_ = Kc + (size_t)(16 * ((bi) >> 1) + fr) * (NH * HD) + 4 * fq + 256 * ((bi) & 1); \
        _Pragma("unroll") for (int i = 0; i < 8; ++i) { dst[2 * i] = *(const f32x4*)(kp_ + 32 * i); dst[2 * i + 1] = *(const f32x4*)(kp_ + 32 * i + 16); } } while (0)
#define KUSE(src, bi) do { _Pragma("unroll") for (int i = 0; i < 8; ++i) { const int kd = 8 * ((bi) & 1) + i; const f32x4 k0 = src[2 * i], k1 = src[2 * i + 1]; \
        u32x4 kw; kw.x = cvt_pk_bf16(k0[0], k0[1]); kw.y = cvt_pk_bf16(k0[2], k0[3]); kw.z = cvt_pk_bf16(k1[0], k1[1]); kw.w = cvt_pk_bf16(k1[2], k1[3]); \
        u32x4 qw = {0u, 0u, 0u, 0u}; \
        if (fr < 4) { const u32x2 qa = *(const LAS u32x2*)(QSw + fr * 512 + 32 * kd + 4 * fq), qb = *(const LAS u32x2*)(QSw + fr * 512 + 32 * kd + 16 + 4 * fq); qw.x = qa.x; qw.y = qa.y; qw.z = qb.x; qw.w = qb.y; } \
        sc[(bi) >> 1] = __builtin_amdgcn_mfma_f32_16x16x32_bf16(__builtin_bit_cast(bf16x8, kw), __builtin_bit_cast(bf16x8, qw), sc[(bi) >> 1], 0, 0, 0); } } while (0)
#define VLOAD(dst, vb) do { const float* vp_ = Vc + (size_t)(8 * (vb)) * (NH * HD) + 4 * lane; \
        _Pragma("unroll") for (int k = 0; k < 8; ++k) { dst[2 * k] = __builtin_nontemporal_load((const f32x4*)(vp_ + (size_t)k * (NH * HD))); dst[2 * k + 1] = __builtin_nontemporal_load((const f32x4*)(vp_ + (size_t)k * (NH * HD) + 256)); } } while (0)
#define VUSE(src, vb) do { _Pragma("unroll") for (int k = 0; k < 8; ++k) { const f32x4 p = *(const LAS f32x4*)(PLw + (8 * (vb) + k) * 4); \
        _Pragma("unroll") for (int t = 0; t < 4; ++t) { o[t][0] += src[2 * k] * p[t]; o[t][1] += src[2 * k + 1] * p[t]; } } } while (0)
#define SB() __builtin_amdgcn_sched_barrier(0)
    KLOAD(ra, 0); KLOAD(rb, 1);
    LDS_WAIT(); __builtin_amdgcn_wave_barrier();
    f32x4 sc[NKG];
#pragma unroll
    for (int i = 0; i < NKG; ++i) sc[i] = (f32x4){0.f, 0.f, 0.f, 0.f};
    SB(); KUSE(ra, 0); SB(); KLOAD(ra, 2); SB(); KUSE(rb, 1); SB(); KLOAD(rb, 3); SB();
    if constexpr (NB == 8) {
        KUSE(ra, 2); SB(); KLOAD(ra, 4); SB(); KUSE(rb, 3); SB(); KLOAD(rb, 5); SB();
        KUSE(ra, 4); SB(); KLOAD(ra, 6); SB(); KUSE(rb, 5); SB(); KLOAD(rb, 7); SB();
        KUSE(ra, 6); SB(); VLOAD(ra, 0); SB(); KUSE(rb, 7); SB(); VLOAD(rb, 1); SB();
    } else {
        KUSE(ra, 2); SB(); VLOAD(ra, 0); SB(); KUSE(rb, 3); SB(); VLOAD(rb, 1); SB();
    }
    float mt = -3.0e38f;
#pragma unroll
    for (int kg = 0; kg < NKG; ++kg) mt = fmaxf(mt, fmaxf(fmaxf(sc[kg][0], sc[kg][1]), fmaxf(sc[kg][2], sc[kg][3])));
    mt = fmaxf(mt, __shfl_xor(mt, 16)); mt = fmaxf(mt, __shfl_xor(mt, 32));
    float lt = 0.f;
#pragma unroll
    for (int kg = 0; kg < NKG; ++kg)
#pragma unroll
        for (int r = 0; r < 4; ++r) { const float e = __expf(sc[kg][r] - mt); lt += e; if (fr < 4) PLw[(16 * kg + 4 * fq + r) * 4 + fr] = e; }
    lt += __shfl_xor(lt, 16); lt += __shfl_xor(lt, 32);
    if (fr < 4 && fq == 0) { ML[(w * 4 + fr) * 2] = mt; ML[(w * 4 + fr) * 2 + 1] = lt; }
    LDS_WAIT(); __builtin_amdgcn_wave_barrier();
    f32x4 o[4][2];
#pragma unroll
    for (int t = 0; t < 4; ++t) { o[t][0] = (f32x4){0.f, 0.f, 0.f, 0.f}; o[t][1] = (f32x4){0.f, 0.f, 0.f, 0.f}; }
    SB(); VUSE(ra, 0); SB(); VLOAD(ra, 2); SB(); VUSE(rb, 1); SB(); VLOAD(rb, 3); SB();
    if constexpr (NB == 8) {
        VUSE(ra, 2); SB(); VLOAD(ra, 4); SB(); VUSE(rb, 3); SB(); VLOAD(rb, 5); SB();
        VUSE(ra, 4); SB(); VLOAD(ra, 6); SB(); VUSE(rb, 5); SB(); VLOAD(rb, 7); SB();
        VUSE(ra, 6); SB(); VUSE(rb, 7);
    } else {
        VUSE(ra, 2); SB(); VUSE(rb, 3);
    }
#undef KLOAD
#undef KUSE
#undef VLOAD
#undef VUSE
#undef SB
#pragma unroll
    for (int t = 0; t < 4; ++t) { *(LAS f32x4*)(RED + (w * 4 + t) * 512 + 4 * lane) = o[t][0]; *(LAS f32x4*)(RED + (w * 4 + t) * 512 + 256 + 4 * lane) = o[t][1]; }
    LDS_WAIT(); __syncthreads();
    if constexpr (WPU == 4) {
        const int uh = tid >> 8, t = (tid >> 6) & 3, c = (tid & 63) * 8;
        float m4[4], l4[4], Mx = -3.0e38f;
#pragma unroll
        for (int q = 0; q < 4; ++q) { m4[q] = ML[((uh * 4 + q) * 4 + t) * 2]; l4[q] = ML[((uh * 4 + q) * 4 + t) * 2 + 1]; Mx = fmaxf(Mx, m4[q]); }
        f32x4 s0 = {0.f, 0.f, 0.f, 0.f}, s1 = {0.f, 0.f, 0.f, 0.f}; float L = 0.f;
#pragma unroll
        for (int q = 0; q < 4; ++q) { const float f = __expf(m4[q] - Mx); L += l4[q] * f;
            s0 += *(const LAS f32x4*)(RED + ((uh * 4 + q) * 4 + t) * 512 + c) * f; s1 += *(const LAS f32x4*)(RED + ((uh * 4 + q) * 4 + t) * 512 + c + 4) * f; }
        const float iv = 1.0f / L; const int su2 = su0 + uh, b2 = su2 >> 2, h2 = su2 & 3;
        pg8::st_bf16x8(ATT + ((size_t)MP + b2 * 4 + t) * D + h2 * HD + c, s0 * iv, s1 * iv);
    } else {
        const int t = tid >> 7, c = (tid & 127) * 4;
        float m8[8], l8[8], Mx = -3.0e38f;
#pragma unroll
        for (int q = 0; q < 8; ++q) { m8[q] = ML[(q * 4 + t) * 2]; l8[q] = ML[(q * 4 + t) * 2 + 1]; Mx = fmaxf(Mx, m8[q]); }
        f32x4 s0 = {0.f, 0.f, 0.f, 0.f}; float L = 0.f;
#pragma unroll
        for (int q = 0; q < 8; ++q) { const float f = __expf(m8[q] - Mx); L += l8[q] * f; s0 += *(const LAS f32x4*)(RED + (q * 4 + t) * 512 + c) * f; }
        const float iv = 1.0f / L; const int b2 = su0 >> 2, h2 = su0 & 3;
        pg8::st_bf16x4(ATT + ((size_t)MP + b2 * 4 + t) * D + h2 * HD + c, s0 * iv);
    }
    LDS_WAIT(); __syncthreads();
}

constexpr int MTP = MP / 256;
struct SchedGrid {
    int G, c, nM, nN; const char* A; const char* B; size_t ta, tb; const char* Sb; size_t ts;
    __device__ __forceinline__ bool next(int i, Unit& u) const {
        const int L = i * G + c; if (L >= nM * nN) return false;
        u.pm = L % nM; u.pn = L / nM; u.job = 0; u.a = A + (size_t)u.pm * ta; u.b = B + (size_t)u.pn * tb; u.s = Sb + (size_t)u.pm * ts; u.srow = MP + 16 * u.pm; return true;
    }
};
struct Sched1 {
    int G, c; const char* hmix; const char* win; const char* mn; const char* wkv;
    __device__ __forceinline__ bool next(int i, Unit& u) const {
        int L = i * G + c;
        if (L < MTP * 8) { u.job = 0; u.pm = L % MTP; u.pn = L / MTP; u.a = hmix + (size_t)u.pm * 256 * D * 2; u.b = win + (size_t)u.pn * 256 * D * 2;
            u.s = hmix + ((size_t)MP + 16 * u.pm) * D * 2; u.srow = MP + 16 * u.pm; return true; }
        L -= MTP * 8;
        if (L < 64) { u.job = 1; u.pm = L & 3; u.pn = L >> 2; u.a = mn + (size_t)u.pm * 256 * D * 2; u.b = wkv + (size_t)u.pn * 256 * D * 2; u.s = u.a; u.srow = -1; return true; }
        return false;
    }
};
struct SchedGU {
    int G, c; const char* A; const char* B;
    __device__ __forceinline__ bool next(int i, Unit& u) const {
        const int L = i * G + c;
        if (L < MTP * 44) { u.pm = L % MTP; u.pn = L / MTP; }
        else if (L < (MTP + 2) * 44) { const int r = L - MTP * 44; u.pm = MTP + (r & 1); u.pn = r >> 1; }
        else return false;
        u.job = 0; u.a = A + (size_t)u.pm * 256 * D * 2; u.b = B + (size_t)u.pn * 256 * D * 2; u.s = u.a; u.srow = -1; return true;
    }
};
struct SchedPool {
    int G, c; const char* pooled; const char* wp;
    __device__ __forceinline__ bool next(int i, Unit& u) const {
        const int L = i * G + c; if (L >= MTP * 4) return false;
        u.job = 0; u.pm = L % MTP; u.pn = L / MTP; u.a = pooled + ((size_t)u.pm * 256 * 1024 + u.pn * 256) * 2; u.b = wp + (size_t)u.pn * 256 * 256 * 2;
        u.s = pooled + (((size_t)MP + 16 * u.pm) * 1024 + u.pn * 256) * 2; u.srow = MP + 16 * u.pm; return true;
    }
};
struct SchedScores {
    int c; const char* Q; const char* KB;
    __device__ __forceinline__ bool next(int i, Unit& u) const {
        if (i > 0 || c >= 128) return false;
        const int bh = c >> 3, qb = c & 7, b = bh >> 2, h = bh & 3;
        u.job = bh; u.pm = qb; u.pn = 0; u.a = Q + (((size_t)b * SEQ + qb * 256) * D + h * HD) * 2; u.b = KB + ((size_t)b * NMEM * D + h * HD) * 2; u.s = u.a; u.srow = -1; return true;
    }
};
struct SchedPVown {
    int c; const char* PR; const char* VT;
    __device__ __forceinline__ bool next(int i, Unit& u) const {
        if (i > 1 || c >= 128) return false;
        const int bh = c >> 3, qb = c & 7, pn = i, b = bh >> 2, h = bh & 3;
        u.job = 0; u.pm = b * 8 + qb; u.pn = h * 2 + pn;
        u.a = PR + ((size_t)bh * SEQ + qb * 256) * 256 * 2; u.b = VT + (((size_t)h * HD + pn * 256) * 1024 + b * 256) * 2; u.s = u.a; u.srow = -1; return true;
    }
};
struct SchedPV {
    int G, c; const char* PR; const char* VT;
    __device__ __forceinline__ bool next(int i, Unit& u) const {
        const int L = i * G + c; if (L >= 256) return false;
        const int bh = L >> 4, rem = L & 15, qb = rem >> 1, pn = rem & 1, b = bh >> 2, h = bh & 3;
        u.job = 0; u.pm = b * 8 + qb; u.pn = h * 2 + pn;
        u.a = PR + ((size_t)bh * SEQ + qb * 256) * 256 * 2; u.b = VT + (((size_t)h * HD + pn * 256) * 1024 + b * 256) * 2; u.s = u.a; u.srow = -1; return true;
    }
};


#define XB_TMO      128
#define XB_XCNT(j)  (256  + 64 * (j))
#define XB_XSUB(j)  (1280 + 64 * (j))
#define XB_XGEN(j)  (2304 + 64 * (j))
#define XB_TOP      3328
#define XB_TOPGEN   3392
#define XCD_BAR_WORDS 3456
#define XB_SPIN_CAP (1u << 18)
__device__ __forceinline__ unsigned xb_ld(unsigned* p)              { return __hip_atomic_load(p, __ATOMIC_RELAXED, __HIP_MEMORY_SCOPE_AGENT); }
__device__ __forceinline__ unsigned xb_add(unsigned* p, unsigned v) { return __hip_atomic_fetch_add(p, v, __ATOMIC_RELAXED, __HIP_MEMORY_SCOPE_AGENT); }
__device__ __forceinline__ unsigned xb_xcc_id() { return (unsigned)__builtin_amdgcn_s_getreg((3 << 11) | 20) & 0xFu; }
#define XB_SPIN(cond, bar) do { unsigned _sp = 0; while (cond) { __builtin_amdgcn_s_sleep(1); \
    if ((++_sp & 255u) == 0u) { if (xb_ld(&(bar)[XB_TMO])) break; if (_sp > XB_SPIN_CAP) { atomicAdd(&(bar)[XB_TMO], 1u); break; } } } } while (0)
struct XcdBarrier { unsigned* bar; unsigned x; volatile LAS unsigned* st; };
__device__ __forceinline__ XcdBarrier xcd_barrier_post(unsigned* bar, volatile LAS unsigned* st) {
    XcdBarrier b; b.bar = bar; b.x = xb_xcc_id(); b.st = st;
    if (threadIdx.x == 0) (void)xb_add(&bar[XB_XCNT(b.x)], 1u);
    return b;
}
__device__ __forceinline__ void xcd_barrier_complete(unsigned* bar, unsigned x, unsigned& nloc, unsigned& nx) {
    const unsigned G = gridDim.x * gridDim.y * gridDim.z;
    unsigned sum, cnt, mine, sp = 0u;
    for (;;) {
        sum = 0u; cnt = 0u; mine = 0u;
#pragma unroll
        for (unsigned j = 0; j < 16; ++j) { const unsigned c = xb_ld(&bar[XB_XCNT(j)]); sum += c; cnt += (c > 0u) ? 1u : 0u; mine = (j == x) ? c : mine; }
        if (sum == G) break;
        __builtin_amdgcn_s_sleep(1);
        if ((++sp & 255u) == 0u) { if (xb_ld(&bar[XB_TMO])) break; if (sp > XB_SPIN_CAP) { atomicAdd(&bar[XB_TMO], 1u); break; } }
    }
    nloc = mine > 0u ? mine : 1u; nx = cnt > 0u ? cnt : 1u;
}
__device__ __forceinline__ void xcd_barrier(const XcdBarrier& b, const int wv) {
    asm volatile("s_waitcnt vmcnt(0)" ::: "memory");
    __syncthreads();
    if (opaque_tid(wv) == 0) {
        unsigned* bar = b.bar;
        __builtin_amdgcn_s_waitcnt(0);
        unsigned nloc = b.st[0], nx = b.st[1];
        if (nloc == 0u) { xcd_barrier_complete(bar, b.x, nloc, nx); b.st[0] = nloc; b.st[1] = nx; }
        const unsigned old = xb_add(&bar[XB_XSUB(b.x)], 1u);
        const unsigned gen = old / nloc;
        if (old + 1u == (gen + 1u) * nloc) {
            __builtin_amdgcn_fence(__ATOMIC_RELEASE, "agent");
            asm volatile("s_waitcnt vmcnt(0)" ::: "memory");
            __builtin_amdgcn_fence(__ATOMIC_RELEASE, "agent");
            asm volatile("s_waitcnt vmcnt(0)" ::: "memory");
            const unsigned og = xb_add(&bar[XB_TOP], 1u);
            const unsigned tg = og / nx;
            if (og + 1u == (tg + 1u) * nx) xb_add(&bar[XB_TOPGEN], 1u);
            else XB_SPIN(xb_ld(&bar[XB_TOPGEN]) == tg, bar);
            __builtin_amdgcn_fence(__ATOMIC_ACQUIRE, "agent");
            xb_add(&bar[XB_XGEN(b.x)], 1u);
            asm volatile("s_waitcnt vmcnt(0)" ::: "memory");
        } else {
            XB_SPIN(xb_ld(&bar[XB_XGEN(b.x)]) == gen, bar);
            __builtin_amdgcn_fence(__ATOMIC_ACQUIRE, "agent");
            asm volatile("s_waitcnt vmcnt(0)" ::: "memory");
        }
    }
    __syncthreads();
}

#ifndef REP_PHASE
#define REP_PHASE -1
#endif
#define REPEAT(k) for (int rep_ = 0; rep_ < ((REP_PHASE == (k)) ? 2 : 1); ++rep_)
__global__ void __launch_bounds__(512, 2) hymba_fwd(Args A) {
    extern __shared__ __attribute__((aligned(16))) unsigned char lds_raw[];
    LAS unsigned char* lds = (LAS unsigned char*)lds_raw;
    cg::grid_group grid = cg::this_grid();
    const int G = gridDim.x, c = blockIdx.x, wv = __builtin_amdgcn_readfirstlane((int)threadIdx.x >> 6);
    unsigned char* ws = A.ws;
    float* SS1 = (float*)(ws + O_SS1); float* SS2 = (float*)(ws + O_SS2); float* SS3 = (float*)(ws + O_SS3); float* SSD = (float*)(ws + O_BAR + 16384);
    volatile LAS unsigned* bst = (volatile LAS unsigned*)(lds + RING_BYTES + 8192);
    if (threadIdx.x < 4) bst[threadIdx.x] = 0u;
    __syncthreads();
    const XcdBarrier xbar = xcd_barrier_post((unsigned*)(ws + O_BAR), bst);
#define SEAM() xcd_barrier(xbar, wv)

    REPEAT(0) {
    {
        convert_weights(A, lds, 0, NEARLY, c * 8 + wv, G * 8, wv);
        phase0_rest(A, G, wv);
    }
    if (A.ws == nullptr) grid.sync();
    SEAM();
    }
    REPEAT(1) {
    {
        Sched1 S{G, c, (const char*)(ws + O_HMIX), (const char*)(ws + O_WIN), (const char*)(ws + O_MN), (const char*)(ws + O_WKV)};
        pg8::EpiInKv E{(bf16_t*)(ws + O_P), A.out, (bf16_t*)(ws + O_KB), (bf16_t*)(ws + O_VT)};
        pg8::gemm_phase<pg8::EpiInKv, Sched1, true, true>(lds, pg8::Dims{D, D, D}, S, E, wv);
        __syncthreads();
        const int skip = (G > 128) ? 64 : 0;
        convert_weights(A, lds, NEARLY, NITEMS, (c >= skip) ? (c - skip) * 8 + wv : -1, (G - skip) * 8, wv);
    }
    SEAM();
    }
    REPEAT(2) {
    ssm_phase(A, lds, G, wv);
    pooled_phase(A, G, wv);
    SEAM();
    }
    REPEAT(3) {
    {
        SchedPool S{G, c, (const char*)(ws + O_POOLED), (const char*)(ws + O_WPOOL)};
        pg8::EpiPool E{(bf16_t*)(ws + O_MIX), A.in[I_PSCALE]};
        pg8::gemm_phase<pg8::EpiPool, SchedPool, true, true>(lds, pg8::Dims{1024, 256, 256}, S, E, wv);
        SchedGrid S2{G, G - 1 - c, MTP, 4, (const char*)(ws + O_G), (const char*)(ws + O_WGLU), (size_t)256 * 1024 * 2, (size_t)256 * 1024 * 2, (const char*)(ws + O_G) + (size_t)MP * 1024 * 2, (size_t)16 * 1024 * 2};
        pg8::EpiGlu E2{(bf16_t*)(ws + O_MIX), (const bf16_t*)(ws + O_G), A.in[I_BGLU]};
        pg8::gemm_phase<pg8::EpiGlu, SchedGrid, true, true>(lds, pg8::Dims{1024, 1024, 1024}, S2, E2, wv);
    }
    SEAM();
    }
    REPEAT(4) {
    {
        SchedGrid S{G, c, MTP, 8, (const char*)(ws + O_MIX), (const char*)(ws + O_WOUT), (size_t)256 * D * 2, (size_t)256 * D * 2, (const char*)(ws + O_MIX) + (size_t)MP * D * 2, (size_t)16 * D * 2};
        pg8::EpiRes<float> E{A.in[I_XP], A.in[I_XS], nullptr, (bf16_t*)(ws + O_XB), rep_ ? SSD : SS1};
        pg8::gemm_phase<pg8::EpiRes<float>, SchedGrid, true, true>(lds, pg8::Dims{D, D, D}, S, E, wv);
    }
    SEAM();
    }
    REPEAT(5) {
    {
        SchedGrid S{G, c, MTP, 8, (const char*)(ws + O_XB), (const char*)(ws + O_WQ), (size_t)256 * D * 2, (size_t)256 * D * 2, (const char*)(ws + O_XB) + (size_t)MP * D * 2, (size_t)16 * D * 2};
        pg8::EpiQ E{(bf16_t*)(ws + O_Q), SS1};
        pg8::gemm_phase<pg8::EpiQ, SchedGrid, true, true>(lds, pg8::Dims{D, D, D}, S, E, wv);
    }
    SEAM();
    }
    REPEAT(6) {
    {
        if (G == 256) {
            if (c < 128) {
                { SchedScores S{c, (const char*)(ws + O_Q), (const char*)(ws + O_KB)};
                  pg8::EpiSoftmax E{(bf16_t*)(ws + O_PR)};
                  pg8::gemm_phase<pg8::EpiSoftmax, SchedScores, false, false>(lds, pg8::Dims{D, D, HD}, S, E, wv); }
                asm volatile("s_waitcnt vmcnt(0)" ::: "memory"); __syncthreads();
                { SchedPVown S{c, (const char*)(ws + O_PR), (const char*)(ws + O_VT)};
                  pg8::EpiPV E{(bf16_t*)(ws + O_ATT)};
                  pg8::gemm_phase<pg8::EpiPV, SchedPVown, true, false>(lds, pg8::Dims{256, 1024, 256}, S, E, wv); }
                __syncthreads();
                sample_attn_units<8>(A, lds, c, wv);
            } else {
                sample_attn_units<4>(A, lds, 128 + 2 * (c - 128), wv);
                sample_attn_units<8>(A, lds, 384 + (c - 128), wv);
            }
        } else {
            for (int base = 0; base < 128; base += G) {
                SchedScores S{c + base, (const char*)(ws + O_Q), (const char*)(ws + O_KB)};
                pg8::EpiSoftmax E{(bf16_t*)(ws + O_PR)};
                pg8::gemm_phase<pg8::EpiSoftmax, SchedScores, false, false>(lds, pg8::Dims{D, D, HD}, S, E, wv);
            }
            __syncthreads();
            for (int du = c; du < 256; du += G) sample_attn_units<4>(A, lds, 2 * du, wv);
        }
    }
    SEAM();
    }
    if (G != 256) {
        SchedPV S{G, c, (const char*)(ws + O_PR), (const char*)(ws + O_VT)};
        pg8::EpiPV E{(bf16_t*)(ws + O_ATT)};
        pg8::gemm_phase<pg8::EpiPV, SchedPV, true, false>(lds, pg8::Dims{256, 1024, 256}, S, E, wv);
        SEAM();
    }
    REPEAT(8) {
    {
        SchedGrid S{G, c, MTP, 8, (const char*)(ws + O_ATT), (const char*)(ws + O_WO), (size_t)256 * D * 2, (size_t)256 * D * 2, (const char*)(ws + O_ATT) + (size_t)MP * D * 2, (size_t)16 * D * 2};
        pg8::EpiRes<bf16_t> E{(const bf16_t*)(ws + O_XB), (const bf16_t*)(ws + O_XB) + (size_t)MP * D, nullptr, (bf16_t*)(ws + O_XB), SS2};
        pg8::gemm_phase<pg8::EpiRes<bf16_t>, SchedGrid, true, true>(lds, pg8::Dims{D, D, D}, S, E, wv);
    }
    SEAM();
    }
    REPEAT(9) {
    {
        SchedGU S{G, c, (const char*)(ws + O_XB), (const char*)(ws + O_WGU)};
        pg8::EpiGateUp E{(bf16_t*)(ws + O_H), SS2};
        pg8::gemm_phase<pg8::EpiGateUp, SchedGU, true, false>(lds, pg8::Dims{D, D, D}, S, E, wv);
    }
    SEAM();
    }
    if (G == 256) {
        SchedGrid S{G, c, MTP, 8, (const char*)(ws + O_H), (const char*)(ws + O_WDN), (size_t)256 * FF * 2, (size_t)256 * FF * 2, (const char*)(ws + O_H) + (size_t)MP * FF * 2, (size_t)16 * FF * 2};
        pg8::EpiFinal E{(const bf16_t*)(ws + O_XB), A.out + OUT_Y, SS3, (unsigned*)(ws + O_PCNT), A.in[I_GFINAL]};
        pg8::gemm_phase<pg8::EpiFinal, SchedGrid, false, true>(lds, pg8::Dims{FF, FF, FF}, S, E, wv);
    } else {
        {
            SchedGrid S{G, c, MTP, 8, (const char*)(ws + O_H), (const char*)(ws + O_WDN), (size_t)256 * FF * 2, (size_t)256 * FF * 2, (const char*)(ws + O_H) + (size_t)MP * FF * 2, (size_t)16 * FF * 2};
            pg8::EpiRes<bf16_t> E{(const bf16_t*)(ws + O_XB), (const bf16_t*)(ws + O_XB) + (size_t)MP * D, A.out + OUT_Y, nullptr, SS3};
            pg8::gemm_phase<pg8::EpiRes<bf16_t>, SchedGrid, true, true>(lds, pg8::Dims{FF, FF, FF}, S, E, wv);
        }
        SEAM();
        const float* gf = A.in[I_GFINAL]; const int tid = opaque_tid(wv), lane = tid & 63, wave = wv;
        for (int m = c * 8 + wave; m < M; m += G * 8) {
            const float rs = rsqrtf(SS3[m] * (1.0f / D) + EPS);
            f32x4* row = (f32x4*)(A.out + OUT_Y + (size_t)m * D) + lane; const f32x4* gr = (const f32x4*)gf + lane;
#pragma unroll
            for (int jj = 0; jj < 8; ++jj) row[64 * jj] = row[64 * jj] * rs * gr[64 * jj];
        }
    }
}

extern "C" void kernel_launch(void* const* d_in, const int* in_sizes, int n_in, void* d_out, int out_size, void* d_ws, size_t ws_size, hipStream_t stream) {
    static int grid = 0;
    if (grid == 0) {
        if (n_in != 34 || ws_size < WS_END) { fprintf(stderr, "kernel_launch: unexpected inputs (n_in %d, ws %zu, need %zu)\n", n_in, ws_size, (size_t)WS_END); grid = -1; return; }
        int dev = 0, cus = 0, per_cu = 0;
        hipGetDevice(&dev);
        hipDeviceGetAttribute(&cus, hipDeviceAttributeMultiprocessorCount, dev);
        if (hipFuncSetAttribute((const void*)hymba_fwd, hipFuncAttributeMaxDynamicSharedMemorySize, LDS_BYTES) != hipSuccess) { fprintf(stderr, "kernel_launch: hipFuncSetAttribute failed\n"); grid = -1; return; }
        if (hipOccupancyMaxActiveBlocksPerMultiprocessor(&per_cu, (const void*)hymba_fwd, 512, LDS_BYTES) != hipSuccess || per_cu < 1) { fprintf(stderr, "kernel_launch: occupancy query failed (%d)\n", per_cu); per_cu = 1; }
        (void)hipGetLastError();
        grid = cus * per_cu;
    }
    if (grid < 0) return;
    hipMemsetAsync(d_ws, 0, CTL_BYTES, stream);
    Args a{};
    for (int i = 0; i < 34; ++i) a.in[i] = (const float*)d_in[i];
    a.out = (float*)d_out; a.ws = (unsigned char*)d_ws;
    void* args[] = {&a};
    hipError_t e = hipLaunchCooperativeKernel((const void*)hymba_fwd, dim3(grid), dim3(512), args, LDS_BYTES, stream);
    if (e != hipSuccess) fprintf(stderr, "cooperative launch failed: %s (grid %d)\n", hipGetErrorString(e), grid);
}
```

```cpp
#include <hip/hip_runtime.h>
#include <hip/hip_cooperative_groups.h>
#include <cstdio>
#include <cstdint>
namespace cg = cooperative_groups;

#define LAS __attribute__((address_space(3)))
typedef unsigned short bf16_t;
typedef short bf16x8 __attribute__((ext_vector_type(8)));
typedef float f32x4 __attribute__((ext_vector_type(4)));
typedef float f32x16 __attribute__((ext_vector_type(16)));
typedef unsigned u32x4 __attribute__((ext_vector_type(4)));
typedef unsigned u32x2 __attribute__((ext_vector_type(2)));

constexpr int D = 2048, SEQ = 2048, NB = 4, MP = NB * SEQ, DB = 128, DS = 4, MS = DB * DS, M = MP + MS;
constexpr int PW = 1024, NG = 64, NMEM = 256, NH = 4, HD = 512, FF = 5632, PBUF = 15;
constexpr float EPS = 1e-6f;

constexpr size_t OUT_Y = 0;
constexpr size_t OUT_PBP = (size_t)M * D;
constexpr size_t OUT_REP = OUT_PBP + (size_t)NB * PBUF * PW;
constexpr size_t OUT_IMP = OUT_REP + (size_t)NB * NG * 64;
constexpr size_t OUT_MK = OUT_IMP + (size_t)NB * NG * 64;
constexpr size_t OUT_MV = OUT_MK + (size_t)NB * NMEM * D;
constexpr size_t OUT_PBS = OUT_MV + (size_t)NB * NMEM * D;
constexpr size_t OUT_RES = OUT_PBS + (size_t)DB * PBUF * PW;
constexpr size_t OUT_IMS = OUT_RES + (size_t)DB * NG * 64;

constexpr size_t CTL_BYTES = 256 * 1024;
constexpr size_t O_SS1 = 0, O_SS2 = 64 * 1024, O_SS3 = 128 * 1024, O_BAR = 192 * 1024, O_PCNT = 248 * 1024;
constexpr size_t O_WIN = 1 << 20;
constexpr size_t O_WKV = O_WIN + (size_t)D * D * 2;
constexpr size_t O_WPOOL = O_WKV + (size_t)2 * D * D * 2;
constexpr size_t O_WGLU = O_WPOOL + (size_t)4 * 256 * 256 * 2;
constexpr size_t O_WOUT = O_WGLU + (size_t)1024 * 1024 * 2;
constexpr size_t O_WQ = O_WOUT + (size_t)D * D * 2;
constexpr size_t O_WO = O_WQ + (size_t)D * D * 2;
constexpr size_t O_WGU = O_WO + (size_t)D * D * 2;
constexpr size_t O_WDN = O_WGU + (size_t)2 * FF * D * 2;
constexpr size_t O_TAB = O_WDN + (size_t)D * FF * 2;
constexpr size_t O_ABAR = O_TAB, O_BB = O_ABAR + 64 * 64 * 16, O_CM = O_BB + 64 * 4096;
constexpr size_t O_HMIX = O_CM + 64 * 4096;
constexpr size_t O_MN = O_HMIX + (size_t)M * D * 2;
constexpr size_t O_P = O_MN + (size_t)1024 * D * 2;
constexpr size_t O_POOLED = O_P + (size_t)M * D * 2;
constexpr size_t O_G = O_POOLED + (size_t)M * 1024 * 2;
constexpr size_t O_MIX = O_G + (size_t)M * 1024 * 2;
constexpr size_t O_X1 = O_MIX + (size_t)M * D * 2;
constexpr size_t O_XB = O_X1 + (size_t)M * D * 4;
constexpr size_t O_Q = O_XB + (size_t)M * D * 2;
constexpr size_t O_KB = O_Q + (size_t)M * D * 2;
constexpr size_t O_VT = O_KB + (size_t)1024 * D * 2;
constexpr size_t O_PR = O_VT + (size_t)D * 1024 * 2;
constexpr size_t O_ATT = O_PR + (size_t)16 * 2048 * 256 * 2;
constexpr size_t O_H = O_ATT + (size_t)M * D * 2;
constexpr size_t WS_END = O_H + (size_t)M * FF * 2;

constexpr int RING_BYTES = 131072, LDS_BYTES = 147456;

__device__ __forceinline__ unsigned cvt_pk_bf16(float lo, float hi) { unsigned r; asm volatile("v_cvt_pk_bf16_f32 %0, %1, %2" : "=v"(r) : "v"(lo), "v"(hi)); return r; }
__device__ __forceinline__ float bf_lo(unsigned w) { return __uint_as_float(w << 16); }
__device__ __forceinline__ float bf_hi(unsigned w) { return __uint_as_float(w & 0xffff0000u); }
__device__ __forceinline__ float wave_sum(float v) {
#pragma unroll
    for (int o = 1; o < 64; o <<= 1) v += __shfl_xor(v, o);
    return v;
}
__device__ __forceinline__ float wave_max(float v) {
#pragma unroll
    for (int o = 1; o < 64; o <<= 1) v = fmaxf(v, __shfl_xor(v, o));
    return v;
}
__device__ __forceinline__ float fast_sigmoid(float x) { return __builtin_amdgcn_rcpf(1.0f + __expf(-x)); }
__device__ __forceinline__ float gelu_tanh(float y) { const float t = 1.5957691216f * (y + 0.044715f * y * y * y); return y * fast_sigmoid(t); }
#define LDS_WAIT() asm volatile("s_waitcnt lgkmcnt(0)" ::: "memory")
__device__ __forceinline__ int opaque_tid(int wv) { int t; asm volatile("v_mbcnt_lo_u32_b32 %0, -1, 0\n\tv_mbcnt_hi_u32_b32 %0, -1, %0\n\tv_lshl_add_u32 %0, %1, 6, %0" : "=&v"(t) : "s"(wv)); return t; }

namespace pg8 {
constexpr int BM = 256, BK = 64, HALF = 128, HTB = HALF * BK * 2;
__device__ __forceinline__ int lds_byte(int r, int c) { const int st = (r >> 4) * 2 + (c >> 5), rr = r & 15, cc = c & 31, ob = rr * 64 + cc * 2; return st * 1024 + (ob ^ (((ob >> 9) & 1) << 5)); }
__device__ __forceinline__ void stage_rc(int b, int& R, int& C) { const int st = b / 1024, sb = b % 1024, swz = sb ^ (((sb >> 9) & 1) << 5); R = (st >> 1) * 16 + swz / 64; C = (st & 1) * 32 + (swz % 64) / 2; }
__device__ __forceinline__ int perm32(int rho) { const int n = rho >> 4, i = rho & 15; return 8 * (i >> 2) + 4 * n + (i & 3); }

struct Unit { const char* a; const char* b; const char* s; int pm, pn, job, srow; };
struct Dims { int lda, ldb, K; };

constexpr int SBUF_OFF = 131072;
template <class Epi, class Sched, bool ALIGN_EPI, bool STRIP>
__device__ __forceinline__ void gemm_phase(LAS unsigned char* lds, const Dims g, const Sched& S, const Epi& E, const int wv) {
    const int tid = opaque_tid(wv), wid = __builtin_amdgcn_readfirstlane(tid >> 6), lane = tid & 63, wr = wid >> 2, wc = wid & 3, fr = lane & 15, fq = lane >> 4;
    int nt = g.K / BK; asm volatile("" : "+s"(nt));
    unsigned voffA[2], voffB[2];
#pragma unroll
    for (int i = 0; i < 2; ++i) { int R, C; stage_rc(tid * 16 + i * 8192, R, C); const int Rb = (R & ~31) + perm32(R & 31);
        voffA[i] = (unsigned)(R * g.lda + C) * 2u; voffB[i] = (unsigned)(Rb * g.ldb + C) * 2u; }
    const unsigned voffS = (unsigned)((2 * wid + (lane >> 5)) * g.lda * 2 + (((((lane & 31) >> 2) ^ wid) & 7) * 16) + (lane & 3) * 4);
    const int soff = fr * 128 + ((fq ^ ((fr >> 1) & 7)) * 16);
    const size_t kstep = (size_t)(BK * 2);
    const size_t hstepA = (size_t)HALF * g.lda * 2, hstepB = (size_t)HALF * g.ldb * 2;
    const unsigned ldsw = (unsigned)wid * 1024u;
    const int aoff = lds_byte(wr * 64 + fr, fq * 8), boff = lds_byte(wc * 32 + fr, fq * 8);
#define PG8_SA(b, h) (((b) * 2 + (h)) * HTB)
#define PG8_SB(b, h) ((4 + (b) * 2 + (h)) * HTB)
#define PG8_STAGE(bufoff, gbase, voff) do { _Pragma("unroll") for (int _i = 0; _i < 2; ++_i) \
        __builtin_amdgcn_global_load_lds((const unsigned*)((const char*)(gbase) + (voff)[_i]), (LAS unsigned*)(lds + (bufoff) + ldsw + _i * 8192), 16, 0, 0); } while (0)
#define PG8_STAGE_S(b, gbase) do { if constexpr (STRIP) __builtin_amdgcn_global_load_lds((const unsigned*)((const char*)(gbase) + voffS), (LAS unsigned*)(lds + SBUF_OFF + (b) * 2048 + wid * 256), 4, 0, 0); } while (0)
#define PG8_LDS_S(b) do { if constexpr (STRIP) { As[0] = *(const LAS bf16x8*)(lds + SBUF_OFF + (b) * 2048 + soff); As[1] = *(const LAS bf16x8*)(lds + SBUF_OFF + (b) * 2048 + (soff ^ 64)); } } while (0)
#define PG8_LDA(dst, b, h) do { _Pragma("unroll") for (int m = 0; m < 4; ++m) _Pragma("unroll") for (int k = 0; k < 2; ++k) dst[m][k] = *(const LAS bf16x8*)(lds + PG8_SA(b, h) + aoff + m * 2048 + k * 1024); } while (0)
#define PG8_LDB(dst, b, h) do { _Pragma("unroll") for (int n = 0; n < 2; ++n) _Pragma("unroll") for (int k = 0; k < 2; ++k) dst[n][k] = *(const LAS bf16x8*)(lds + PG8_SB(b, h) + boff + n * 2048 + k * 1024); } while (0)
#define PG8_MMA(ai, bj, At, Bt) do { __builtin_amdgcn_s_setprio(1); _Pragma("unroll") for (int m = 0; m < 4; ++m) _Pragma("unroll") for (int n = 0; n < 2; ++n) _Pragma("unroll") for (int k = 0; k < 2; ++k) \
        acc[ai][bj][m][n] = __builtin_amdgcn_mfma_f32_16x16x32_bf16(Bt[n][k], At[m][k], acc[ai][bj][m][n], 0, 0, 0); __builtin_amdgcn_s_setprio(0); } while (0)
#define PG8_MMA_S() do { if constexpr (STRIP) { __builtin_amdgcn_s_setprio(1); \
        if (wr == 0) { _Pragma("unroll") for (int k = 0; k < 2; ++k) { sacc[0] = __builtin_amdgcn_mfma_f32_16x16x32_bf16(B0[0][k], As[k], sacc[0], 0, 0, 0); sacc[1] = __builtin_amdgcn_mfma_f32_16x16x32_bf16(B1[0][k], As[k], sacc[1], 0, 0, 0); } } \
        else         { _Pragma("unroll") for (int k = 0; k < 2; ++k) { sacc[0] = __builtin_amdgcn_mfma_f32_16x16x32_bf16(B0[1][k], As[k], sacc[0], 0, 0, 0); sacc[1] = __builtin_amdgcn_mfma_f32_16x16x32_bf16(B1[1][k], As[k], sacc[1], 0, 0, 0); } } \
        __builtin_amdgcn_s_setprio(0); } } while (0)
#define PG8_WAIT_V(n) asm volatile("s_waitcnt vmcnt(" #n ")" ::: "memory")
#define PG8_WAIT_VL() do { if constexpr (STRIP) PG8_WAIT_V(9); else PG8_WAIT_V(8); } while (0)
#define PG8_WAIT_L(n) asm volatile("s_waitcnt lgkmcnt(" #n ")" ::: "memory")
#define PG8_BAR __builtin_amdgcn_s_barrier()
#define PG8_SCHED __builtin_amdgcn_sched_barrier(0)
    Unit cur, nxt; int ui = 0;
    if (!S.next(0, cur)) return;
    f32x4 acc[2][2][4][2];
#pragma unroll
    for (int a = 0; a < 2; ++a)
#pragma unroll
        for (int b = 0; b < 2; ++b)
#pragma unroll
            for (int m = 0; m < 4; ++m)
#pragma unroll
                for (int n = 0; n < 2; ++n) acc[a][b][m][n] = (f32x4){0.f, 0.f, 0.f, 0.f};
    f32x4 sacc[2]; sacc[0] = (f32x4){0.f, 0.f, 0.f, 0.f}; sacc[1] = (f32x4){0.f, 0.f, 0.f, 0.f};
    bf16x8 At[4][2], B0[2][2], B1[2][2], As[2];
    const char* cA = cur.a; const char* cB = cur.b; const char* cS = cur.s;
    PG8_STAGE(PG8_SB(0, 0), cB, voffB); PG8_STAGE(PG8_SB(0, 1), cB + hstepB, voffB); PG8_STAGE(PG8_SA(0, 0), cA, voffA); PG8_STAGE_S(0, cS); PG8_STAGE(PG8_SA(0, 1), cA + hstepA, voffA);
    if (wr == 1) PG8_BAR;
    PG8_WAIT_V(2); PG8_BAR;
    PG8_STAGE(PG8_SB(1, 0), cB + kstep, voffB); PG8_STAGE(PG8_SA(1, 0), cA + kstep, voffA); PG8_STAGE(PG8_SB(1, 1), cB + hstepB + kstep, voffB); PG8_STAGE_S(1, cS + kstep);
    if constexpr (STRIP) PG8_WAIT_V(7); else PG8_WAIT_V(6);
    PG8_BAR;
    for (;;) {
        const bool has_next = S.next(ui + 1, nxt);
        const char* nA = has_next ? nxt.a : cA; const char* nB = has_next ? nxt.b : cB; const char* nS = has_next ? nxt.s : cS;
        for (int t = 0; t < nt; t += 2) {
            const bool last = (t == nt - 2);
            const char* a1 = cA + (size_t)(t + 1) * kstep;
            const char* a2 = last ? nA : cA + (size_t)(t + 2) * kstep; const char* b2 = last ? nB : cB + (size_t)(t + 2) * kstep; const char* s2 = last ? nS : cS + (size_t)(t + 2) * kstep;
            const char* a3 = a2 + kstep; const char* b3 = b2 + kstep; const char* s3 = s2 + kstep;
            PG8_LDB(B0, 0, 0); PG8_LDB(B1, 0, 1); PG8_SCHED; PG8_LDA(At, 0, 0); PG8_LDS_S(0); PG8_STAGE(PG8_SA(1, 1), a1 + hstepA, voffA);
            PG8_WAIT_VL(); PG8_WAIT_L(0); PG8_BAR; PG8_MMA(0, 0, At, B0); PG8_MMA(0, 1, At, B1); PG8_MMA_S(); PG8_BAR; PG8_SCHED;
            PG8_LDA(At, 0, 1); PG8_STAGE(PG8_SB(0, 0), b2, voffB); PG8_STAGE(PG8_SB(0, 1), b2 + hstepB, voffB); PG8_STAGE(PG8_SA(0, 0), a2, voffA); PG8_STAGE_S(0, s2);
            PG8_WAIT_VL(); PG8_WAIT_L(0); PG8_BAR; PG8_MMA(1, 0, At, B0); PG8_MMA(1, 1, At, B1); PG8_BAR; PG8_SCHED;
            PG8_LDB(B0, 1, 0); PG8_LDB(B1, 1, 1); PG8_SCHED; PG8_LDA(At, 1, 0); PG8_LDS_S(1); PG8_STAGE(PG8_SA(0, 1), a2 + hstepA, voffA);
            PG8_WAIT_VL(); PG8_WAIT_L(0); PG8_BAR; PG8_MMA(0, 0, At, B0); PG8_MMA(0, 1, At, B1); PG8_MMA_S(); PG8_BAR; PG8_SCHED;
            PG8_LDA(At, 1, 1); PG8_STAGE(PG8_SB(1, 0), b3, voffB); PG8_STAGE(PG8_SB(1, 1), b3 + hstepB, voffB); PG8_STAGE(PG8_SA(1, 0), a3, voffA); PG8_STAGE_S(1, s3);
            PG8_WAIT_VL(); PG8_WAIT_L(0); PG8_BAR; PG8_MMA(1, 0, At, B0); PG8_MMA(1, 1, At, B1); PG8_BAR; PG8_SCHED;
        }
        if constexpr (ALIGN_EPI) { if (wr == 0) PG8_BAR; }
        if constexpr (!Epi::AFTER_DRAIN) { E(acc, cur, wr, wc, fr, fq); if constexpr (STRIP) { if (cur.srow >= 0) E.strip(sacc, cur, wr, wc, fr, fq); } }
        if (!has_next) break;
#pragma unroll
        for (int a = 0; a < 2; ++a)
#pragma unroll
            for (int b = 0; b < 2; ++b)
#pragma unroll
                for (int m = 0; m < 4; ++m)
#pragma unroll
                    for (int n = 0; n < 2; ++n) acc[a][b][m][n] = (f32x4){0.f, 0.f, 0.f, 0.f};
        sacc[0] = (f32x4){0.f, 0.f, 0.f, 0.f}; sacc[1] = (f32x4){0.f, 0.f, 0.f, 0.f};
        cur = nxt; cA = nA; cB = nB; cS = nS; ++ui;
        if constexpr (ALIGN_EPI) { if (wr == 1) PG8_BAR; }
    }
    PG8_WAIT_V(0);
    if constexpr (!ALIGN_EPI) { if (wr == 0) PG8_BAR; }
    PG8_BAR;
    if constexpr (Epi::AFTER_DRAIN) { E.fused(acc, sacc, cur, wr, wc, fr, fq, lds, wid, lane); }
#undef PG8_SA
#undef PG8_SB
#undef PG8_STAGE
#undef PG8_STAGE_S
#undef PG8_LDS_S
#undef PG8_LDA
#undef PG8_LDB
#undef PG8_MMA
#undef PG8_MMA_S
#undef PG8_WAIT_V
#undef PG8_WAIT_VL
#undef PG8_WAIT_L
#undef PG8_BAR
#undef PG8_SCHED
}
typedef f32x4 Acc[2][2][4][2];

__device__ __forceinline__ void st_bf16x8(bf16_t* p, f32x4 v0, f32x4 v1) {
    u32x4 w; w.x = cvt_pk_bf16(v0[0], v0[1]); w.y = cvt_pk_bf16(v0[2], v0[3]); w.z = cvt_pk_bf16(v1[0], v1[1]); w.w = cvt_pk_bf16(v1[2], v1[3]); *(u32x4*)p = w;
}
__device__ __forceinline__ void st_bf16x4(bf16_t* p, f32x4 v) { u32x2 w; w.x = cvt_pk_bf16(v[0], v[1]); w.y = cvt_pk_bf16(v[2], v[3]); *(u32x2*)p = w; }
typedef f32x4 SAcc[2];
struct EpiInKv {
    static constexpr bool AFTER_DRAIN = false;
    bf16_t* P; float* out; bf16_t* KB; bf16_t* VT;
    __device__ __forceinline__ void operator()(const Acc& acc, const Unit& u, int wr, int wc, int fr, int fq) const {
        if (u.job == 0) {
#pragma unroll
            for (int ai = 0; ai < 2; ++ai)
#pragma unroll
                for (int m = 0; m < 4; ++m) {
                    const int row = u.pm * 256 + ai * 128 + wr * 64 + m * 16 + fr;
                    float* pbp = nullptr;
                    if (u.pn < 4) {
                        if (row < MP) { const int t = row & (SEQ - 1); if (t >= SEQ - PBUF) pbp = out + OUT_PBP + ((size_t)(row >> 11) * PBUF + (t - (SEQ - PBUF))) * PW; }
                        else { const int rs = row - MP; pbp = out + OUT_PBS + ((size_t)(rs >> 2) * PBUF + 11 + (rs & 3)) * PW; }
                    }
#pragma unroll
                    for (int bj = 0; bj < 2; ++bj) {
                        const int col = u.pn * 256 + bj * 128 + wc * 32 + 8 * fq;
                        const f32x4 v0 = acc[ai][bj][m][0], v1 = acc[ai][bj][m][1];
                        st_bf16x8(P + (size_t)row * D + col, v0, v1);
                        if (pbp) { *(f32x4*)(pbp + col) = v0; *(f32x4*)(pbp + col + 4) = v1; }
                    }
                }
        } else {
#pragma unroll
            for (int ai = 0; ai < 2; ++ai)
#pragma unroll
                for (int m = 0; m < 4; ++m) {
                    const int row = u.pm * 256 + ai * 128 + wr * 64 + m * 16 + fr;
#pragma unroll
                    for (int bj = 0; bj < 2; ++bj) {
                        const int col = u.pn * 256 + bj * 128 + wc * 32 + 8 * fq;
                        const f32x4 v0 = acc[ai][bj][m][0], v1 = acc[ai][bj][m][1];
                        if (col < D) {
                            float* o = out + OUT_MK + (size_t)row * D + col; *(f32x4*)o = v0; *(f32x4*)(o + 4) = v1;
                            st_bf16x8(KB + (size_t)row * D + col, v0, v1);
                        } else {
                            const int c = col - D;
                            float* o = out + OUT_MV + (size_t)row * D + c; *(f32x4*)o = v0; *(f32x4*)(o + 4) = v1;
#pragma unroll
                            for (int i = 0; i < 4; ++i) { VT[(size_t)(c + i) * 1024 + row] = (bf16_t)(cvt_pk_bf16(v0[i], 0.f) & 0xffffu); VT[(size_t)(c + 4 + i) * 1024 + row] = (bf16_t)(cvt_pk_bf16(v1[i], 0.f) & 0xffffu); }
                        }
                    }
                }
        }
    }
    __device__ __forceinline__ void strip(const SAcc& sacc, const Unit& u, int wr, int wc, int fr, int fq) const {
        const int row = u.srow + fr, rs = row - MP;
        float* pbp = (u.pn < 4) ? out + OUT_PBS + ((size_t)(rs >> 2) * PBUF + 11 + (rs & 3)) * PW : nullptr;
#pragma unroll
        for (int bj = 0; bj < 2; ++bj) {
            const int col = u.pn * 256 + bj * 128 + wc * 32 + 8 * fq + 4 * wr;
            st_bf16x4(P + (size_t)row * D + col, sacc[bj]);
            if (pbp) *(f32x4*)(pbp + col) = sacc[bj];
        }
    }
};
struct EpiPool {
    static constexpr bool AFTER_DRAIN = false;
    bf16_t* MIX; const float* scale;
    __device__ __forceinline__ void operator()(const Acc& acc, const Unit& u, int wr, int wc, int fr, int fq) const {
#pragma unroll
        for (int bj = 0; bj < 2; ++bj) {
            const int col = u.pn * 256 + bj * 128 + wc * 32 + 8 * fq;
            const f32x4 s0 = *(const f32x4*)(scale + col), s1 = *(const f32x4*)(scale + col + 4);
#pragma unroll
            for (int ai = 0; ai < 2; ++ai)
#pragma unroll
                for (int m = 0; m < 4; ++m) {
                    const int row = u.pm * 256 + ai * 128 + wr * 64 + m * 16 + fr;
                    st_bf16x8(MIX + (size_t)row * D + col, acc[ai][bj][m][0] * s0, acc[ai][bj][m][1] * s1);
                }
        }
    }
    __device__ __forceinline__ void strip(const SAcc& sacc, const Unit& u, int wr, int wc, int fr, int fq) const {
        const int row = u.srow + fr;
#pragma unroll
        for (int bj = 0; bj < 2; ++bj) {
            const int col = u.pn * 256 + bj * 128 + wc * 32 + 8 * fq + 4 * wr;
            st_bf16x4(MIX + (size_t)row * D + col, sacc[bj] * *(const f32x4*)(scale + col));
        }
    }
};
struct EpiGlu {
    static constexpr bool AFTER_DRAIN = false;
    bf16_t* MIX; const bf16_t* G; const float* bias;
    __device__ __forceinline__ void operator()(const Acc& acc, const Unit& u, int wr, int wc, int fr, int fq) const {
#pragma unroll
        for (int bj = 0; bj < 2; ++bj) {
            const int col = u.pn * 256 + bj * 128 + wc * 32 + 8 * fq;
            const f32x4 b0 = *(const f32x4*)(bias + col), b1 = *(const f32x4*)(bias + col + 4);
#pragma unroll
            for (int ai = 0; ai < 2; ++ai)
#pragma unroll
                for (int m = 0; m < 4; ++m) {
                    const int row = u.pm * 256 + ai * 128 + wr * 64 + m * 16 + fr;
                    const u32x4 gw = *(const u32x4*)(G + (size_t)row * 1024 + col);
                    const f32x4 x0 = acc[ai][bj][m][0] + b0, x1 = acc[ai][bj][m][1] + b1;
                    f32x4 o0, o1;
                    o0[0] = bf_lo(gw.x) * fast_sigmoid(x0[0]); o0[1] = bf_hi(gw.x) * fast_sigmoid(x0[1]); o0[2] = bf_lo(gw.y) * fast_sigmoid(x0[2]); o0[3] = bf_hi(gw.y) * fast_sigmoid(x0[3]);
                    o1[0] = bf_lo(gw.z) * fast_sigmoid(x1[0]); o1[1] = bf_hi(gw.z) * fast_sigmoid(x1[1]); o1[2] = bf_lo(gw.w) * fast_sigmoid(x1[2]); o1[3] = bf_hi(gw.w) * fast_sigmoid(x1[3]);
                    st_bf16x8(MIX + (size_t)row * D + 1024 + col, o0, o1);
                }
        }
    }
    __device__ __forceinline__ void strip(const SAcc& sacc, const Unit& u, int wr, int wc, int fr, int fq) const {
        const int row = u.srow + fr;
#pragma unroll
        for (int bj = 0; bj < 2; ++bj) {
            const int col = u.pn * 256 + bj * 128 + wc * 32 + 8 * fq + 4 * wr;
            const u32x2 gw = *(const u32x2*)(G + (size_t)row * 1024 + col);
            const f32x4 x = sacc[bj] + *(const f32x4*)(bias + col);
            f32x4 o; o[0] = bf_lo(gw.x) * fast_sigmoid(x[0]); o[1] = bf_hi(gw.x) * fast_sigmoid(x[1]); o[2] = bf_lo(gw.y) * fast_sigmoid(x[2]); o[3] = bf_hi(gw.y) * fast_sigmoid(x[3]);
            st_bf16x4(MIX + (size_t)row * D + 1024 + col, o);
        }
    }
};
__device__ __forceinline__ void ld_res8(const float* p, f32x4& a, f32x4& b) { a = *(const f32x4*)p; b = *(const f32x4*)(p + 4); }
__device__ __forceinline__ void ld_res8(const bf16_t* p, f32x4& a, f32x4& b) { const u32x4 w = *(const u32x4*)p; a = (f32x4){bf_lo(w.x), bf_hi(w.x), bf_lo(w.y), bf_hi(w.y)}; b = (f32x4){bf_lo(w.z), bf_hi(w.z), bf_lo(w.w), bf_hi(w.w)}; }
__device__ __forceinline__ f32x4 ld_res4(const float* p) { return *(const f32x4*)p; }
__device__ __forceinline__ f32x4 ld_res4(const bf16_t* p) { const u32x2 w = *(const u32x2*)p; return (f32x4){bf_lo(w.x), bf_hi(w.x), bf_lo(w.y), bf_hi(w.y)}; }
template <class RT>
struct EpiRes {
    static constexpr bool AFTER_DRAIN = false;
    const RT* xin_p; const RT* xin_s; float* xo; bf16_t* xb; float* ss;
    __device__ __forceinline__ void operator()(const Acc& acc, const Unit& u, int wr, int wc, int fr, int fq) const {
        const RT* xin = xin_p;
#pragma unroll
        for (int ai = 0; ai < 2; ++ai)
#pragma unroll
            for (int m = 0; m < 4; ++m) {
                const int row = u.pm * 256 + ai * 128 + wr * 64 + m * 16 + fr;
                float sq = 0.f;
#pragma unroll
                for (int bj = 0; bj < 2; ++bj) {
                    const int col = u.pn * 256 + bj * 128 + wc * 32 + 8 * fq;
                    const size_t off = (size_t)row * D + col;
                    f32x4 r0, r1; ld_res8(xin + off, r0, r1);
                    const f32x4 v0 = acc[ai][bj][m][0] + r0, v1 = acc[ai][bj][m][1] + r1;
                    if (xo) { *(f32x4*)(xo + off) = v0; *(f32x4*)(xo + off + 4) = v1; }
                    if (xb) st_bf16x8(xb + off, v0, v1);
                    sq += (v0[0] * v0[0] + v0[1] * v0[1]) + (v0[2] * v0[2] + v0[3] * v0[3]) + (v1[0] * v1[0] + v1[1] * v1[1]) + (v1[2] * v1[2] + v1[3] * v1[3]);
                }
                sq += __shfl_xor(sq, 16); sq += __shfl_xor(sq, 32);
                if (fq == 0) atomicAdd(ss + row, sq);
            }
    }
    __device__ __forceinline__ void strip(const SAcc& sacc, const Unit& u, int wr, int wc, int fr, int fq) const {
        const int row = u.srow + fr; const RT* xin = xin_s - (size_t)MP * D;
        float sq = 0.f;
#pragma unroll
        for (int bj = 0; bj < 2; ++bj) {
            const int col = u.pn * 256 + bj * 128 + wc * 32 + 8 * fq + 4 * wr;
            const size_t off = (size_t)row * D + col;
            const f32x4 v = sacc[bj] + ld_res4(xin + off);
            if (xo) *(f32x4*)(xo + off) = v;
            if (xb) st_bf16x4(xb + off, v);
            sq += (v[0] * v[0] + v[1] * v[1]) + (v[2] * v[2] + v[3] * v[3]);
        }
        sq += __shfl_xor(sq, 16); sq += __shfl_xor(sq, 32);
        if (fq == 0) atomicAdd(ss + row, sq);
    }
};
struct EpiFinal {
    static constexpr bool AFTER_DRAIN = true;
    const bf16_t* xin; float* out; float* ss; unsigned* cnt; const float* gf;
    __device__ __forceinline__ void operator()(const Acc&, const Unit&, int, int, int, int) const {}
    __device__ __forceinline__ void fused(Acc& acc, f32x4 (&sacc)[2], const Unit& u, int wr, int wc, int fr, int fq, LAS unsigned char* lds, int wid, int lane) const {
#pragma unroll
        for (int ai = 0; ai < 2; ++ai)
#pragma unroll
            for (int m = 0; m < 4; ++m) {
                const int row = u.pm * 256 + ai * 128 + wr * 64 + m * 16 + fr;
                float sq = 0.f;
#pragma unroll
                for (int bj = 0; bj < 2; ++bj) {
                    const size_t off = (size_t)row * D + u.pn * 256 + bj * 128 + wc * 32 + 8 * fq;
                    f32x4 r0, r1; ld_res8(xin + off, r0, r1);
                    const f32x4 v0 = acc[ai][bj][m][0] + r0, v1 = acc[ai][bj][m][1] + r1; acc[ai][bj][m][0] = v0; acc[ai][bj][m][1] = v1;
                    sq += (v0[0] * v0[0] + v0[1] * v0[1]) + (v0[2] * v0[2] + v0[3] * v0[3]) + (v1[0] * v1[0] + v1[1] * v1[1]) + (v1[2] * v1[2] + v1[3] * v1[3]);
                }
                sq += __shfl_xor(sq, 16); sq += __shfl_xor(sq, 32);
                if (fq == 0) { const float old = atomicAdd(ss + row, sq); asm volatile("" :: "v"(old)); }
            }
        const int srow = u.srow + fr;
        {
            float sq = 0.f;
#pragma unroll
            for (int bj = 0; bj < 2; ++bj) {
                const size_t off = (size_t)srow * D + u.pn * 256 + bj * 128 + wc * 32 + 8 * fq + 4 * wr;
                const f32x4 v = sacc[bj] + ld_res4(xin + off); sacc[bj] = v;
                sq += (v[0] * v[0] + v[1] * v[1]) + (v[2] * v[2] + v[3] * v[3]);
            }
            sq += __shfl_xor(sq, 16); sq += __shfl_xor(sq, 32);
            if (fq == 0) { const float old = atomicAdd(ss + srow, sq); asm volatile("" :: "v"(old)); }
        }
        asm volatile("s_waitcnt vmcnt(0)" ::: "memory");
        __builtin_amdgcn_s_barrier();
        if (wid == 0 && lane == 0) {
            unsigned* cw = cnt + 64 * u.pm;
            __hip_atomic_fetch_add(cw, 1u, __ATOMIC_RELEASE, __HIP_MEMORY_SCOPE_AGENT);
            unsigned sp = 0;
            while (__hip_atomic_load(cw, __ATOMIC_RELAXED, __HIP_MEMORY_SCOPE_AGENT) < 8u) { __builtin_amdgcn_s_sleep(1); if (++sp > (1u << 22)) break; }
            __builtin_amdgcn_fence(__ATOMIC_ACQUIRE, "agent");
            asm volatile("s_waitcnt vmcnt(0)" ::: "memory");
        }
        __builtin_amdgcn_s_barrier(); asm volatile("" ::: "memory");
        f32x4 g0[2], g1[2];
#pragma unroll
        for (int bj = 0; bj < 2; ++bj) { const int col = u.pn * 256 + bj * 128 + wc * 32 + 8 * fq; g0[bj] = *(const f32x4*)(gf + col); g1[bj] = *(const f32x4*)(gf + col + 4); }
#pragma unroll
        for (int ai = 0; ai < 2; ++ai)
#pragma unroll
            for (int m = 0; m < 4; ++m) {
                const int row = u.pm * 256 + ai * 128 + wr * 64 + m * 16 + fr;
                const float rs = rsqrtf(__hip_atomic_load(ss + row, __ATOMIC_RELAXED, __HIP_MEMORY_SCOPE_AGENT) * (1.0f / D) + EPS);
#pragma unroll
                for (int bj = 0; bj < 2; ++bj) {
                    const size_t off = (size_t)row * D + u.pn * 256 + bj * 128 + wc * 32 + 8 * fq;
                    *(f32x4*)(out + off) = acc[ai][bj][m][0] * rs * g0[bj]; *(f32x4*)(out + off + 4) = acc[ai][bj][m][1] * rs * g1[bj];
                }
            }
        {
            const float rs = rsqrtf(__hip_atomic_load(ss + srow, __ATOMIC_RELAXED, __HIP_MEMORY_SCOPE_AGENT) * (1.0f / D) + EPS);
#pragma unroll
            for (int bj = 0; bj < 2; ++bj) {
                const int col = u.pn * 256 + bj * 128 + wc * 32 + 8 * fq + 4 * wr;
                *(f32x4*)(out + (size_t)srow * D + col) = sacc[bj] * rs * *(const f32x4*)(gf + col);
            }
        }
    }
};
struct EpiQ {
    static constexpr bool AFTER_DRAIN = false;
    bf16_t* Q; const float* ss;
    __device__ __forceinline__ void operator()(const Acc& acc, const Unit& u, int wr, int wc, int fr, int fq) const {
#pragma unroll
        for (int ai = 0; ai < 2; ++ai)
#pragma unroll
            for (int m = 0; m < 4; ++m) {
                const int row = u.pm * 256 + ai * 128 + wr * 64 + m * 16 + fr;
                const float rs = rsqrtf(ss[row] * (1.0f / D) + EPS);
#pragma unroll
                for (int bj = 0; bj < 2; ++bj) {
                    const int col = u.pn * 256 + bj * 128 + wc * 32 + 8 * fq;
                    st_bf16x8(Q + (size_t)row * D + col, acc[ai][bj][m][0] * rs, acc[ai][bj][m][1] * rs);
                }
            }
    }
    __device__ __forceinline__ void strip(const SAcc& sacc, const Unit& u, int wr, int wc, int fr, int fq) const {
        const int row = u.srow + fr; const float rs = rsqrtf(ss[row] * (1.0f / D) + EPS);
#pragma unroll
        for (int bj = 0; bj < 2; ++bj) st_bf16x4(Q + (size_t)row * D + u.pn * 256 + bj * 128 + wc * 32 + 8 * fq + 4 * wr, sacc[bj] * rs);
    }
};
struct EpiGateUp {
    static constexpr bool AFTER_DRAIN = false;
    bf16_t* H; const float* ss;
    __device__ __forceinline__ void operator()(const Acc& acc, const Unit& u, int wr, int wc, int fr, int fq) const {
        const int col = u.pn * 128 + wc * 32 + 8 * fq;
#pragma unroll
        for (int ai = 0; ai < 2; ++ai)
#pragma unroll
            for (int m = 0; m < 4; ++m) {
                const int row = u.pm * 256 + ai * 128 + wr * 64 + m * 16 + fr;
                const float rs = rsqrtf(ss[row] * (1.0f / D) + EPS);
                f32x4 o[2];
#pragma unroll
                for (int n = 0; n < 2; ++n)
#pragma unroll
                    for (int j = 0; j < 4; ++j) { const float gt = acc[ai][0][m][n][j] * rs, up = acc[ai][1][m][n][j] * rs; o[n][j] = gt * fast_sigmoid(gt) * up; }
                st_bf16x8(H + (size_t)row * FF + col, o[0], o[1]);
            }
    }
    __device__ __forceinline__ void strip(const SAcc& sacc, const Unit& u, int wr, int wc, int fr, int fq) const {
        const int row = u.srow + fr; const float rs = rsqrtf(ss[row] * (1.0f / D) + EPS);
        f32x4 o;
#pragma unroll
        for (int j = 0; j < 4; ++j) { const float gt = sacc[0][j] * rs, up = sacc[1][j] * rs; o[j] = gt * fast_sigmoid(gt) * up; }
        st_bf16x4(H + (size_t)row * FF + u.pn * 128 + wc * 32 + 8 * fq + 4 * wr, o);
    }
};
struct EpiPV {
    static constexpr bool AFTER_DRAIN = false;
    bf16_t* ATT;
    __device__ __forceinline__ void operator()(const Acc& acc, const Unit& u, int wr, int wc, int fr, int fq) const {
#pragma unroll
        for (int ai = 0; ai < 2; ++ai)
#pragma unroll
            for (int m = 0; m < 4; ++m) {
                const int row = u.pm * 256 + ai * 128 + wr * 64 + m * 16 + fr;
#pragma unroll
                for (int bj = 0; bj < 2; ++bj) {
                    const int col = u.pn * 256 + bj * 128 + wc * 32 + 8 * fq;
                    st_bf16x8(ATT + (size_t)row * D + col, acc[ai][bj][m][0], acc[ai][bj][m][1]);
                }
            }
    }
};
struct EpiSoftmax {
    static constexpr bool AFTER_DRAIN = true;
    bf16_t* PR;
    __device__ __forceinline__ void operator()(const Acc&, const Unit&, int, int, int, int) const {}
    __device__ __forceinline__ void fused(Acc& acc, f32x4 (&)[2], const Unit& u, int wr, int wc, int fr, int fq, LAS unsigned char* lds, int wid, int lane) const {
        LAS float* MX = (LAS float*)lds;
        LAS float* SM = (LAS float*)(lds + 4096);
#pragma unroll
        for (int ai = 0; ai < 2; ++ai)
#pragma unroll
            for (int m = 0; m < 4; ++m) {
                float mx = -3.0e38f;
#pragma unroll
                for (int bj = 0; bj < 2; ++bj)
#pragma unroll
                    for (int n = 0; n < 2; ++n)
#pragma unroll
                        for (int j = 0; j < 4; ++j) mx = fmaxf(mx, acc[ai][bj][m][n][j]);
                mx = fmaxf(mx, __shfl_xor(mx, 16)); mx = fmaxf(mx, __shfl_xor(mx, 32));
                if (fq == 0) MX[(ai * 128 + wr * 64 + m * 16 + fr) * 4 + wc] = mx;
            }
        LDS_WAIT(); __builtin_amdgcn_s_barrier(); asm volatile("" ::: "memory");
#pragma unroll
        for (int ai = 0; ai < 2; ++ai)
#pragma unroll
            for (int m = 0; m < 4; ++m) {
                const int r = ai * 128 + wr * 64 + m * 16 + fr;
                const f32x4 mv = *(const LAS f32x4*)(MX + r * 4);
                const float mx = fmaxf(fmaxf(mv[0], mv[1]), fmaxf(mv[2], mv[3]));
                float sm = 0.f;
#pragma unroll
                for (int bj = 0; bj < 2; ++bj)
#pragma unroll
                    for (int n = 0; n < 2; ++n)
#pragma unroll
                        for (int j = 0; j < 4; ++j) { const float e = __expf(acc[ai][bj][m][n][j] - mx); acc[ai][bj][m][n][j] = e; sm += e; }
                sm += __shfl_xor(sm, 16); sm += __shfl_xor(sm, 32);
                if (fq == 0) SM[r * 4 + wc] = sm;
            }
        LDS_WAIT(); __builtin_amdgcn_s_barrier(); asm volatile("" ::: "memory");
#pragma unroll
        for (int ai = 0; ai < 2; ++ai)
#pragma unroll
            for (int m = 0; m < 4; ++m) {
                const int r = ai * 128 + wr * 64 + m * 16 + fr;
                const f32x4 sv = *(const LAS f32x4*)(SM + r * 4);
                const float inv = __builtin_amdgcn_rcpf((sv[0] + sv[1]) + (sv[2] + sv[3]));
#pragma unroll
                for (int bj = 0; bj < 2; ++bj) {
                    const int col = bj * 128 + wc * 32 + 8 * fq;
                    st_bf16x8(PR + ((size_t)u.job * SEQ + u.pm * 256 + r) * 256 + col, acc[ai][bj][m][0] * inv, acc[ai][bj][m][1] * inv);
                }
            }
        LDS_WAIT(); __builtin_amdgcn_s_barrier(); asm volatile("" ::: "memory");
    }
};
}
using pg8::Unit;

enum { I_XP = 0, I_XS = 1, I_MEM = 2, I_PBUF = 3, I_SRE = 4, I_SIM = 5, I_CK = 6, I_CV = 7, I_GMIX = 8, I_WIN = 9, I_WPOOL = 10, I_PSCALE = 11,
       I_LRE = 12, I_LIM = 13, I_LSTEP = 14, I_BRE = 15, I_BIM = 16, I_CRE = 17, I_CIM = 18, I_SSMD = 19, I_WGLU = 20, I_BGLU = 21, I_WOUT = 22,
       I_GCROSS = 23, I_GMEM = 24, I_WQ = 25, I_WK = 26, I_WV = 27, I_WO = 28, I_GFFN = 29, I_WGATE = 30, I_WUP = 31, I_WDOWN = 32, I_GFINAL = 33 };
struct Args {
    const float* in[34];
    float* out; unsigned char* ws;
};

struct CvItem { const float* src; bf16_t* dst; const float* gk; float sc; int N, ldt; };
__device__ __forceinline__ void cv_load(const CvItem& it, f32x4 (&v)[8], float (&g)[8], int lane) {
#pragma unroll
    for (int i = 0; i < 8; ++i) { const int kk = (lane >> 3) + 8 * i; v[i] = *(const f32x4*)(it.src + (size_t)kk * it.N + 4 * (lane & 7)); g[i] = it.gk ? it.gk[kk] : 1.0f; }
}
__device__ __forceinline__ void cv_finish(const CvItem& it, const f32x4 (&v)[8], const float (&g)[8], LAS float* scr, int lane) {
#pragma unroll
    for (int i = 0; i < 8; ++i) { const int kk = (lane >> 3) + 8 * i; const float m = g[i] * it.sc; LAS float* d = scr + kk * 33 + 4 * (lane & 7);
        d[0] = v[i][0] * m; d[1] = v[i][1] * m; d[2] = v[i][2] * m; d[3] = v[i][3] * m; }
    LDS_WAIT(); __builtin_amdgcn_wave_barrier();
    const int c = lane & 7;
#pragma unroll
    for (int j = 0; j < 4; ++j) { const int n = (lane >> 3) + 8 * j; const LAS float* q = scr + (8 * c) * 33 + n;
        u32x4 o; o.x = cvt_pk_bf16(q[0 * 33], q[1 * 33]); o.y = cvt_pk_bf16(q[2 * 33], q[3 * 33]); o.z = cvt_pk_bf16(q[4 * 33], q[5 * 33]); o.w = cvt_pk_bf16(q[6 * 33], q[7 * 33]);
        *(u32x4*)(it.dst + (size_t)n * it.ldt + 8 * c) = o; }
    LDS_WAIT(); __builtin_amdgcn_wave_barrier();
}
__device__ __forceinline__ void rms_row_to_bf16(const float* xrow, const float* g, bf16_t* orow, int lane) {
    const f32x4* xr = (const f32x4*)xrow + lane; const f32x4* gr = (const f32x4*)g + lane;
    f32x4 v[8]; float s = 0.f;
#pragma unroll
    for (int j = 0; j < 8; ++j) { v[j] = xr[64 * j]; s += (v[j][0] * v[j][0] + v[j][1] * v[j][1]) + (v[j][2] * v[j][2] + v[j][3] * v[j][3]); }
    const float rstd = rsqrtf(wave_sum(s) * (1.0f / D) + EPS);
    u32x2* o8 = (u32x2*)orow + lane;
#pragma unroll
    for (int j = 0; j < 8; ++j) { const f32x4 gg = gr[64 * j]; u32x2 w; w.x = cvt_pk_bf16(v[j][0] * rstd * gg[0], v[j][1] * rstd * gg[1]); w.y = cvt_pk_bf16(v[j][2] * rstd * gg[2], v[j][3] * rstd * gg[3]); o8[64 * j] = w; }
}
__device__ __forceinline__ void cmul(float ar, float ai, float br, float bi, float& cr, float& ci) { cr = ar * br - ai * bi; ci = ar * bi + ai * br; }

__device__ __forceinline__ void ssm_chan(const float* lam_re, const float* lam_im, float delta, int g, int ch, float& ar, float& ai, float& kr, float& ki) {
    const float lr = lam_re[g * 64 + ch], li = lam_im[g * 64 + ch];
    const float mag = expf(lr * delta);
    double rev = (double)li * (double)delta * 0.15915494309189535; rev -= __builtin_rint(rev);
    const float rv = (float)rev;
    ar = mag * __builtin_amdgcn_cosf(rv); ai = mag * __builtin_amdgcn_sinf(rv);
    const float nr = ar - 1.0f, ni = ai, den = 1.0f / (lr * lr + li * li);
    kr = (nr * lr + ni * li) * den; ki = (ni * lr - nr * li) * den;
}

__device__ __forceinline__ void ssm_tables(const Args& A, int g, int lane) {
    const float* lam_re = A.in[I_LRE]; const float* lam_im = A.in[I_LIM]; const float* log_step = A.in[I_LSTEP];
    const float* b_re = A.in[I_BRE]; const float* b_im = A.in[I_BIM]; const float* c_re = A.in[I_CRE]; const float* c_im = A.in[I_CIM];
    float* ABAR = (float*)(A.ws + O_ABAR); bf16_t* BB = (bf16_t*)(A.ws + O_BB); bf16_t* CM = (bf16_t*)(A.ws + O_CM);
    const float delta = expf(log_step[g]);
    {
        float ar, ai, kr, ki; ssm_chan(lam_re, lam_im, delta, g, lane, ar, ai, kr, ki);
        float pr = ar, pi = ai;
#pragma unroll
        for (int s = 0; s < 7; ++s) { float tr, ti; cmul(pr, pi, pr, pi, tr, ti); pr = tr; pi = ti; }
        *(f32x4*)(ABAR + ((size_t)g * 64 + lane) * 4) = (f32x4){ar, ai, pr, pi};
    }
    {
        const int j = lane & 31, hi = lane >> 5;
#pragma unroll
        for (int half = 0; half < 2; ++half) {
            const int ch = j + 32 * half; float ar, ai, kr, ki; ssm_chan(lam_re, lam_im, delta, g, ch, ar, ai, kr, ki);
            float vr[8], vi[8];
#pragma unroll
            for (int i = 0; i < 8; ++i) { const int c = 8 * hi + i; const float br = b_re[((size_t)g * 64 + ch) * 16 + c], bi = b_im[((size_t)g * 64 + ch) * 16 + c]; cmul(kr, ki, br, bi, vr[i], vi[i]); }
            u32x4 wr_, wi_;
            wr_.x = cvt_pk_bf16(vr[0], vr[1]); wr_.y = cvt_pk_bf16(vr[2], vr[3]); wr_.z = cvt_pk_bf16(vr[4], vr[5]); wr_.w = cvt_pk_bf16(vr[6], vr[7]);
            wi_.x = cvt_pk_bf16(vi[0], vi[1]); wi_.y = cvt_pk_bf16(vi[2], vi[3]); wi_.z = cvt_pk_bf16(vi[4], vi[5]); wi_.w = cvt_pk_bf16(vi[6], vi[7]);
            *(u32x4*)(BB + (((size_t)g * 4 + half) * 64 + lane) * 8) = wr_;
            *(u32x4*)(BB + (((size_t)g * 4 + 2 + half) * 64 + lane) * 8) = wi_;
        }
    }
    {
        const int c = lane & 15, fq = lane >> 4;
#pragma unroll
        for (int ks = 0; ks < 4; ++ks) {
            float v[8];
#pragma unroll
            for (int i = 0; i < 8; ++i) { const int k = 32 * ks + 8 * fq + i, jj = k >> 2, sel = k & 3, ch = jj + 32 * (sel >> 1);
                v[i] = (sel & 1) ? -c_im[((size_t)g * 16 + c) * 64 + ch] : c_re[((size_t)g * 16 + c) * 64 + ch]; }
            u32x4 w; w.x = cvt_pk_bf16(v[0], v[1]); w.y = cvt_pk_bf16(v[2], v[3]); w.z = cvt_pk_bf16(v[4], v[5]); w.w = cvt_pk_bf16(v[6], v[7]);
            *(u32x4*)(CM + (((size_t)g * 4 + ks) * 64 + lane) * 8) = w;
        }
    }
}

constexpr int I_SQ = (D / 64) * (D / 32);
constexpr int I_POOL = 4 * (256 / 64) * (256 / 32);
constexpr int I_GLU = (1024 / 64) * (1024 / 32);
constexpr int I_FF = (D / 64) * (FF / 32);
constexpr int I_DN = (FF / 64) * (D / 32);
constexpr int NITEMS = 6 * I_SQ + I_POOL + I_GLU + 2 * I_FF + I_DN, NEARLY = 3 * I_SQ, NP9 = 2560;
__device__ __forceinline__ CvItem cv_decode(const Args& A, int r) {
    unsigned char* ws = A.ws; CvItem it; it.gk = nullptr; it.sc = 1.f;
    const float* W; bf16_t* WT; int N, ldt, k0, n0, row0; const float* gkb = nullptr;
    if (r < 6 * I_SQ) {
        const int mtx = r / I_SQ; r -= mtx * I_SQ; const int kb = r / (D / 32), nb = r % (D / 32);
        N = D; ldt = D; k0 = 64 * kb; n0 = 32 * nb; row0 = n0;
        switch (mtx) {
            case 0: W = A.in[I_WIN]; WT = (bf16_t*)(ws + O_WIN); break;
            case 1: W = A.in[I_WK]; WT = (bf16_t*)(ws + O_WKV); break;
            case 2: W = A.in[I_WV]; WT = (bf16_t*)(ws + O_WKV); row0 += D; break;
            case 3: W = A.in[I_WOUT]; WT = (bf16_t*)(ws + O_WOUT); break;
            case 4: W = A.in[I_WQ]; WT = (bf16_t*)(ws + O_WQ); gkb = A.in[I_GCROSS]; it.sc = 0.04419417382415922f; break;
            default: W = A.in[I_WO]; WT = (bf16_t*)(ws + O_WO); break;
        }
    } else if ((r -= 6 * I_SQ) < I_POOL) {
        const int gg = r / 32, q = r % 32, kb = q / 8, nb = q % 8;
        W = A.in[I_WPOOL] + (size_t)gg * 65536; WT = (bf16_t*)(ws + O_WPOOL); N = 256; ldt = 256; k0 = 64 * kb; n0 = 32 * nb; row0 = gg * 256 + n0;
    } else if ((r -= I_POOL) < I_GLU) {
        const int kb = r / 32, nb = r % 32; W = A.in[I_WGLU]; WT = (bf16_t*)(ws + O_WGLU); N = 1024; ldt = 1024; k0 = 64 * kb; n0 = 32 * nb; row0 = n0;
    } else if ((r -= I_GLU) < 2 * I_FF) {
        const int up = r / I_FF; r -= up * I_FF; const int kb = r / (FF / 32), nb = r % (FF / 32);
        W = up ? A.in[I_WUP] : A.in[I_WGATE]; WT = (bf16_t*)(ws + O_WGU); N = FF; ldt = D; k0 = 64 * kb; n0 = 32 * nb; row0 = (n0 >> 7) * 256 + up * 128 + (n0 & 127); gkb = A.in[I_GFFN];
    } else {
        r -= 2 * I_FF; const int kb = r / (D / 32), nb = r % (D / 32);
        W = A.in[I_WDOWN]; WT = (bf16_t*)(ws + O_WDN); N = D; ldt = FF; k0 = 64 * kb; n0 = 32 * nb; row0 = n0;
    }
    it.src = W + (size_t)k0 * N + n0; it.dst = WT + (size_t)row0 * ldt + k0; it.gk = gkb ? gkb + k0 : nullptr; it.N = N; it.ldt = ldt;
    return it;
}
__device__ __forceinline__ void convert_weights(const Args& A, LAS unsigned char* lds, int lo, int hi, int gw, int NGW, const int wv) {
    const int tid = opaque_tid(wv), lane = tid & 63, wave = __builtin_amdgcn_readfirstlane(tid >> 6);
    LAS float* scr = (LAS float*)(lds + wave * 16384);
    if (gw < 0) return;
    int it = lo + gw; if (it >= hi) return;
    CvItem cur = cv_decode(A, it); f32x4 va[8]; float ga[8]; cv_load(cur, va, ga, lane);
    for (;;) {
        const int nit = it + NGW; const bool hn = nit < hi;
        CvItem nx = cur; f32x4 vb[8]; float gb[8];
        if (hn) { nx = cv_decode(A, nit); cv_load(nx, vb, gb, lane); }
        cv_finish(cur, va, ga, scr, lane);
        if (!hn) break;
        cur = nx; it = nit;
#pragma unroll
        for (int i = 0; i < 8; ++i) { va[i] = vb[i]; ga[i] = gb[i]; }
    }
}
__device__ __forceinline__ const float* p0_src(const Args& A, int m) { return m < MP ? A.in[I_XP] + (size_t)m * D : (m < M ? A.in[I_XS] + (size_t)(m - MP) * D : A.in[I_MEM] + (size_t)(m - M) * D); }
__device__ __forceinline__ void phase0_rest(const Args& A, int G, const int wv) {
    const int tid = opaque_tid(wv), lane = tid & 63, wave = __builtin_amdgcn_readfirstlane(tid >> 6);
    const int gw = blockIdx.x * 8 + wave, NGW = G * 8;
    unsigned char* ws = A.ws;
    {
        int m = gw;
        if (m < M + 1024) {
            f32x4 v[8];
            { const f32x4* xr = (const f32x4*)p0_src(A, m) + lane;
#pragma unroll
              for (int jj = 0; jj < 8; ++jj) v[jj] = xr[64 * jj]; }
            for (;;) {
                const int nm = m + NGW; const bool hn = nm < M + 1024;
                f32x4 nv[8];
                if (hn) { const f32x4* xr = (const f32x4*)p0_src(A, nm) + lane;
#pragma unroll
                    for (int jj = 0; jj < 8; ++jj) nv[jj] = xr[64 * jj]; }
                float sq = 0.f;
#pragma unroll
                for (int jj = 0; jj < 8; ++jj) sq += (v[jj][0] * v[jj][0] + v[jj][1] * v[jj][1]) + (v[jj][2] * v[jj][2] + v[jj][3] * v[jj][3]);
                const float rstd = rsqrtf(wave_sum(sq) * (1.0f / D) + EPS);
                const f32x4* gr = (const f32x4*)(m < M ? A.in[I_GMIX] : A.in[I_GMEM]) + lane;
                u32x2* o8 = (u32x2*)(m < M ? (bf16_t*)(ws + O_HMIX) + (size_t)m * D : (bf16_t*)(ws + O_MN) + (size_t)(m - M) * D) + lane;
#pragma unroll
                for (int jj = 0; jj < 8; ++jj) { const f32x4 gg = gr[64 * jj]; u32x2 wq; wq.x = cvt_pk_bf16(v[jj][0] * rstd * gg[0], v[jj][1] * rstd * gg[1]); wq.y = cvt_pk_bf16(v[jj][2] * rstd * gg[2], v[jj][3] * rstd * gg[3]); o8[64 * jj] = wq; }
                if (!hn) break;
#pragma unroll
                for (int jj = 0; jj < 8; ++jj) v[jj] = nv[jj];
                m = nm;
            }
        }
    }
    for (int g = gw; g < NG; g += NGW) ssm_tables(A, g, lane);
    {
        const f32x4* src = (const f32x4*)A.in[I_PBUF]; f32x4* dst = (f32x4*)(A.out + OUT_PBS);
        const int total = DB * 11 * (PW / 4);
        for (int i = blockIdx.x * 512 + tid; i < total; i += G * 512) { const int b = i / (11 * 256), r = i % (11 * 256); dst[(size_t)b * (15 * 256) + r] = src[(size_t)b * (15 * 256) + 4 * 256 + r]; }
    }
}

__device__ __forceinline__ void acc8(float (&s)[8], u32x4 w) {
    s[0] += bf_lo(w.x); s[1] += bf_hi(w.x); s[2] += bf_lo(w.y); s[3] += bf_hi(w.y); s[4] += bf_lo(w.z); s[5] += bf_hi(w.z); s[6] += bf_lo(w.w); s[7] += bf_hi(w.w);
}
template <int W>
__device__ __forceinline__ void pooled_prompt_item(const bf16_t* P, bf16_t* PO, int row0, int col) {
    const int t0 = row0 & (SEQ - 1);
    u32x4 z[W + 7];
#pragma unroll
    for (int i = 0; i < W + 7; ++i) {
        const int t = t0 - (W - 1) + i;
        z[i] = (u32x4){0u, 0u, 0u, 0u};
        if (t >= 0) z[i] = *(const u32x4*)(P + (size_t)(row0 - (W - 1) + i) * D + col);
    }
    float s[8] = {0.f, 0.f, 0.f, 0.f, 0.f, 0.f, 0.f, 0.f};
#pragma unroll
    for (int i = 0; i < W - 1; ++i) acc8(s, z[i]);
#pragma unroll
    for (int o = 0; o < 8; ++o) {
        const u32x4 uw = z[o + W - 1];
        acc8(s, uw);
        const int n = (t0 + o + 1 < W) ? t0 + o + 1 : W; const float ic = 1.0f / (float)n;
        u32x4 ow;
        ow.x = cvt_pk_bf16(s[0] * ic - bf_lo(uw.x), s[1] * ic - bf_hi(uw.x)); ow.y = cvt_pk_bf16(s[2] * ic - bf_lo(uw.y), s[3] * ic - bf_hi(uw.y));
        ow.z = cvt_pk_bf16(s[4] * ic - bf_lo(uw.z), s[5] * ic - bf_hi(uw.z)); ow.w = cvt_pk_bf16(s[6] * ic - bf_lo(uw.w), s[7] * ic - bf_hi(uw.w));
        *(u32x4*)(PO + (size_t)(row0 + o) * 1024 + col) = ow;
        const u32x4 zo = z[o];
        s[0] -= bf_lo(zo.x); s[1] -= bf_hi(zo.x); s[2] -= bf_lo(zo.y); s[3] -= bf_hi(zo.y); s[4] -= bf_lo(zo.z); s[5] -= bf_hi(zo.z); s[6] -= bf_lo(zo.w); s[7] -= bf_hi(zo.w);
    }
}
template <int W>
__device__ __forceinline__ void pooled_sample_item(const bf16_t* P, bf16_t* PO, const float* sbuf, int b, int col) {
    float h[W - 1][8];
#pragma unroll
    for (int i = 0; i < W - 1; ++i) { const float* q = sbuf + ((size_t)b * PBUF + (PBUF - (W - 1) + i)) * PW + col; const f32x4 a = *(const f32x4*)q, c = *(const f32x4*)(q + 4);
        h[i][0] = a[0]; h[i][1] = a[1]; h[i][2] = a[2]; h[i][3] = a[3]; h[i][4] = c[0]; h[i][5] = c[1]; h[i][6] = c[2]; h[i][7] = c[3]; }
    u32x4 z[4];
#pragma unroll
    for (int t = 0; t < 4; ++t) z[t] = *(const u32x4*)(P + ((size_t)MP + b * 4 + t) * D + col);
    float s[8] = {0.f, 0.f, 0.f, 0.f, 0.f, 0.f, 0.f, 0.f};
#pragma unroll
    for (int i = 0; i < W - 1; ++i)
#pragma unroll
        for (int j = 0; j < 8; ++j) s[j] += h[i][j];
    const float ic = 1.0f / (float)W;
#pragma unroll
    for (int t = 0; t < 4; ++t) {
        const u32x4 uw = z[t];
        acc8(s, uw);
        u32x4 o;
        o.x = cvt_pk_bf16(s[0] * ic - bf_lo(uw.x), s[1] * ic - bf_hi(uw.x)); o.y = cvt_pk_bf16(s[2] * ic - bf_lo(uw.y), s[3] * ic - bf_hi(uw.y));
        o.z = cvt_pk_bf16(s[4] * ic - bf_lo(uw.z), s[5] * ic - bf_hi(uw.z)); o.w = cvt_pk_bf16(s[6] * ic - bf_lo(uw.w), s[7] * ic - bf_hi(uw.w));
        *(u32x4*)(PO + ((size_t)MP + b * 4 + t) * 1024 + col) = o;
        if (t < W - 1) {
#pragma unroll
            for (int j = 0; j < 8; ++j) s[j] -= h[t < W - 1 ? t : 0][j];
        } else {
            const u32x4 zo = z[t - (W - 1) >= 0 ? t - (W - 1) : 0];
            s[0] -= bf_lo(zo.x); s[1] -= bf_hi(zo.x); s[2] -= bf_lo(zo.y); s[3] -= bf_hi(zo.y); s[4] -= bf_lo(zo.z); s[5] -= bf_hi(zo.z); s[6] -= bf_lo(zo.w); s[7] -= bf_hi(zo.w);
        }
    }
}
__device__ __forceinline__ void pooled_phase(const Args& A, int G, const int wv) {
    const bf16_t* P = (const bf16_t*)(A.ws + O_P); bf16_t* PO = (bf16_t*)(A.ws + O_POOLED); const float* sbuf = A.in[I_PBUF];
    const int tid0 = blockIdx.x * 512 + opaque_tid(wv);
    for (int it = tid0; it < 4 * 1024 * 32; it += G * 512) {
        const int g = it >> 15, rb = (it >> 5) & 1023, col = g * 256 + (it & 31) * 8, row0 = rb * 8;
        if (g == 0) pooled_prompt_item<2>(P, PO, row0, col); else if (g == 1) pooled_prompt_item<4>(P, PO, row0, col);
        else if (g == 2) pooled_prompt_item<8>(P, PO, row0, col); else pooled_prompt_item<16>(P, PO, row0, col);
    }
    for (int it = tid0; it < 4 * DB * 32; it += G * 512) {
        const int g = it >> 12, b = (it >> 5) & (DB - 1), col = g * 256 + (it & 31) * 8;
        if (g == 0) pooled_sample_item<2>(P, PO, sbuf, b, col); else if (g == 1) pooled_sample_item<4>(P, PO, sbuf, b, col);
        else if (g == 2) pooled_sample_item<8>(P, PO, sbuf, b, col); else pooled_sample_item<16>(P, PO, sbuf, b, col);
    }
}

struct SsmCtx {
    bf16x8 BB[4], CMf[4];
    float a[4];
    float dsk[4];
    float s[4];
};
template <int MODE>
__device__ __forceinline__ void ssm_sub(SsmCtx& cx, const bf16_t* P, bf16_t* Gout, int g, const bf16x8 af  ,
                                        const size_t (&yrow)[2]  , LAS unsigned char* tile, int lane,
                                        const float* h_re, const float* h_im, float* o_re, float* o_im, int sbatch0  ) {
    const int j = lane & 31, hi = lane >> 5, fr = lane & 15, fq = lane >> 4;
    u32x2 uwp[2] = {(u32x2){0u, 0u}, (u32x2){0u, 0u}};
    if (MODE != 0) { uwp[0] = *(const u32x2*)(P + yrow[0] * D + 1024 + 16 * g + 4 * fq); uwp[1] = *(const u32x2*)(P + yrow[1] * D + 1024 + 16 * g + 4 * fq); }
    float hs[4][4];
    if (MODE == 2) {
#pragma unroll
        for (int q = 0; q < 4; ++q) { const size_t o = ((size_t)(sbatch0 + q) * NG + g) * 64 + j; hs[q][0] = h_re[o]; hs[q][1] = h_im[o]; hs[q][2] = h_re[o + 32]; hs[q][3] = h_im[o + 32]; }
    }
    const f32x16 z = {0.f, 0.f, 0.f, 0.f, 0.f, 0.f, 0.f, 0.f, 0.f, 0.f, 0.f, 0.f, 0.f, 0.f, 0.f, 0.f};
    const f32x16 r0 = __builtin_amdgcn_mfma_f32_32x32x16_bf16(af, cx.BB[0], z, 0, 0, 0);
    const f32x16 r1 = __builtin_amdgcn_mfma_f32_32x32x16_bf16(af, cx.BB[1], z, 0, 0, 0);
    const f32x16 i0 = __builtin_amdgcn_mfma_f32_32x32x16_bf16(af, cx.BB[2], z, 0, 0, 0);
    const f32x16 i1 = __builtin_amdgcn_mfma_f32_32x32x16_bf16(af, cx.BB[3], z, 0, 0, 0);
    float sr0 = cx.s[0], si0 = cx.s[1], sr1 = cx.s[2], si1 = cx.s[3];
    const float ar0 = cx.a[0], ai0 = cx.a[1], ar1 = cx.a[2], ai1 = cx.a[3];
#pragma unroll
    for (int r = 0; r < 16; ++r) {
        if (MODE == 2 && (r & 3) == 0) { sr0 = hs[r >> 2][0]; si0 = hs[r >> 2][1]; sr1 = hs[r >> 2][2]; si1 = hs[r >> 2][3]; }
        const float nr0 = fmaf(ar0, sr0, fmaf(-ai0, si0, r0[r])), ni0 = fmaf(ar0, si0, fmaf(ai0, sr0, i0[r]));
        const float nr1 = fmaf(ar1, sr1, fmaf(-ai1, si1, r1[r])), ni1 = fmaf(ar1, si1, fmaf(ai1, sr1, i1[r]));
        sr0 = nr0; si0 = ni0; sr1 = nr1; si1 = ni1;
        if (MODE != 0) { u32x2 w; w.x = cvt_pk_bf16(sr0, si0); w.y = cvt_pk_bf16(sr1, si1); *(LAS u32x2*)(tile + (16 * hi + r) * 272 + 8 * j) = w; }
        if (MODE == 2 && (r & 3) == 3) {
            const size_t o = ((size_t)(sbatch0 + (r >> 2)) * NG + g) * 64 + j;
            o_re[o] = sr0; o_im[o] = si0; o_re[o + 32] = sr1; o_im[o + 32] = si1;
        }
    }
    cx.s[0] = sr0; cx.s[1] = si0; cx.s[2] = sr1; cx.s[3] = si1;
    if (MODE != 0) {
        LDS_WAIT(); __builtin_amdgcn_wave_barrier();
#pragma unroll
        for (int tg = 0; tg < 2; ++tg) {
            f32x4 y = {0.f, 0.f, 0.f, 0.f};
#pragma unroll
            for (int ks = 0; ks < 4; ++ks) {
                const bf16x8 sf = *(const LAS bf16x8*)(tile + (16 * tg + fr) * 272 + (32 * ks + 8 * fq) * 2);
                y = __builtin_amdgcn_mfma_f32_16x16x32_bf16(cx.CMf[ks], sf, y, 0, 0, 0);
            }
            const u32x2 uw = uwp[tg];
            const float y0 = gelu_tanh(y[0] + cx.dsk[0] * bf_lo(uw.x)), y1 = gelu_tanh(y[1] + cx.dsk[1] * bf_hi(uw.x));
            const float y2 = gelu_tanh(y[2] + cx.dsk[2] * bf_lo(uw.y)), y3 = gelu_tanh(y[3] + cx.dsk[3] * bf_hi(uw.y));
            u32x2 o; o.x = cvt_pk_bf16(y0, y1); o.y = cvt_pk_bf16(y2, y3);
            *(u32x2*)(Gout + yrow[tg] * 1024 + 16 * g + 4 * fq) = o;
        }
    }
}

__device__ __forceinline__ void ssm_load_ctx(SsmCtx& cx, const Args& A, int g, int lane) {
    const bf16_t* BB = (const bf16_t*)(A.ws + O_BB); const bf16_t* CM = (const bf16_t*)(A.ws + O_CM); const float* ABAR = (const float*)(A.ws + O_ABAR);
    const int j = lane & 31, fq = lane >> 4;
#pragma unroll
    for (int i = 0; i < 4; ++i) { cx.BB[i] = *(const bf16x8*)(BB + (((size_t)g * 4 + i) * 64 + lane) * 8); cx.CMf[i] = *(const bf16x8*)(CM + (((size_t)g * 4 + i) * 64 + lane) * 8); }
    const f32x4 a0 = *(const f32x4*)(ABAR + ((size_t)g * 64 + j) * 4), a1 = *(const f32x4*)(ABAR + ((size_t)g * 64 + j + 32) * 4);
    cx.a[0] = a0[0]; cx.a[1] = a0[1]; cx.a[2] = a1[0]; cx.a[3] = a1[1];
    const f32x4 dv = *(const f32x4*)(A.in[I_SSMD] + 16 * g + 4 * fq);
    cx.dsk[0] = dv[0]; cx.dsk[1] = dv[1]; cx.dsk[2] = dv[2]; cx.dsk[3] = dv[3];
}

__device__ __forceinline__ void ssm_phase(const Args& A, LAS unsigned char* lds, int G, const int wv) {
    const int tid = opaque_tid(wv), lane = tid & 63, w = __builtin_amdgcn_readfirstlane(tid >> 6);
    const int j = lane & 31, hi = lane >> 5, fr = lane & 15;
    const bf16_t* P = (const bf16_t*)(A.ws + O_P); bf16_t* Gout = (bf16_t*)(A.ws + O_G);
    const float* ABAR = (const float*)(A.ws + O_ABAR);
    LAS unsigned char* tile = lds + w * 8704;
    LAS f32x4* EL = (LAS f32x4*)(lds + 8 * 8704);
    const int arow_i = lane & 31, own = (arow_i >> 2) & 1, rloc = 4 * (arow_i >> 3) + (arow_i & 3);
    for (int un = blockIdx.x; un < NB * NG; un += G) {
        const int b = un >> 6, g = un & 63;
        SsmCtx cx; ssm_load_ctx(cx, A, g, lane);
        const f32x4 p0 = *(const f32x4*)(ABAR + ((size_t)g * 64 + j) * 4), p1 = *(const f32x4*)(ABAR + ((size_t)g * 64 + j + 32) * 4);
        const size_t rowb = (size_t)b * SEQ;
        size_t yrow[2];
        cx.s[0] = cx.s[1] = cx.s[2] = cx.s[3] = 0.f;
        const bf16_t* abase = P + (rowb + (2 * w + own) * 128 + rloc) * D + 1024 + 16 * g + 8 * hi;
        bf16x8 af = *(const bf16x8*)abase;
        for (int k = 0; k < 8; ++k) {
            const bf16x8 afn = *(const bf16x8*)(abase + (size_t)(16 * ((k + 1) & 7)) * D);
            yrow[0] = 0; yrow[1] = 0;
            ssm_sub<0>(cx, P, Gout, g, af, yrow, tile, lane, nullptr, nullptr, nullptr, nullptr, 0);
            af = afn;
        }
        EL[(2 * w + hi) * 32 + j] = (f32x4){cx.s[0], cx.s[1], cx.s[2], cx.s[3]};
        LDS_WAIT(); __syncthreads();
        {
            float sr0 = 0.f, si0 = 0.f, sr1 = 0.f, si1 = 0.f; const int wk = 2 * w + hi;
            for (int q = 0; q < 15; ++q) {
                if (q < wk) { const f32x4 e = EL[q * 32 + j]; float tr, ti;
                    cmul(p0[2], p0[3], sr0, si0, tr, ti); sr0 = tr + e[0]; si0 = ti + e[1];
                    cmul(p1[2], p1[3], sr1, si1, tr, ti); sr1 = tr + e[2]; si1 = ti + e[3]; }
            }
            cx.s[0] = sr0; cx.s[1] = si0; cx.s[2] = sr1; cx.s[3] = si1;
        }
        for (int k = 0; k < 8; ++k) {
            const bf16x8 afn = *(const bf16x8*)(abase + (size_t)(16 * ((k + 1) & 7)) * D);
            yrow[0] = rowb + (2 * w) * 128 + 16 * k + fr; yrow[1] = rowb + (2 * w + 1) * 128 + 16 * k + fr;
            ssm_sub<1>(cx, P, Gout, g, af, yrow, tile, lane, nullptr, nullptr, nullptr, nullptr, 0);
            af = afn;
        }
        if (w == 7 && hi == 1) {
            const size_t o = ((size_t)b * NG + g) * 64 + j;
            A.out[OUT_REP + o] = cx.s[0]; A.out[OUT_IMP + o] = cx.s[1]; A.out[OUT_REP + o + 32] = cx.s[2]; A.out[OUT_IMP + o + 32] = cx.s[3];
        }
        LDS_WAIT(); __syncthreads();
    }
    for (int un = (G == 256) ? (int)blockIdx.x - 128 : (int)blockIdx.x; un < 2 * NG; un += G) {
        if (un < 0) continue;
        const int g = un >> 1, bh = un & 1;
        SsmCtx cx; ssm_load_ctx(cx, A, g, lane);
        cx.s[0] = cx.s[1] = cx.s[2] = cx.s[3] = 0.f;
        const int bbase = bh * 64 + w * 8;
        const size_t arow = (size_t)MP + (size_t)(bbase + own * 4 + (arow_i >> 3)) * 4 + (arow_i & 3);
        size_t yrow[2];
        yrow[0] = (size_t)MP + (size_t)(bbase + (fr >> 2)) * 4 + (fr & 3); yrow[1] = (size_t)MP + (size_t)(bbase + 4 + (fr >> 2)) * 4 + (fr & 3);
        const bf16x8 af = *(const bf16x8*)(P + arow * D + 1024 + 16 * g + 8 * hi);
        ssm_sub<2>(cx, P, Gout, g, af, yrow, tile, lane, A.in[I_SRE], A.in[I_SIM], A.out + OUT_RES, A.out + OUT_IMS, bbase + hi * 4);
    }
}

template <int WPU>
__device__ __forceinline__ void sample_attn_units(const Args& A, LAS unsigned char* lds, int su0, const int wv) {
    constexpr int KPW = 256 / WPU, NB = KPW / 8, NKG = KPW / 16;
    const int tid = opaque_tid(wv), lane = tid & 63, w = __builtin_amdgcn_readfirstlane(tid >> 6), fr = lane & 15, fq = lane >> 4;
    const int su = su0 + (WPU == 4 ? (w >> 2) : 0), b = su >> 2, h = su & 3, kq = (WPU == 4) ? (w & 3) : w;
    const bf16_t* Q = (const bf16_t*)(A.ws + O_Q); bf16_t* ATT = (bf16_t*)(A.ws + O_ATT);
    const float* Kc = A.in[I_CK] + (((size_t)b * NMEM + KPW * kq) * NH + h) * HD;
    const float* Vc = A.in[I_CV] + (((size_t)b * NMEM + KPW * kq) * NH + h) * HD;
    LAS bf16_t* QSw = (LAS bf16_t*)(lds + w * 4096);
    LAS float* PLw = (LAS float*)(lds + 32768 + w * 1024);
    LAS float* ML = (LAS float*)(lds + 40960);
    LAS float* RED = (LAS float*)(lds + 49152);
#pragma unroll
    for (int t = 0; t < 4; ++t) *(LAS u32x4*)(QSw + t * 512 + lane * 8) = *(const u32x4*)(Q + ((size_t)MP + b * 4 + t) * D + h * HD + lane * 8);
    f32x4 ra[16], rb[16];
#define KLOAD(dst, bi) do { const float* kp_ = Kc + (size_t)(16 * ((bi) >> 1) + fr) * (NH * HD) + 4 * fq + 256 * ((bi) & 1); \
        _Pragma("unroll") for (int i = 0; i < 8; ++i) { dst[2 * i] = *(const f32x4*)(kp_ + 32 * i); dst[2 * i + 1] = *(const f32x4*)(kp_ + 32 * i + 16); } } while (0)
#define KUSE(src, bi) do { _Pragma("unroll") for (int i = 0; i < 8; ++i) { const int kd = 8 * ((bi) & 1) + i; const f32x4 k0 = src[2 * i], k1 = src[2 * i + 1]; \
        u32x4 kw; kw.x = cvt_pk_bf16(k0[0], k0[1]); kw.y = cvt_pk_bf16(k0[2], k0[3]); kw.z = cvt_pk_bf16(k1[0], k1[1]); kw.w = cvt_pk_bf16(k1[2], k1[3]); \
        u32x4 qw = {0u, 0u, 0u, 0u}; \
        if (fr < 4) { const u32x2 qa = *(const LAS u32x2*)(QSw + fr * 512 + 32 * kd + 4 * fq), qb = *(const LAS u32x2*)(QSw + fr * 512 + 32 * kd + 16 + 4 * fq); qw.x = qa.x; qw.y = qa.y; qw.z = qb.x; qw.w = qb.y; } \
        sc[(bi) >> 1] = __builtin_amdgcn_mfma_f32_16x16x32_bf16(__builtin_bit_cast(bf16x8, kw), __builtin_bit_cast(bf16x8, qw), sc[(bi) >> 1], 0, 0, 0); } } while (0)
#define VLOAD(dst, vb) do { const float* vp_ = Vc + (size_t)(8 * (vb)) * (NH * HD) + 4 * lane; \
        _Pragma("unroll") for (int k = 0; k < 8; ++k) { dst[2 * k] = __builtin_nontemporal_load((const f32x4*)(vp_ + (size_t)k * (NH * HD))); dst[2 * k + 1] = __builtin_nontemporal_load((const f32x4*)(vp_ + (size_t)k * (NH * HD) + 256)); } } while (0)
#define VUSE(src, vb) do { _Pragma("unroll") for (int k = 0; k < 8; ++k) { const f32x4 p = *(const LAS f32x4*)(PLw + (8 * (vb) + k) * 4); \
        _Pragma("unroll") for (int t = 0; t < 4; ++t) { o[t][0] += src[2 * k] * p[t]; o[t][1] += src[2 * k + 1] * p[t]; } } } while (0)
#define SB() __builtin_amdgcn_sched_barrier(0)
    KLOAD(ra, 0); KLOAD(rb, 1);
    LDS_WAIT(); __builtin_amdgcn_wave_barrier();
    f32x4 sc[NKG];
#pragma unroll
    for (int i = 0; i < NKG; ++i) sc[i] = (f32x4){0.f, 0.f, 0.f, 0.f};
    SB(); KUSE(ra, 0); SB(); KLOAD(ra, 2); SB(); KUSE(rb, 1); SB(); KLOAD(rb, 3); SB();
    if constexpr (NB == 8) {
        KUSE(ra, 2); SB(); KLOAD(ra, 4); SB(); KUSE(rb, 3); SB(); KLOAD(rb, 5); SB();
        KUSE(ra, 4); SB(); KLOAD(ra, 6); SB(); KUSE(rb, 5); SB(); KLOAD(rb, 7); SB();
        KUSE(ra, 6); SB(); VLOAD(ra, 0); SB(); KUSE(rb, 7); SB(); VLOAD(rb, 1); SB();
    } else {
        KUSE(ra, 2); SB(); VLOAD(ra, 0); SB(); KUSE(rb, 3); SB(); VLOAD(rb, 1); SB();
    }
    float mt = -3.0e38f;
#pragma unroll
    for (int kg = 0; kg < NKG; ++kg) mt = fmaxf(mt, fmaxf(fmaxf(sc[kg][0], sc[kg][1]), fmaxf(sc[kg][2], sc[kg][3])));
    mt = fmaxf(mt, __shfl_xor(mt, 16)); mt = fmaxf(mt, __shfl_xor(mt, 32));
    float lt = 0.f;
#pragma unroll
    for (int kg = 0; kg < NKG; ++kg)
#pragma unroll
        for (int r = 0; r < 4; ++r) { const float e = __expf(sc[kg][r] - mt); lt += e; if (fr < 4) PLw[(16 * kg + 4 * fq + r) * 4 + fr] = e; }
    lt += __shfl_xor(lt, 16); lt += __shfl_xor(lt, 32);
    if (fr < 4 && fq == 0) { ML[(w * 4 + fr) * 2] = mt; ML[(w * 4 + fr) * 2 + 1] = lt; }
    LDS_WAIT(); __builtin_amdgcn_wave_barrier();
    f32x4 o[4][2];
#pragma unroll
    for (int t = 0; t < 4; ++t) { o[t][0] = (f32x4){0.f, 0.f, 0.f, 0.f}; o[t][1] = (f32x4){0.f, 0.f, 0.f, 0.f}; }
    SB(); VUSE(ra, 0); SB(); VLOAD(ra, 2); SB(); VUSE(rb, 1); SB(); VLOAD(rb, 3); SB();
    if constexpr (NB == 8) {
        VUSE(ra, 2); SB(); VLOAD(ra, 4); SB(); VUSE(rb, 3); SB(); VLOAD(rb, 5); SB();
        VUSE(ra, 4); SB(); VLOAD(ra, 6); SB(); VUSE(rb, 5); SB(); VLOAD(rb, 7); SB();
        VUSE(ra, 6); SB(); VUSE(rb, 7);
    } else {
        VUSE(ra, 2); SB(); VUSE(rb, 3);
    }
#undef KLOAD
#undef KUSE
#undef VLOAD
#undef VUSE
#undef SB
#pragma unroll
    for (int t = 0; t < 4; ++t) { *(LAS f32x4*)(RED + (w * 4 + t) * 512 + 4 * lane) = o[t][0]; *(LAS f32x4*)(RED + (w * 4 + t) * 512 + 256 + 4 * lane) = o[t][1]; }
    LDS_WAIT(); __syncthreads();
    if constexpr (WPU == 4) {
        const int uh = tid >> 8, t = (tid >> 6) & 3, c = (tid & 63) * 8;
        float m4[4], l4[4], Mx = -3.0e38f;
#pragma unroll
        for (int q = 0; q < 4; ++q) { m4[q] = ML[((uh * 4 + q) * 4 + t) * 2]; l4[q] = ML[((uh * 4 + q) * 4 + t) * 2 + 1]; Mx = fmaxf(Mx, m4[q]); }
        f32x4 s0 = {0.f, 0.f, 0.f, 0.f}, s1 = {0.f, 0.f, 0.f, 0.f}; float L = 0.f;
#pragma unroll
        for (int q = 0; q < 4; ++q) { const float f = __expf(m4[q] - Mx); L += l4[q] * f;
            s0 += *(const LAS f32x4*)(RED + ((uh * 4 + q) * 4 + t) * 512 + c) * f; s1 += *(const LAS f32x4*)(RED + ((uh * 4 + q) * 4 + t) * 512 + c + 4) * f; }
        const float iv = 1.0f / L; const int su2 = su0 + uh, b2 = su2 >> 2, h2 = su2 & 3;
        pg8::st_bf16x8(ATT + ((size_t)MP + b2 * 4 + t) * D + h2 * HD + c, s0 * iv, s1 * iv);
    } else {
        const int t = tid >> 7, c = (tid & 127) * 4;
        float m8[8], l8[8], Mx = -3.0e38f;
#pragma unroll
        for (int q = 0; q < 8; ++q) { m8[q] = ML[(q * 4 + t) * 2]; l8[q] = ML[(q * 4 + t) * 2 + 1]; Mx = fmaxf(Mx, m8[q]); }
        f32x4 s0 = {0.f, 0.f, 0.f, 0.f}; float L = 0.f;
#pragma unroll
        for (int q = 0; q < 8; ++q) { const float f = __expf(m8[q] - Mx); L += l8[q] * f; s0 += *(const LAS f32x4*)(RED + (q * 4 + t) * 512 + c) * f; }
        const float iv = 1.0f / L; const int b2 = su0 >> 2, h2 = su0 & 3;
        pg8::st_bf16x4(ATT + ((size_t)MP + b2 * 4 + t) * D + h2 * HD + c, s0 * iv);
    }
    LDS_WAIT(); __syncthreads();
}

constexpr int MTP = MP / 256;
struct SchedGrid {
    int G, c, nM, nN; const char* A; const char* B; size_t ta, tb; const char* Sb; size_t ts;
    __device__ __forceinline__ bool next(int i, Unit& u) const {
        const int L = i * G + c; if (L >= nM * nN) return false;
        u.pm = L % nM; u.pn = L / nM; u.job = 0; u.a = A + (size_t)u.pm * ta; u.b = B + (size_t)u.pn * tb; u.s = Sb + (size_t)u.pm * ts; u.srow = MP + 16 * u.pm; return true;
    }
};
struct Sched1 {
    int G, c; const char* hmix; const char* win; const char* mn; const char* wkv;
    __device__ __forceinline__ bool next(int i, Unit& u) const {
        int L = i * G + c; u.srow = -1;
        if (L < MTP * 8) { u.job = 0; u.pm = L % MTP; u.pn = L / MTP; u.a = hmix + (size_t)u.pm * 256 * D * 2; u.b = win + (size_t)u.pn * 256 * D * 2; u.s = u.a; return true; }
        L -= MTP * 8;
        if (L < 64) { u.job = 1; u.pm = L & 3; u.pn = L >> 2; u.a = mn + (size_t)u.pm * 256 * D * 2; u.b = wkv + (size_t)u.pn * 256 * D * 2; u.s = u.a; return true; }
        L -= 64;
        if (L < 16) { u.job = 0; u.pm = MTP + (L & 1); u.pn = L >> 1; u.a = hmix + (size_t)u.pm * 256 * D * 2; u.b = win + (size_t)u.pn * 256 * D * 2; u.s = u.a; return true; }
        return false;
    }
};
struct SchedGU {
    int G, c; const char* A; const char* B;
    __device__ __forceinline__ bool next(int i, Unit& u) const {
        const int L = i * G + c;
        if (L < MTP * 44) { u.pm = L % MTP; u.pn = L / MTP; }
        else if (L < (MTP + 2) * 44) { const int r = L - MTP * 44; u.pm = MTP + (r & 1); u.pn = r >> 1; }
        else return false;
        u.job = 0; u.a = A + (size_t)u.pm * 256 * D * 2; u.b = B + (size_t)u.pn * 256 * D * 2; u.s = u.a; u.srow = -1; return true;
    }
};
struct SchedPool {
    int G, c; const char* pooled; const char* wp;
    __device__ __forceinline__ bool next(int i, Unit& u) const {
        const int L = i * G + c; if (L >= MTP * 4) return false;
        u.job = 0; u.pm = L % MTP; u.pn = L / MTP; u.a = pooled + ((size_t)u.pm * 256 * 1024 + u.pn * 256) * 2; u.b = wp + (size_t)u.pn * 256 * 256 * 2;
        u.s = pooled + (((size_t)MP + 16 * u.pm) * 1024 + u.pn * 256) * 2; u.srow = MP + 16 * u.pm; return true;
    }
};
struct SchedScores {
    int c; const char* Q; const char* KB;
    __device__ __forceinline__ bool next(int i, Unit& u) const {
        if (i > 0 || c >= 128) return false;
        const int bh = c >> 3, qb = c & 7, b = bh >> 2, h = bh & 3;
        u.job = bh; u.pm = qb; u.pn = 0; u.a = Q + (((size_t)b * SEQ + qb * 256) * D + h * HD) * 2; u.b = KB + ((size_t)b * NMEM * D + h * HD) * 2; u.s = u.a; u.srow = -1; return true;
    }
};
struct SchedPVown {
    int c; const char* PR; const char* VT;
    __device__ __forceinline__ bool next(int i, Unit& u) const {
        if (i > 1 || c >= 128) return false;
        const int bh = c >> 3, qb = c & 7, pn = i, b = bh >> 2, h = bh & 3;
        u.job = 0; u.pm = b * 8 + qb; u.pn = h * 2 + pn;
        u.a = PR + ((size_t)bh * SEQ + qb * 256) * 256 * 2; u.b = VT + (((size_t)h * HD + pn * 256) * 1024 + b * 256) * 2; u.s = u.a; u.srow = -1; return true;
    }
};
struct SchedPV {
    int G, c; const char* PR; const char* VT;
    __device__ __forceinline__ bool next(int i, Unit& u) const {
        const int L = i * G + c; if (L >= 256) return false;
        const int bh = L >> 4, rem = L & 15, qb = rem >> 1, pn = rem & 1, b = bh >> 2, h = bh & 3;
        u.job = 0; u.pm = b * 8 + qb; u.pn = h * 2 + pn;
        u.a = PR + ((size_t)bh * SEQ + qb * 256) * 256 * 2; u.b = VT + (((size_t)h * HD + pn * 256) * 1024 + b * 256) * 2; u.s = u.a; u.srow = -1; return true;
    }
};


#define XB_TMO      128
#define XB_XCNT(j)  (256  + 64 * (j))
#define XB_XSUB(j)  (1280 + 64 * (j))
#define XB_XGEN(j)  (2304 + 64 * (j))
#define XB_TOP      3328
#define XB_TOPGEN   3392
#define XCD_BAR_WORDS 3456
#define XB_SPIN_CAP (1u << 18)
__device__ __forceinline__ unsigned xb_ld(unsigned* p)              { return __hip_atomic_load(p, __ATOMIC_RELAXED, __HIP_MEMORY_SCOPE_AGENT); }
__device__ __forceinline__ unsigned xb_add(unsigned* p, unsigned v) { return __hip_atomic_fetch_add(p, v, __ATOMIC_RELAXED, __HIP_MEMORY_SCOPE_AGENT); }
__device__ __forceinline__ unsigned xb_xcc_id() { return (unsigned)__builtin_amdgcn_s_getreg((3 << 11) | 20) & 0xFu; }
#define XB_SPIN(cond, bar) do { unsigned _sp = 0; while (cond) { __builtin_amdgcn_s_sleep(1); \
    if ((++_sp & 255u) == 0u) { if (xb_ld(&(bar)[XB_TMO])) break; if (_sp > XB_SPIN_CAP) { atomicAdd(&(bar)[XB_TMO], 1u); break; } } } } while (0)
struct XcdBarrier { unsigned* bar; unsigned x; volatile LAS unsigned* st; };
__device__ __forceinline__ XcdBarrier xcd_barrier_post(unsigned* bar, volatile LAS unsigned* st) {
    XcdBarrier b; b.bar = bar; b.x = xb_xcc_id(); b.st = st;
    if (threadIdx.x == 0) (void)xb_add(&bar[XB_XCNT(b.x)], 1u);
    return b;
}
__device__ __forceinline__ void xcd_barrier_complete(unsigned* bar, unsigned x, unsigned& nloc, unsigned& nx) {
    const unsigned G = gridDim.x * gridDim.y * gridDim.z;
    unsigned sum, cnt, mine, sp = 0u;
    for (;;) {
        sum = 0u; cnt = 0u; mine = 0u;
#pragma unroll
        for (unsigned j = 0; j < 16; ++j) { const unsigned c = xb_ld(&bar[XB_XCNT(j)]); sum += c; cnt += (c > 0u) ? 1u : 0u; mine = (j == x) ? c : mine; }
        if (sum == G) break;
        __builtin_amdgcn_s_sleep(1);
        if ((++sp & 255u) == 0u) { if (xb_ld(&bar[XB_TMO])) break; if (sp > XB_SPIN_CAP) { atomicAdd(&bar[XB_TMO], 1u); break; } }
    }
    nloc = mine > 0u ? mine : 1u; nx = cnt > 0u ? cnt : 1u;
}
__device__ __forceinline__ void xcd_barrier(const XcdBarrier& b, const int wv) {
    asm volatile("s_waitcnt vmcnt(0)" ::: "memory");
    __syncthreads();
    if (opaque_tid(wv) == 0) {
        unsigned* bar = b.bar;
        __builtin_amdgcn_s_waitcnt(0);
        unsigned nloc = b.st[0], nx = b.st[1];
        if (nloc == 0u) { xcd_barrier_complete(bar, b.x, nloc, nx); b.st[0] = nloc; b.st[1] = nx; }
        const unsigned old = xb_add(&bar[XB_XSUB(b.x)], 1u);
        const unsigned gen = old / nloc;
        if (old + 1u == (gen + 1u) * nloc) {
            __builtin_amdgcn_fence(__ATOMIC_RELEASE, "agent");
            asm volatile("s_waitcnt vmcnt(0)" ::: "memory");
            __builtin_amdgcn_fence(__ATOMIC_RELEASE, "agent");
            asm volatile("s_waitcnt vmcnt(0)" ::: "memory");
            const unsigned og = xb_add(&bar[XB_TOP], 1u);
            const unsigned tg = og / nx;
            if (og + 1u == (tg + 1u) * nx) xb_add(&bar[XB_TOPGEN], 1u);
            else XB_SPIN(xb_ld(&bar[XB_TOPGEN]) == tg, bar);
            __builtin_amdgcn_fence(__ATOMIC_ACQUIRE, "agent");
            xb_add(&bar[XB_XGEN(b.x)], 1u);
            asm volatile("s_waitcnt vmcnt(0)" ::: "memory");
        } else {
            XB_SPIN(xb_ld(&bar[XB_XGEN(b.x)]) == gen, bar);
            __builtin_amdgcn_fence(__ATOMIC_ACQUIRE, "agent");
            asm volatile("s_waitcnt vmcnt(0)" ::: "memory");
        }
    }
    __syncthreads();
}

#ifndef REP_PHASE
#define REP_PHASE -1
#endif
#define REPEAT(k) for (int rep_ = 0; rep_ < ((REP_PHASE == (k)) ? 2 : 1); ++rep_)
__global__ void __launch_bounds__(512, 2) hymba_fwd(Args A) {
    extern __shared__ __attribute__((aligned(16))) unsigned char lds_raw[];
    LAS unsigned char* lds = (LAS unsigned char*)lds_raw;
    cg::grid_group grid = cg::this_grid();
    const int G = gridDim.x, c = blockIdx.x, wv = __builtin_amdgcn_readfirstlane((int)threadIdx.x >> 6);
    unsigned char* ws = A.ws;
    float* SS1 = (float*)(ws + O_SS1); float* SS2 = (float*)(ws + O_SS2); float* SS3 = (float*)(ws + O_SS3); float* SSD = (float*)(ws + O_BAR + 16384);
    volatile LAS unsigned* bst = (volatile LAS unsigned*)(lds + RING_BYTES + 8192);
    if (threadIdx.x < 4) bst[threadIdx.x] = 0u;
    __syncthreads();
    const XcdBarrier xbar = xcd_barrier_post((unsigned*)(ws + O_BAR), bst);
#define SEAM() xcd_barrier(xbar, wv)

    REPEAT(0) {
    {
        convert_weights(A, lds, 0, NEARLY, c * 8 + wv, G * 8, wv);
        phase0_rest(A, G, wv);
    }
    if (A.ws == nullptr) grid.sync();
    SEAM();
    }
    REPEAT(1) {
    {
        Sched1 S{G, c, (const char*)(ws + O_HMIX), (const char*)(ws + O_WIN), (const char*)(ws + O_MN), (const char*)(ws + O_WKV)};
        pg8::EpiInKv E{(bf16_t*)(ws + O_P), A.out, (bf16_t*)(ws + O_KB), (bf16_t*)(ws + O_VT)};
        pg8::gemm_phase<pg8::EpiInKv, Sched1, true, false>(lds, pg8::Dims{D, D, D}, S, E, wv);
        __syncthreads();
        const int skip = (G == 256) ? 80 : 0;
        convert_weights(A, lds, NEARLY, NITEMS - NP9, (c >= skip) ? (c - skip) * 8 + wv : -1, (G - skip) * 8, wv);
    }
    SEAM();
    }
    REPEAT(2) {
    ssm_phase(A, lds, G, wv);
    pooled_phase(A, G, wv);
    SEAM();
    }
    REPEAT(3) {
    {
        SchedPool S{G, c, (const char*)(ws + O_POOLED), (const char*)(ws + O_WPOOL)};
        pg8::EpiPool E{(bf16_t*)(ws + O_MIX), A.in[I_PSCALE]};
        pg8::gemm_phase<pg8::EpiPool, SchedPool, true, true>(lds, pg8::Dims{1024, 256, 256}, S, E, wv);
        SchedGrid S2{G, G - 1 - c, MTP, 4, (const char*)(ws + O_G), (const char*)(ws + O_WGLU), (size_t)256 * 1024 * 2, (size_t)256 * 1024 * 2, (const char*)(ws + O_G) + (size_t)MP * 1024 * 2, (size_t)16 * 1024 * 2};
        pg8::EpiGlu E2{(bf16_t*)(ws + O_MIX), (const bf16_t*)(ws + O_G), A.in[I_BGLU]};
        pg8::gemm_phase<pg8::EpiGlu, SchedGrid, true, true>(lds, pg8::Dims{1024, 1024, 1024}, S2, E2, wv);
    }
    SEAM();
    }
    REPEAT(4) {
    {
        SchedGrid S{G, c, MTP, 8, (const char*)(ws + O_MIX), (const char*)(ws + O_WOUT), (size_t)256 * D * 2, (size_t)256 * D * 2, (const char*)(ws + O_MIX) + (size_t)MP * D * 2, (size_t)16 * D * 2};
        pg8::EpiRes<float> E{A.in[I_XP], A.in[I_XS], nullptr, (bf16_t*)(ws + O_XB), rep_ ? SSD : SS1};
        pg8::gemm_phase<pg8::EpiRes<float>, SchedGrid, true, true>(lds, pg8::Dims{D, D, D}, S, E, wv);
    }
    SEAM();
    }
    REPEAT(5) {
    {
        SchedGrid S{G, c, MTP, 8, (const char*)(ws + O_XB), (const char*)(ws + O_WQ), (size_t)256 * D * 2, (size_t)256 * D * 2, (const char*)(ws + O_XB) + (size_t)MP * D * 2, (size_t)16 * D * 2};
        pg8::EpiQ E{(bf16_t*)(ws + O_Q), SS1};
        pg8::gemm_phase<pg8::EpiQ, SchedGrid, true, true>(lds, pg8::Dims{D, D, D}, S, E, wv);
    }
    SEAM();
    }
    REPEAT(6) {
    {
        if (G == 256) {
            if (c < 128) {
                { SchedScores S{c, (const char*)(ws + O_Q), (const char*)(ws + O_KB)};
                  pg8::EpiSoftmax E{(bf16_t*)(ws + O_PR)};
                  pg8::gemm_phase<pg8::EpiSoftmax, SchedScores, false, false>(lds, pg8::Dims{D, D, HD}, S, E, wv); }
                asm volatile("s_waitcnt vmcnt(0)" ::: "memory"); __syncthreads();
                { SchedPVown S{c, (const char*)(ws + O_PR), (const char*)(ws + O_VT)};
                  pg8::EpiPV E{(bf16_t*)(ws + O_ATT)};
                  pg8::gemm_phase<pg8::EpiPV, SchedPVown, true, false>(lds, pg8::Dims{256, 1024, 256}, S, E, wv); }
                __syncthreads();
                sample_attn_units<8>(A, lds, c, wv);
            } else {
                sample_attn_units<4>(A, lds, 128 + 2 * (c - 128), wv);
                sample_attn_units<8>(A, lds, 384 + (c - 128), wv);
            }
        } else {
            for (int base = 0; base < 128; base += G) {
                SchedScores S{c + base, (const char*)(ws + O_Q), (const char*)(ws + O_KB)};
                pg8::EpiSoftmax E{(bf16_t*)(ws + O_PR)};
                pg8::gemm_phase<pg8::EpiSoftmax, SchedScores, false, false>(lds, pg8::Dims{D, D, HD}, S, E, wv);
            }
            __syncthreads();
            for (int du = c; du < 256; du += G) sample_attn_units<4>(A, lds, 2 * du, wv);
        }
    }
    SEAM();
    }
    if (G != 256) {
        SchedPV S{G, c, (const char*)(ws + O_PR), (const char*)(ws + O_VT)};
        pg8::EpiPV E{(bf16_t*)(ws + O_ATT)};
        pg8::gemm_phase<pg8::EpiPV, SchedPV, true, false>(lds, pg8::Dims{256, 1024, 256}, S, E, wv);
        SEAM();
    }
    REPEAT(8) {
    {
        SchedGrid S{G, c, MTP, 8, (const char*)(ws + O_ATT), (const char*)(ws + O_WO), (size_t)256 * D * 2, (size_t)256 * D * 2, (const char*)(ws + O_ATT) + (size_t)MP * D * 2, (size_t)16 * D * 2};
        pg8::EpiRes<bf16_t> E{(const bf16_t*)(ws + O_XB), (const bf16_t*)(ws + O_XB) + (size_t)MP * D, nullptr, (bf16_t*)(ws + O_XB), SS2};
        pg8::gemm_phase<pg8::EpiRes<bf16_t>, SchedGrid, true, true>(lds, pg8::Dims{D, D, D}, S, E, wv);
    }
    SEAM();
    }
    REPEAT(9) {
    {
        SchedGU S{G, c, (const char*)(ws + O_XB), (const char*)(ws + O_WGU)};
        pg8::EpiGateUp E{(bf16_t*)(ws + O_H), SS2};
        pg8::gemm_phase<pg8::EpiGateUp, SchedGU, true, false>(lds, pg8::Dims{D, D, D}, S, E, wv);
        __syncthreads();
        { const int nfull = ((MTP + 2) * 44) % G;
          if (nfull > 0) convert_weights(A, lds, NITEMS - NP9, NITEMS, (c >= nfull) ? (c - nfull) * 8 + wv : -1, (G - nfull) * 8, wv);
          else convert_weights(A, lds, NITEMS - NP9, NITEMS, c * 8 + wv, G * 8, wv); }
    }
    SEAM();
    }
    if (G == 256) {
        SchedGrid S{G, c, MTP, 8, (const char*)(ws + O_H), (const char*)(ws + O_WDN), (size_t)256 * FF * 2, (size_t)256 * FF * 2, (const char*)(ws + O_H) + (size_t)MP * FF * 2, (size_t)16 * FF * 2};
        pg8::EpiFinal E{(const bf16_t*)(ws + O_XB), A.out + OUT_Y, SS3, (unsigned*)(ws + O_PCNT), A.in[I_GFINAL]};
        pg8::gemm_phase<pg8::EpiFinal, SchedGrid, false, true>(lds, pg8::Dims{FF, FF, FF}, S, E, wv);
    } else {
        {
            SchedGrid S{G, c, MTP, 8, (const char*)(ws + O_H), (const char*)(ws + O_WDN), (size_t)256 * FF * 2, (size_t)256 * FF * 2, (const char*)(ws + O_H) + (size_t)MP * FF * 2, (size_t)16 * FF * 2};
            pg8::EpiRes<bf16_t> E{(const bf16_t*)(ws + O_XB), (const bf16_t*)(ws + O_XB) + (size_t)MP * D, A.out + OUT_Y, nullptr, SS3};
            pg8::gemm_phase<pg8::EpiRes<bf16_t>, SchedGrid, true, true>(lds, pg8::Dims{FF, FF, FF}, S, E, wv);
        }
        SEAM();
        const float* gf = A.in[I_GFINAL]; const int tid = opaque_tid(wv), lane = tid & 63, wave = wv;
        for (int m = c * 8 + wave; m < M; m += G * 8) {
            const float rs = rsqrtf(SS3[m] * (1.0f / D) + EPS);
            f32x4* row = (f32x4*)(A.out + OUT_Y + (size_t)m * D) + lane; const f32x4* gr = (const f32x4*)gf + lane;
#pragma unroll
            for (int jj = 0; jj < 8; ++jj) row[64 * jj] = row[64 * jj] * rs * gr[64 * jj];
        }
    }
}

extern "C" void kernel_launch(void* const* d_in, const int* in_sizes, int n_in, void* d_out, int out_size, void* d_ws, size_t ws_size, hipStream_t stream) {
    static int grid = 0;
    if (grid == 0) {
        if (n_in != 34 || ws_size < WS_END) { fprintf(stderr, "kernel_launch: unexpected inputs (n_in %d, ws %zu, need %zu)\n", n_in, ws_size, (size_t)WS_END); grid = -1; return; }
        int dev = 0, cus = 0, per_cu = 0;
        hipGetDevice(&dev);
        hipDeviceGetAttribute(&cus, hipDeviceAttributeMultiprocessorCount, dev);
        if (hipFuncSetAttribute((const void*)hymba_fwd, hipFuncAttributeMaxDynamicSharedMemorySize, LDS_BYTES) != hipSuccess) { fprintf(stderr, "kernel_launch: hipFuncSetAttribute failed\n"); grid = -1; return; }
        if (hipOccupancyMaxActiveBlocksPerMultiprocessor(&per_cu, (const void*)hymba_fwd, 512, LDS_BYTES) != hipSuccess || per_cu < 1) { fprintf(stderr, "kernel_launch: occupancy query failed (%d)\n", per_cu); per_cu = 1; }
        (void)hipGetLastError();
        grid = cus * per_cu;
    }
    if (grid < 0) return;
    hipMemsetAsync(d_ws, 0, CTL_BYTES, stream);
    Args a{};
    for (int i = 0; i < 34; ++i) a.in[i] = (const float*)d_in[i];
    a.out = (float*)d_out; a.ws = (unsigned char*)d_ws;
    void* args[] = {&a};
    hipError_t e = hipLaunchCooperativeKernel((const void*)hymba_fwd, dim3(grid), dim3(512), args, LDS_BYTES, stream);
    if (e != hipSuccess) fprintf(stderr, "cooperative launch failed: %s (grid %d)\n", hipGetErrorString(e), grid);
}
```

```cpp
#include <hip/hip_runtime.h>
#include <hip/hip_cooperative_groups.h>
#include <cstdio>
#include <cstdint>
namespace cg = cooperative_groups;

#define LAS __attribute__((address_space(3)))
typedef unsigned short bf16_t;
typedef short bf16x8 __attribute__((ext_vector_type(8)));
typedef float f32x4 __attribute__((ext_vector_type(4)));
typedef float f32x16 __attribute__((ext_vector_type(16)));
typedef unsigned u32x4 __attribute__((ext_vector_type(4)));
typedef unsigned u32x2 __attribute__((ext_vector_type(2)));

constexpr int D = 2048, SEQ = 2048, NB = 4, MP = NB * SEQ, DB = 128, DS = 4, MS = DB * DS, M = MP + MS;
constexpr int PW = 1024, NG = 64, NMEM = 256, NH = 4, HD = 512, FF = 5632, PBUF = 15;
constexpr float EPS = 1e-6f;

constexpr size_t OUT_Y = 0;
constexpr size_t OUT_PBP = (size_t)M * D;
constexpr size_t OUT_REP = OUT_PBP + (size_t)NB * PBUF * PW;
constexpr size_t OUT_IMP = OUT_REP + (size_t)NB * NG * 64;
constexpr size_t OUT_MK = OUT_IMP + (size_t)NB * NG * 64;
constexpr size_t OUT_MV = OUT_MK + (size_t)NB * NMEM * D;
constexpr size_t OUT_PBS = OUT_MV + (size_t)NB * NMEM * D;
constexpr size_t OUT_RES = OUT_PBS + (size_t)DB * PBUF * PW;
constexpr size_t OUT_IMS = OUT_RES + (size_t)DB * NG * 64;

constexpr size_t CTL_BYTES = 256 * 1024;
constexpr size_t O_SS1 = 0, O_SS2 = 64 * 1024, O_SS3 = 128 * 1024, O_BAR = 192 * 1024, O_PCNT = 248 * 1024;
constexpr size_t O_WIN = 1 << 20;
constexpr size_t O_WKV = O_WIN + (size_t)D * D * 2;
constexpr size_t O_WPOOL = O_WKV + (size_t)2 * D * D * 2;
constexpr size_t O_WGLU = O_WPOOL + (size_t)4 * 256 * 256 * 2;
constexpr size_t O_WOUT = O_WGLU + (size_t)1024 * 1024 * 2;
constexpr size_t O_WQ = O_WOUT + (size_t)D * D * 2;
constexpr size_t O_WO = O_WQ + (size_t)D * D * 2;
constexpr size_t O_WGU = O_WO + (size_t)D * D * 2;
constexpr size_t O_WDN = O_WGU + (size_t)2 * FF * D * 2;
constexpr size_t O_TAB = O_WDN + (size_t)D * FF * 2;
constexpr size_t O_ABAR = O_TAB, O_BB = O_ABAR + 64 * 64 * 16, O_CM = O_BB + 64 * 4096;
constexpr size_t O_HMIX = O_CM + 64 * 4096;
constexpr size_t O_MN = O_HMIX + (size_t)M * D * 2;
constexpr size_t O_P = O_MN + (size_t)1024 * D * 2;
constexpr size_t O_POOLED = O_P + (size_t)M * D * 2;
constexpr size_t O_G = O_POOLED + (size_t)M * 1024 * 2;
constexpr size_t O_MIX = O_G + (size_t)M * 1024 * 2;
constexpr size_t O_X1 = O_MIX + (size_t)M * D * 2;
constexpr size_t O_XB = O_X1 + (size_t)M * D * 4;
constexpr size_t O_Q = O_XB + (size_t)M * D * 2;
constexpr size_t O_KB = O_Q + (size_t)M * D * 2;
constexpr size_t O_VT = O_KB + (size_t)1024 * D * 2;
constexpr size_t O_PR = O_VT + (size_t)D * 1024 * 2;
constexpr size_t O_ATT = O_PR + (size_t)16 * 2048 * 256 * 2;
constexpr size_t O_H = O_ATT + (size_t)M * D * 2;
constexpr size_t WS_END = O_H + (size_t)M * FF * 2;

constexpr int RING_BYTES = 131072, LDS_BYTES = 147456;

__device__ __forceinline__ unsigned cvt_pk_bf16(float lo, float hi) { unsigned r; asm volatile("v_cvt_pk_bf16_f32 %0, %1, %2" : "=v"(r) : "v"(lo), "v"(hi)); return r; }
__device__ __forceinline__ float bf_lo(unsigned w) { return __uint_as_float(w << 16); }
__device__ __forceinline__ float bf_hi(unsigned w) { return __uint_as_float(w & 0xffff0000u); }
__device__ __forceinline__ float wave_sum(float v) {
#pragma unroll
    for (int o = 1; o < 64; o <<= 1) v += __shfl_xor(v, o);
    return v;
}
__device__ __forceinline__ float wave_max(float v) {
#pragma unroll
    for (int o = 1; o < 64; o <<= 1) v = fmaxf(v, __shfl_xor(v, o));
    return v;
}
__device__ __forceinline__ float fast_sigmoid(float x) { return __builtin_amdgcn_rcpf(1.0f + __expf(-x)); }
__device__ __forceinline__ float gelu_tanh(float y) { const float t = 1.5957691216f * (y + 0.044715f * y * y * y); return y * fast_sigmoid(t); }
#define LDS_WAIT() asm volatile("s_waitcnt lgkmcnt(0)" ::: "memory")
__device__ __forceinline__ int opaque_tid(int wv) { int t; asm volatile("v_mbcnt_lo_u32_b32 %0, -1, 0\n\tv_mbcnt_hi_u32_b32 %0, -1, %0\n\tv_lshl_add_u32 %0, %1, 6, %0" : "=&v"(t) : "s"(wv)); return t; }

namespace pg8 {
constexpr int BM = 256, BK = 64, HALF = 128, HTB = HALF * BK * 2;
__device__ __forceinline__ int lds_byte(int r, int c) { const int st = (r >> 4) * 2 + (c >> 5), rr = r & 15, cc = c & 31, ob = rr * 64 + cc * 2; return st * 1024 + (ob ^ (((ob >> 9) & 1) << 5)); }
__device__ __forceinline__ void stage_rc(int b, int& R, int& C) { const int st = b / 1024, sb = b % 1024, swz = sb ^ (((sb >> 9) & 1) << 5); R = (st >> 1) * 16 + swz / 64; C = (st & 1) * 32 + (swz % 64) / 2; }
__device__ __forceinline__ int perm32(int rho) { const int n = rho >> 4, i = rho & 15; return 8 * (i >> 2) + 4 * n + (i & 3); }

struct Unit { const char* a; const char* b; const char* s; int pm, pn, job, srow; };
struct Dims { int lda, ldb, K; };

constexpr int SBUF_OFF = 131072;
template <class Epi, class Sched, bool ALIGN_EPI, bool STRIP>
__device__ __forceinline__ void gemm_phase(LAS unsigned char* lds, const Dims g, const Sched& S, const Epi& E, const int wv) {
    const int tid = opaque_tid(wv), wid = __builtin_amdgcn_readfirstlane(tid >> 6), lane = tid & 63, wr = wid >> 2, wc = wid & 3, fr = lane & 15, fq = lane >> 4;
    int nt = g.K / BK; asm volatile("" : "+s"(nt));
    unsigned voffA[2], voffB[2];
#pragma unroll
    for (int i = 0; i < 2; ++i) { int R, C; stage_rc(tid * 16 + i * 8192, R, C); const int Rb = (R & ~31) + perm32(R & 31);
        voffA[i] = (unsigned)(R * g.lda + C) * 2u; voffB[i] = (unsigned)(Rb * g.ldb + C) * 2u; }
    const unsigned voffS = (unsigned)((2 * wid + (lane >> 5)) * g.lda * 2 + (((((lane & 31) >> 2) ^ wid) & 7) * 16) + (lane & 3) * 4);
    const int soff = fr * 128 + ((fq ^ ((fr >> 1) & 7)) * 16);
    const size_t kstep = (size_t)(BK * 2);
    const size_t hstepA = (size_t)HALF * g.lda * 2, hstepB = (size_t)HALF * g.ldb * 2;
    const unsigned ldsw = (unsigned)wid * 1024u;
    const int aoff = lds_byte(wr * 64 + fr, fq * 8), boff = lds_byte(wc * 32 + fr, fq * 8);
#define PG8_SA(b, h) (((b) * 2 + (h)) * HTB)
#define PG8_SB(b, h) ((4 + (b) * 2 + (h)) * HTB)
#define PG8_STAGE(bufoff, gbase, voff) do { _Pragma("unroll") for (int _i = 0; _i < 2; ++_i) \
        __builtin_amdgcn_global_load_lds((const unsigned*)((const char*)(gbase) + (voff)[_i]), (LAS unsigned*)(lds + (bufoff) + ldsw + _i * 8192), 16, 0, 0); } while (0)
#define PG8_STAGE_S(b, gbase) do { if constexpr (STRIP) __builtin_amdgcn_global_load_lds((const unsigned*)((const char*)(gbase) + voffS), (LAS unsigned*)(lds + SBUF_OFF + (b) * 2048 + wid * 256), 4, 0, 0); } while (0)
#define PG8_LDS_S(b) do { if constexpr (STRIP) { As[0] = *(const LAS bf16x8*)(lds + SBUF_OFF + (b) * 2048 + soff); As[1] = *(const LAS bf16x8*)(lds + SBUF_OFF + (b) * 2048 + (soff ^ 64)); } } while (0)
#define PG8_LDA(dst, b, h) do { _Pragma("unroll") for (int m = 0; m < 4; ++m) _Pragma("unroll") for (int k = 0; k < 2; ++k) dst[m][k] = *(const LAS bf16x8*)(lds + PG8_SA(b, h) + aoff + m * 2048 + k * 1024); } while (0)
#define PG8_LDB(dst, b, h) do { _Pragma("unroll") for (int n = 0; n < 2; ++n) _Pragma("unroll") for (int k = 0; k < 2; ++k) dst[n][k] = *(const LAS bf16x8*)(lds + PG8_SB(b, h) + boff + n * 2048 + k * 1024); } while (0)
#define PG8_MMA(ai, bj, At, Bt) do { __builtin_amdgcn_s_setprio(1); _Pragma("unroll") for (int m = 0; m < 4; ++m) _Pragma("unroll") for (int n = 0; n < 2; ++n) _Pragma("unroll") for (int k = 0; k < 2; ++k) \
        acc[ai][bj][m][n] = __builtin_amdgcn_mfma_f32_16x16x32_bf16(Bt[n][k], At[m][k], acc[ai][bj][m][n], 0, 0, 0); __builtin_amdgcn_s_setprio(0); } while (0)
#define PG8_MMA_S() do { if constexpr (STRIP) { __builtin_amdgcn_s_setprio(1); \
        if (wr == 0) { _Pragma("unroll") for (int k = 0; k < 2; ++k) { sacc[0] = __builtin_amdgcn_mfma_f32_16x16x32_bf16(B0[0][k], As[k], sacc[0], 0, 0, 0); sacc[1] = __builtin_amdgcn_mfma_f32_16x16x32_bf16(B1[0][k], As[k], sacc[1], 0, 0, 0); } } \
        else         { _Pragma("unroll") for (int k = 0; k < 2; ++k) { sacc[0] = __builtin_amdgcn_mfma_f32_16x16x32_bf16(B0[1][k], As[k], sacc[0], 0, 0, 0); sacc[1] = __builtin_amdgcn_mfma_f32_16x16x32_bf16(B1[1][k], As[k], sacc[1], 0, 0, 0); } } \
        __builtin_amdgcn_s_setprio(0); } } while (0)
#define PG8_WAIT_V(n) asm volatile("s_waitcnt vmcnt(" #n ")" ::: "memory")
#define PG8_WAIT_VL() do { if constexpr (STRIP) PG8_WAIT_V(9); else PG8_WAIT_V(8); } while (0)
#define PG8_WAIT_L(n) asm volatile("s_waitcnt lgkmcnt(" #n ")" ::: "memory")
#define PG8_BAR __builtin_amdgcn_s_barrier()
#define PG8_SCHED __builtin_amdgcn_sched_barrier(0)
    Unit cur, nxt; int ui = 0;
    if (!S.next(0, cur)) return;
    f32x4 acc[2][2][4][2];
#pragma unroll
    for (int a = 0; a < 2; ++a)
#pragma unroll
        for (int b = 0; b < 2; ++b)
#pragma unroll
            for (int m = 0; m < 4; ++m)
#pragma unroll
                for (int n = 0; n < 2; ++n) acc[a][b][m][n] = (f32x4){0.f, 0.f, 0.f, 0.f};
    f32x4 sacc[2]; sacc[0] = (f32x4){0.f, 0.f, 0.f, 0.f}; sacc[1] = (f32x4){0.f, 0.f, 0.f, 0.f};
    bf16x8 At[4][2], B0[2][2], B1[2][2], As[2];
    const char* cA = cur.a; const char* cB = cur.b; const char* cS = cur.s;
    PG8_STAGE(PG8_SB(0, 0), cB, voffB); PG8_STAGE(PG8_SB(0, 1), cB + hstepB, voffB); PG8_STAGE(PG8_SA(0, 0), cA, voffA); PG8_STAGE_S(0, cS); PG8_STAGE(PG8_SA(0, 1), cA + hstepA, voffA);
    if (wr == 1) PG8_BAR;
    PG8_WAIT_V(2); PG8_BAR;
    PG8_STAGE(PG8_SB(1, 0), cB + kstep, voffB); PG8_STAGE(PG8_SA(1, 0), cA + kstep, voffA); PG8_STAGE(PG8_SB(1, 1), cB + hstepB + kstep, voffB); PG8_STAGE_S(1, cS + kstep);
    if constexpr (STRIP) PG8_WAIT_V(7); else PG8_WAIT_V(6);
    PG8_BAR;
    for (;;) {
        const bool has_next = S.next(ui + 1, nxt);
        const char* nA = has_next ? nxt.a : cA; const char* nB = has_next ? nxt.b : cB; const char* nS = has_next ? nxt.s : cS;
        for (int t = 0; t < nt; t += 2) {
            const bool last = (t == nt - 2);
            const char* a1 = cA + (size_t)(t + 1) * kstep;
            const char* a2 = last ? nA : cA + (size_t)(t + 2) * kstep; const char* b2 = last ? nB : cB + (size_t)(t + 2) * kstep; const char* s2 = last ? nS : cS + (size_t)(t + 2) * kstep;
            const char* a3 = a2 + kstep; const char* b3 = b2 + kstep; const char* s3 = s2 + kstep;
            PG8_LDB(B0, 0, 0); PG8_LDB(B1, 0, 1); PG8_SCHED; PG8_LDA(At, 0, 0); PG8_LDS_S(0); PG8_STAGE(PG8_SA(1, 1), a1 + hstepA, voffA);
            PG8_WAIT_VL(); PG8_WAIT_L(0); PG8_BAR; PG8_MMA(0, 0, At, B0); PG8_MMA(0, 1, At, B1); PG8_MMA_S(); PG8_BAR; PG8_SCHED;
            PG8_LDA(At, 0, 1); PG8_STAGE(PG8_SB(0, 0), b2, voffB); PG8_STAGE(PG8_SB(0, 1), b2 + hstepB, voffB); PG8_STAGE(PG8_SA(0, 0), a2, voffA); PG8_STAGE_S(0, s2);
            PG8_WAIT_VL(); PG8_WAIT_L(0); PG8_BAR; PG8_MMA(1, 0, At, B0); PG8_MMA(1, 1, At, B1); PG8_BAR; PG8_SCHED;
            PG8_LDB(B0, 1, 0); PG8_LDB(B1, 1, 1); PG8_SCHED; PG8_LDA(At, 1, 0); PG8_LDS_S(1); PG8_STAGE(PG8_SA(0, 1), a2 + hstepA, voffA);
            PG8_WAIT_VL(); PG8_WAIT_L(0); PG8_BAR; PG8_MMA(0, 0, At, B0); PG8_MMA(0, 1, At, B1); PG8_MMA_S(); PG8_BAR; PG8_SCHED;
            PG8_LDA(At, 1, 1); PG8_STAGE(PG8_SB(1, 0), b3, voffB); PG8_STAGE(PG8_SB(1, 1), b3 + hstepB, voffB); PG8_STAGE(PG8_SA(1, 0), a3, voffA); PG8_STAGE_S(1, s3);
            PG8_WAIT_VL(); PG8_WAIT_L(0); PG8_BAR; PG8_MMA(1, 0, At, B0); PG8_MMA(1, 1, At, B1); PG8_BAR; PG8_SCHED;
        }
        if constexpr (ALIGN_EPI) { if (wr == 0) PG8_BAR; }
        if constexpr (!Epi::AFTER_DRAIN) { E(acc, cur, wr, wc, fr, fq); if constexpr (STRIP) { if (cur.srow >= 0) E.strip(sacc, cur, wr, wc, fr, fq); } }
        if (!has_next) break;
#pragma unroll
        for (int a = 0; a < 2; ++a)
#pragma unroll
            for (int b = 0; b < 2; ++b)
#pragma unroll
                for (int m = 0; m < 4; ++m)
#pragma unroll
                    for (int n = 0; n < 2; ++n) acc[a][b][m][n] = (f32x4){0.f, 0.f, 0.f, 0.f};
        sacc[0] = (f32x4){0.f, 0.f, 0.f, 0.f}; sacc[1] = (f32x4){0.f, 0.f, 0.f, 0.f};
        cur = nxt; cA = nA; cB = nB; cS = nS; ++ui;
        if constexpr (ALIGN_EPI) { if (wr == 1) PG8_BAR; }
    }
    PG8_WAIT_V(0);
    if constexpr (!ALIGN_EPI) { if (wr == 0) PG8_BAR; }
    PG8_BAR;
    if constexpr (Epi::AFTER_DRAIN) { E.fused(acc, sacc, cur, wr, wc, fr, fq, lds, wid, lane); }
#undef PG8_SA
#undef PG8_SB
#undef PG8_STAGE
#undef PG8_STAGE_S
#undef PG8_LDS_S
#undef PG8_LDA
#undef PG8_LDB
#undef PG8_MMA
#undef PG8_MMA_S
#undef PG8_WAIT_V
#undef PG8_WAIT_VL
#undef PG8_WAIT_L
#undef PG8_BAR
#undef PG8_SCHED
}
typedef f32x4 Acc[2][2][4][2];

__device__ __forceinline__ void st_bf16x8(bf16_t* p, f32x4 v0, f32x4 v1) {
    u32x4 w; w.x = cvt_pk_bf16(v0[0], v0[1]); w.y = cvt_pk_bf16(v0[2], v0[3]); w.z = cvt_pk_bf16(v1[0], v1[1]); w.w = cvt_pk_bf16(v1[2], v1[3]); *(u32x4*)p = w;
}
__device__ __forceinline__ void st_bf16x4(bf16_t* p, f32x4 v) { u32x2 w; w.x = cvt_pk_bf16(v[0], v[1]); w.y = cvt_pk_bf16(v[2], v[3]); *(u32x2*)p = w; }
typedef f32x4 SAcc[2];
struct EpiInKv {
    static constexpr bool AFTER_DRAIN = false;
    bf16_t* P; float* out; bf16_t* KB; bf16_t* VT;
    __device__ __forceinline__ void operator()(const Acc& acc, const Unit& u, int wr, int wc, int fr, int fq) const {
        if (u.job == 0) {
#pragma unroll
            for (int ai = 0; ai < 2; ++ai)
#pragma unroll
                for (int m = 0; m < 4; ++m) {
                    const int row = u.pm * 256 + ai * 128 + wr * 64 + m * 16 + fr;
                    float* pbp = nullptr;
                    if (u.pn < 4) {
                        if (row < MP) { const int t = row & (SEQ - 1); if (t >= SEQ - PBUF) pbp = out + OUT_PBP + ((size_t)(row >> 11) * PBUF + (t - (SEQ - PBUF))) * PW; }
                        else { const int rs = row - MP; pbp = out + OUT_PBS + ((size_t)(rs >> 2) * PBUF + 11 + (rs & 3)) * PW; }
                    }
#pragma unroll
                    for (int bj = 0; bj < 2; ++bj) {
                        const int col = u.pn * 256 + bj * 128 + wc * 32 + 8 * fq;
                        const f32x4 v0 = acc[ai][bj][m][0], v1 = acc[ai][bj][m][1];
                        st_bf16x8(P + (size_t)row * D + col, v0, v1);
                        if (pbp) { *(f32x4*)(pbp + col) = v0; *(f32x4*)(pbp + col + 4) = v1; }
                    }
                }
        } else {
#pragma unroll
            for (int ai = 0; ai < 2; ++ai)
#pragma unroll
                for (int m = 0; m < 4; ++m) {
                    const int row = u.pm * 256 + ai * 128 + wr * 64 + m * 16 + fr;
#pragma unroll
                    for (int bj = 0; bj < 2; ++bj) {
                        const int col = u.pn * 256 + bj * 128 + wc * 32 + 8 * fq;
                        const f32x4 v0 = acc[ai][bj][m][0], v1 = acc[ai][bj][m][1];
                        if (col < D) {
                            float* o = out + OUT_MK + (size_t)row * D + col; *(f32x4*)o = v0; *(f32x4*)(o + 4) = v1;
                            st_bf16x8(KB + (size_t)row * D + col, v0, v1);
                        } else {
                            const int c = col - D;
                            float* o = out + OUT_MV + (size_t)row * D + c; *(f32x4*)o = v0; *(f32x4*)(o + 4) = v1;
#pragma unroll
                            for (int i = 0; i < 4; ++i) { VT[(size_t)(c + i) * 1024 + row] = (bf16_t)(cvt_pk_bf16(v0[i], 0.f) & 0xffffu); VT[(size_t)(c + 4 + i) * 1024 + row] = (bf16_t)(cvt_pk_bf16(v1[i], 0.f) & 0xffffu); }
                        }
                    }
                }
        }
    }
    __device__ __forceinline__ void strip(const SAcc& sacc, const Unit& u, int wr, int wc, int fr, int fq) const {
        const int row = u.srow + fr, rs = row - MP;
        float* pbp = (u.pn < 4) ? out + OUT_PBS + ((size_t)(rs >> 2) * PBUF + 11 + (rs & 3)) * PW : nullptr;
#pragma unroll
        for (int bj = 0; bj < 2; ++bj) {
            const int col = u.pn * 256 + bj * 128 + wc * 32 + 8 * fq + 4 * wr;
            st_bf16x4(P + (size_t)row * D + col, sacc[bj]);
            if (pbp) *(f32x4*)(pbp + col) = sacc[bj];
        }
    }
};
struct EpiPool {
    static constexpr bool AFTER_DRAIN = false;
    bf16_t* MIX; const float* scale;
    __device__ __forceinline__ void operator()(const Acc& acc, const Unit& u, int wr, int wc, int fr, int fq) const {
#pragma unroll
        for (int bj = 0; bj < 2; ++bj) {
            const int col = u.pn * 256 + bj * 128 + wc * 32 + 8 * fq;
            const f32x4 s0 = *(const f32x4*)(scale + col), s1 = *(const f32x4*)(scale + col + 4);
#pragma unroll
            for (int ai = 0; ai < 2; ++ai)
#pragma unroll
                for (int m = 0; m < 4; ++m) {
                    const int row = u.pm * 256 + ai * 128 + wr * 64 + m * 16 + fr;
                    st_bf16x8(MIX + (size_t)row * D + col, acc[ai][bj][m][0] * s0, acc[ai][bj][m][1] * s1);
                }
        }
    }
    __device__ __forceinline__ void strip(const SAcc& sacc, const Unit& u, int wr, int wc, int fr, int fq) const {
        const int row = u.srow + fr;
#pragma unroll
        for (int bj = 0; bj < 2; ++bj) {
            const int col = u.pn * 256 + bj * 128 + wc * 32 + 8 * fq + 4 * wr;
            st_bf16x4(MIX + (size_t)row * D + col, sacc[bj] * *(const f32x4*)(scale + col));
        }
    }
};
struct EpiGlu {
    static constexpr bool AFTER_DRAIN = false;
    bf16_t* MIX; const bf16_t* G; const float* bias;
    __device__ __forceinline__ void operator()(const Acc& acc, const Unit& u, int wr, int wc, int fr, int fq) const {
#pragma unroll
        for (int bj = 0; bj < 2; ++bj) {
            const int col = u.pn * 256 + bj * 128 + wc * 32 + 8 * fq;
            const f32x4 b0 = *(const f32x4*)(bias + col), b1 = *(const f32x4*)(bias + col + 4);
#pragma unroll
            for (int ai = 0; ai < 2; ++ai) {
                u32x4 gws[4];
#pragma unroll
                for (int m = 0; m < 4; ++m) gws[m] = *(const u32x4*)(G + (size_t)(u.pm * 256 + ai * 128 + wr * 64 + m * 16 + fr) * 1024 + col);
#pragma unroll
                for (int m = 0; m < 4; ++m) {
                    const int row = u.pm * 256 + ai * 128 + wr * 64 + m * 16 + fr;
                    const u32x4 gw = gws[m];
                    const f32x4 x0 = acc[ai][bj][m][0] + b0, x1 = acc[ai][bj][m][1] + b1;
                    f32x4 o0, o1;
                    o0[0] = bf_lo(gw.x) * fast_sigmoid(x0[0]); o0[1] = bf_hi(gw.x) * fast_sigmoid(x0[1]); o0[2] = bf_lo(gw.y) * fast_sigmoid(x0[2]); o0[3] = bf_hi(gw.y) * fast_sigmoid(x0[3]);
                    o1[0] = bf_lo(gw.z) * fast_sigmoid(x1[0]); o1[1] = bf_hi(gw.z) * fast_sigmoid(x1[1]); o1[2] = bf_lo(gw.w) * fast_sigmoid(x1[2]); o1[3] = bf_hi(gw.w) * fast_sigmoid(x1[3]);
                    st_bf16x8(MIX + (size_t)row * D + 1024 + col, o0, o1);
                }
            }
        }
    }
    __device__ __forceinline__ void strip(const SAcc& sacc, const Unit& u, int wr, int wc, int fr, int fq) const {
        const int row = u.srow + fr;
#pragma unroll
        for (int bj = 0; bj < 2; ++bj) {
            const int col = u.pn * 256 + bj * 128 + wc * 32 + 8 * fq + 4 * wr;
            const u32x2 gw = *(const u32x2*)(G + (size_t)row * 1024 + col);
            const f32x4 x = sacc[bj] + *(const f32x4*)(bias + col);
            f32x4 o; o[0] = bf_lo(gw.x) * fast_sigmoid(x[0]); o[1] = bf_hi(gw.x) * fast_sigmoid(x[1]); o[2] = bf_lo(gw.y) * fast_sigmoid(x[2]); o[3] = bf_hi(gw.y) * fast_sigmoid(x[3]);
            st_bf16x4(MIX + (size_t)row * D + 1024 + col, o);
        }
    }
};
__device__ __forceinline__ void ld_res8(const float* p, f32x4& a, f32x4& b) { a = *(const f32x4*)p; b = *(const f32x4*)(p + 4); }
__device__ __forceinline__ void ld_res8(const bf16_t* p, f32x4& a, f32x4& b) { const u32x4 w = *(const u32x4*)p; a = (f32x4){bf_lo(w.x), bf_hi(w.x), bf_lo(w.y), bf_hi(w.y)}; b = (f32x4){bf_lo(w.z), bf_hi(w.z), bf_lo(w.w), bf_hi(w.w)}; }
__device__ __forceinline__ f32x4 ld_res4(const float* p) { return *(const f32x4*)p; }
__device__ __forceinline__ f32x4 ld_res4(const bf16_t* p) { const u32x2 w = *(const u32x2*)p; return (f32x4){bf_lo(w.x), bf_hi(w.x), bf_lo(w.y), bf_hi(w.y)}; }
template <class RT>
struct EpiRes {
    static constexpr bool AFTER_DRAIN = false;
    const RT* xin_p; const RT* xin_s; float* xo; bf16_t* xb; float* ss;
    __device__ __forceinline__ void operator()(const Acc& acc, const Unit& u, int wr, int wc, int fr, int fq) const {
        const RT* xin = xin_p;
#pragma unroll
        for (int ai = 0; ai < 2; ++ai)
#pragma unroll
            for (int m = 0; m < 4; ++m) {
                const int row = u.pm * 256 + ai * 128 + wr * 64 + m * 16 + fr;
                float sq = 0.f;
#pragma unroll
                for (int bj = 0; bj < 2; ++bj) {
                    const int col = u.pn * 256 + bj * 128 + wc * 32 + 8 * fq;
                    const size_t off = (size_t)row * D + col;
                    f32x4 r0, r1; ld_res8(xin + off, r0, r1);
                    const f32x4 v0 = acc[ai][bj][m][0] + r0, v1 = acc[ai][bj][m][1] + r1;
                    if (xo) { *(f32x4*)(xo + off) = v0; *(f32x4*)(xo + off + 4) = v1; }
                    if (xb) st_bf16x8(xb + off, v0, v1);
                    sq += (v0[0] * v0[0] + v0[1] * v0[1]) + (v0[2] * v0[2] + v0[3] * v0[3]) + (v1[0] * v1[0] + v1[1] * v1[1]) + (v1[2] * v1[2] + v1[3] * v1[3]);
                }
                sq += __shfl_xor(sq, 16); sq += __shfl_xor(sq, 32);
                if (fq == 0) atomicAdd(ss + row, sq);
            }
    }
    __device__ __forceinline__ void strip(const SAcc& sacc, const Unit& u, int wr, int wc, int fr, int fq) const {
        const int row = u.srow + fr; const RT* xin = xin_s - (size_t)MP * D;
        float sq = 0.f;
#pragma unroll
        for (int bj = 0; bj < 2; ++bj) {
            const int col = u.pn * 256 + bj * 128 + wc * 32 + 8 * fq + 4 * wr;
            const size_t off = (size_t)row * D + col;
            const f32x4 v = sacc[bj] + ld_res4(xin + off);
            if (xo) *(f32x4*)(xo + off) = v;
            if (xb) st_bf16x4(xb + off, v);
            sq += (v[0] * v[0] + v[1] * v[1]) + (v[2] * v[2] + v[3] * v[3]);
        }
        sq += __shfl_xor(sq, 16); sq += __shfl_xor(sq, 32);
        if (fq == 0) atomicAdd(ss + row, sq);
    }
};
struct EpiFinal {
    static constexpr bool AFTER_DRAIN = true;
    const bf16_t* xin; float* out; float* ss; unsigned* cnt; const float* gf;
    __device__ __forceinline__ void operator()(const Acc&, const Unit&, int, int, int, int) const {}
    __device__ __forceinline__ void fused(Acc& acc, f32x4 (&sacc)[2], const Unit& u, int wr, int wc, int fr, int fq, LAS unsigned char* lds, int wid, int lane) const {
#pragma unroll
        for (int ai = 0; ai < 2; ++ai)
#pragma unroll
            for (int m = 0; m < 4; ++m) {
                const int row = u.pm * 256 + ai * 128 + wr * 64 + m * 16 + fr;
                float sq = 0.f;
#pragma unroll
                for (int bj = 0; bj < 2; ++bj) {
                    const size_t off = (size_t)row * D + u.pn * 256 + bj * 128 + wc * 32 + 8 * fq;
                    f32x4 r0, r1; ld_res8(xin + off, r0, r1);
                    const f32x4 v0 = acc[ai][bj][m][0] + r0, v1 = acc[ai][bj][m][1] + r1; acc[ai][bj][m][0] = v0; acc[ai][bj][m][1] = v1;
                    sq += (v0[0] * v0[0] + v0[1] * v0[1]) + (v0[2] * v0[2] + v0[3] * v0[3]) + (v1[0] * v1[0] + v1[1] * v1[1]) + (v1[2] * v1[2] + v1[3] * v1[3]);
                }
                sq += __shfl_xor(sq, 16); sq += __shfl_xor(sq, 32);
                if (fq == 0) { const float old = atomicAdd(ss + row, sq); asm volatile("" :: "v"(old)); }
            }
        const int srow = u.srow + fr;
        {
            float sq = 0.f;
#pragma unroll
            for (int bj = 0; bj < 2; ++bj) {
                const size_t off = (size_t)srow * D + u.pn * 256 + bj * 128 + wc * 32 + 8 * fq + 4 * wr;
                const f32x4 v = sacc[bj] + ld_res4(xin + off); sacc[bj] = v;
                sq += (v[0] * v[0] + v[1] * v[1]) + (v[2] * v[2] + v[3] * v[3]);
            }
            sq += __shfl_xor(sq, 16); sq += __shfl_xor(sq, 32);
            if (fq == 0) { const float old = atomicAdd(ss + srow, sq); asm volatile("" :: "v"(old)); }
        }
        asm volatile("s_waitcnt vmcnt(0)" ::: "memory");
        __builtin_amdgcn_s_barrier();
        if (wid == 0 && lane == 0) {
            unsigned* cw = cnt + 64 * u.pm;
            __hip_atomic_fetch_add(cw, 1u, __ATOMIC_RELEASE, __HIP_MEMORY_SCOPE_AGENT);
            unsigned sp = 0;
            while (__hip_atomic_load(cw, __ATOMIC_RELAXED, __HIP_MEMORY_SCOPE_AGENT) < 8u) { __builtin_amdgcn_s_sleep(1); if (++sp > (1u << 22)) break; }
            __builtin_amdgcn_fence(__ATOMIC_ACQUIRE, "agent");
            asm volatile("s_waitcnt vmcnt(0)" ::: "memory");
        }
        __builtin_amdgcn_s_barrier(); asm volatile("" ::: "memory");
        f32x4 g0[2], g1[2];
#pragma unroll
        for (int bj = 0; bj < 2; ++bj) { const int col = u.pn * 256 + bj * 128 + wc * 32 + 8 * fq; g0[bj] = *(const f32x4*)(gf + col); g1[bj] = *(const f32x4*)(gf + col + 4); }
#pragma unroll
        for (int ai = 0; ai < 2; ++ai)
#pragma unroll
            for (int m = 0; m < 4; ++m) {
                const int row = u.pm * 256 + ai * 128 + wr * 64 + m * 16 + fr;
                const float rs = rsqrtf(__hip_atomic_load(ss + row, __ATOMIC_RELAXED, __HIP_MEMORY_SCOPE_AGENT) * (1.0f / D) + EPS);
#pragma unroll
                for (int bj = 0; bj < 2; ++bj) {
                    const size_t off = (size_t)row * D + u.pn * 256 + bj * 128 + wc * 32 + 8 * fq;
                    *(f32x4*)(out + off) = acc[ai][bj][m][0] * rs * g0[bj]; *(f32x4*)(out + off + 4) = acc[ai][bj][m][1] * rs * g1[bj];
                }
            }
        {
            const float rs = rsqrtf(__hip_atomic_load(ss + srow, __ATOMIC_RELAXED, __HIP_MEMORY_SCOPE_AGENT) * (1.0f / D) + EPS);
#pragma unroll
            for (int bj = 0; bj < 2; ++bj) {
                const int col = u.pn * 256 + bj * 128 + wc * 32 + 8 * fq + 4 * wr;
                *(f32x4*)(out + (size_t)srow * D + col) = sacc[bj] * rs * *(const f32x4*)(gf + col);
            }
        }
    }
};
struct EpiQ {
    static constexpr bool AFTER_DRAIN = false;
    bf16_t* Q; const float* ss;
    __device__ __forceinline__ void operator()(const Acc& acc, const Unit& u, int wr, int wc, int fr, int fq) const {
        float ssv[2][4];
#pragma unroll
        for (int ai = 0; ai < 2; ++ai)
#pragma unroll
            for (int m = 0; m < 4; ++m) ssv[ai][m] = ss[u.pm * 256 + ai * 128 + wr * 64 + m * 16 + fr];
#pragma unroll
        for (int ai = 0; ai < 2; ++ai)
#pragma unroll
            for (int m = 0; m < 4; ++m) {
                const int row = u.pm * 256 + ai * 128 + wr * 64 + m * 16 + fr;
                const float rs = rsqrtf(ssv[ai][m] * (1.0f / D) + EPS);
#pragma unroll
                for (int bj = 0; bj < 2; ++bj) {
                    const int col = u.pn * 256 + bj * 128 + wc * 32 + 8 * fq;
                    st_bf16x8(Q + (size_t)row * D + col, acc[ai][bj][m][0] * rs, acc[ai][bj][m][1] * rs);
                }
            }
    }
    __device__ __forceinline__ void strip(const SAcc& sacc, const Unit& u, int wr, int wc, int fr, int fq) const {
        const int row = u.srow + fr; const float rs = rsqrtf(ss[row] * (1.0f / D) + EPS);
#pragma unroll
        for (int bj = 0; bj < 2; ++bj) st_bf16x4(Q + (size_t)row * D + u.pn * 256 + bj * 128 + wc * 32 + 8 * fq + 4 * wr, sacc[bj] * rs);
    }
};
struct EpiGateUp {
    static constexpr bool AFTER_DRAIN = false;
    bf16_t* H; const float* ss;
    __device__ __forceinline__ void operator()(const Acc& acc, const Unit& u, int wr, int wc, int fr, int fq) const {
        const int col = u.pn * 128 + wc * 32 + 8 * fq;
        float ssv[2][4];
#pragma unroll
        for (int ai = 0; ai < 2; ++ai)
#pragma unroll
            for (int m = 0; m < 4; ++m) ssv[ai][m] = ss[u.pm * 256 + ai * 128 + wr * 64 + m * 16 + fr];
#pragma unroll
        for (int ai = 0; ai < 2; ++ai)
#pragma unroll
            for (int m = 0; m < 4; ++m) {
                const int row = u.pm * 256 + ai * 128 + wr * 64 + m * 16 + fr;
                const float rs = rsqrtf(ssv[ai][m] * (1.0f / D) + EPS);
                f32x4 o[2];
#pragma unroll
                for (int n = 0; n < 2; ++n)
#pragma unroll
                    for (int j = 0; j < 4; ++j) { const float gt = acc[ai][0][m][n][j] * rs, up = acc[ai][1][m][n][j] * rs; o[n][j] = gt * fast_sigmoid(gt) * up; }
                st_bf16x8(H + (size_t)row * FF + col, o[0], o[1]);
            }
    }
    __device__ __forceinline__ void strip(const SAcc& sacc, const Unit& u, int wr, int wc, int fr, int fq) const {
        const int row = u.srow + fr; const float rs = rsqrtf(ss[row] * (1.0f / D) + EPS);
        f32x4 o;
#pragma unroll
        for (int j = 0; j < 4; ++j) { const float gt = sacc[0][j] * rs, up = sacc[1][j] * rs; o[j] = gt * fast_sigmoid(gt) * up; }
        st_bf16x4(H + (size_t)row * FF + u.pn * 128 + wc * 32 + 8 * fq + 4 * wr, o);
    }
};
struct EpiPV {
    static constexpr bool AFTER_DRAIN = false;
    bf16_t* ATT;
    __device__ __forceinline__ void operator()(const Acc& acc, const Unit& u, int wr, int wc, int fr, int fq) const {
#pragma unroll
        for (int ai = 0; ai < 2; ++ai)
#pragma unroll
            for (int m = 0; m < 4; ++m) {
                const int row = u.pm * 256 + ai * 128 + wr * 64 + m * 16 + fr;
#pragma unroll
                for (int bj = 0; bj < 2; ++bj) {
                    const int col = u.pn * 256 + bj * 128 + wc * 32 + 8 * fq;
                    st_bf16x8(ATT + (size_t)row * D + col, acc[ai][bj][m][0], acc[ai][bj][m][1]);
                }
            }
    }
};
struct EpiSoftmax {
    static constexpr bool AFTER_DRAIN = true;
    bf16_t* PR;
    __device__ __forceinline__ void operator()(const Acc&, const Unit&, int, int, int, int) const {}
    __device__ __forceinline__ void fused(Acc& acc, f32x4 (&)[2], const Unit& u, int wr, int wc, int fr, int fq, LAS unsigned char* lds, int wid, int lane) const {
        LAS float* MX = (LAS float*)lds;
        LAS float* SM = (LAS float*)(lds + 4096);
#pragma unroll
        for (int ai = 0; ai < 2; ++ai)
#pragma unroll
            for (int m = 0; m < 4; ++m) {
                float mx = -3.0e38f;
#pragma unroll
                for (int bj = 0; bj < 2; ++bj)
#pragma unroll
                    for (int n = 0; n < 2; ++n)
#pragma unroll
                        for (int j = 0; j < 4; ++j) mx = fmaxf(mx, acc[ai][bj][m][n][j]);
                mx = fmaxf(mx, __shfl_xor(mx, 16)); mx = fmaxf(mx, __shfl_xor(mx, 32));
                if (fq == 0) MX[(ai * 128 + wr * 64 + m * 16 + fr) * 4 + wc] = mx;
            }
        LDS_WAIT(); __builtin_amdgcn_s_barrier(); asm volatile("" ::: "memory");
#pragma unroll
        for (int ai = 0; ai < 2; ++ai)
#pragma unroll
            for (int m = 0; m < 4; ++m) {
                const int r = ai * 128 + wr * 64 + m * 16 + fr;
                const f32x4 mv = *(const LAS f32x4*)(MX + r * 4);
                const float mx = fmaxf(fmaxf(mv[0], mv[1]), fmaxf(mv[2], mv[3]));
                float sm = 0.f;
#pragma unroll
                for (int bj = 0; bj < 2; ++bj)
#pragma unroll
                    for (int n = 0; n < 2; ++n)
#pragma unroll
                        for (int j = 0; j < 4; ++j) { const float e = __expf(acc[ai][bj][m][n][j] - mx); acc[ai][bj][m][n][j] = e; sm += e; }
                sm += __shfl_xor(sm, 16); sm += __shfl_xor(sm, 32);
                if (fq == 0) SM[r * 4 + wc] = sm;
            }
        LDS_WAIT(); __builtin_amdgcn_s_barrier(); asm volatile("" ::: "memory");
#pragma unroll
        for (int ai = 0; ai < 2; ++ai)
#pragma unroll
            for (int m = 0; m < 4; ++m) {
                const int r = ai * 128 + wr * 64 + m * 16 + fr;
                const f32x4 sv = *(const LAS f32x4*)(SM + r * 4);
                const float inv = __builtin_amdgcn_rcpf((sv[0] + sv[1]) + (sv[2] + sv[3]));
#pragma unroll
                for (int bj = 0; bj < 2; ++bj) {
                    const int col = bj * 128 + wc * 32 + 8 * fq;
                    st_bf16x8(PR + ((size_t)u.job * SEQ + u.pm * 256 + r) * 256 + col, acc[ai][bj][m][0] * inv, acc[ai][bj][m][1] * inv);
                }
            }
        LDS_WAIT(); __builtin_amdgcn_s_barrier(); asm volatile("" ::: "memory");
    }
};
}
using pg8::Unit;

enum { I_XP = 0, I_XS = 1, I_MEM = 2, I_PBUF = 3, I_SRE = 4, I_SIM = 5, I_CK = 6, I_CV = 7, I_GMIX = 8, I_WIN = 9, I_WPOOL = 10, I_PSCALE = 11,
       I_LRE = 12, I_LIM = 13, I_LSTEP = 14, I_BRE = 15, I_BIM = 16, I_CRE = 17, I_CIM = 18, I_SSMD = 19, I_WGLU = 20, I_BGLU = 21, I_WOUT = 22,
       I_GCROSS = 23, I_GMEM = 24, I_WQ = 25, I_WK = 26, I_WV = 27, I_WO = 28, I_GFFN = 29, I_WGATE = 30, I_WUP = 31, I_WDOWN = 32, I_GFINAL = 33 };
struct Args {
    const float* in[34];
    float* out; unsigned char* ws;
};

struct CvItem { const float* src; bf16_t* dst; const float* gk; float sc; int N, ldt; };
__device__ __forceinline__ void cv_load(const CvItem& it, f32x4 (&v)[8], float (&g)[8], int lane) {
#pragma unroll
    for (int i = 0; i < 8; ++i) { const int kk = (lane >> 3) + 8 * i; v[i] = *(const f32x4*)(it.src + (size_t)kk * it.N + 4 * (lane & 7)); g[i] = it.gk ? it.gk[kk] : 1.0f; }
}
__device__ __forceinline__ void cv_finish(const CvItem& it, const f32x4 (&v)[8], const float (&g)[8], LAS float* scr, int lane) {
#pragma unroll
    for (int i = 0; i < 8; ++i) { const int kk = (lane >> 3) + 8 * i; const float m = g[i] * it.sc; LAS float* d = scr + kk * 33 + 4 * (lane & 7);
        d[0] = v[i][0] * m; d[1] = v[i][1] * m; d[2] = v[i][2] * m; d[3] = v[i][3] * m; }
    LDS_WAIT(); __builtin_amdgcn_wave_barrier();
    const int c = lane & 7;
#pragma unroll
    for (int j = 0; j < 4; ++j) { const int n = (lane >> 3) + 8 * j; const LAS float* q = scr + (8 * c) * 33 + n;
        u32x4 o; o.x = cvt_pk_bf16(q[0 * 33], q[1 * 33]); o.y = cvt_pk_bf16(q[2 * 33], q[3 * 33]); o.z = cvt_pk_bf16(q[4 * 33], q[5 * 33]); o.w = cvt_pk_bf16(q[6 * 33], q[7 * 33]);
        *(u32x4*)(it.dst + (size_t)n * it.ldt + 8 * c) = o; }
    LDS_WAIT(); __builtin_amdgcn_wave_barrier();
}
__device__ __forceinline__ void rms_row_to_bf16(const float* xrow, const float* g, bf16_t* orow, int lane) {
    const f32x4* xr = (const f32x4*)xrow + lane; const f32x4* gr = (const f32x4*)g + lane;
    f32x4 v[8]; float s = 0.f;
#pragma unroll
    for (int j = 0; j < 8; ++j) { v[j] = xr[64 * j]; s += (v[j][0] * v[j][0] + v[j][1] * v[j][1]) + (v[j][2] * v[j][2] + v[j][3] * v[j][3]); }
    const float rstd = rsqrtf(wave_sum(s) * (1.0f / D) + EPS);
    u32x2* o8 = (u32x2*)orow + lane;
#pragma unroll
    for (int j = 0; j < 8; ++j) { const f32x4 gg = gr[64 * j]; u32x2 w; w.x = cvt_pk_bf16(v[j][0] * rstd * gg[0], v[j][1] * rstd * gg[1]); w.y = cvt_pk_bf16(v[j][2] * rstd * gg[2], v[j][3] * rstd * gg[3]); o8[64 * j] = w; }
}
__device__ __forceinline__ void cmul(float ar, float ai, float br, float bi, float& cr, float& ci) { cr = ar * br - ai * bi; ci = ar * bi + ai * br; }

__device__ __forceinline__ void ssm_chan(const float* lam_re, const float* lam_im, float delta, int g, int ch, float& ar, float& ai, float& kr, float& ki) {
    const float lr = lam_re[g * 64 + ch], li = lam_im[g * 64 + ch];
    const float mag = expf(lr * delta);
    double rev = (double)li * (double)delta * 0.15915494309189535; rev -= __builtin_rint(rev);
    const float rv = (float)rev;
    ar = mag * __builtin_amdgcn_cosf(rv); ai = mag * __builtin_amdgcn_sinf(rv);
    const float nr = ar - 1.0f, ni = ai, den = 1.0f / (lr * lr + li * li);
    kr = (nr * lr + ni * li) * den; ki = (ni * lr - nr * li) * den;
}

__device__ __forceinline__ void ssm_tables(const Args& A, int g, int lane) {
    const float* lam_re = A.in[I_LRE]; const float* lam_im = A.in[I_LIM]; const float* log_step = A.in[I_LSTEP];
    const float* b_re = A.in[I_BRE]; const float* b_im = A.in[I_BIM]; const float* c_re = A.in[I_CRE]; const float* c_im = A.in[I_CIM];
    float* ABAR = (float*)(A.ws + O_ABAR); bf16_t* BB = (bf16_t*)(A.ws + O_BB); bf16_t* CM = (bf16_t*)(A.ws + O_CM);
    const float delta = expf(log_step[g]);
    {
        float ar, ai, kr, ki; ssm_chan(lam_re, lam_im, delta, g, lane, ar, ai, kr, ki);
        float pr = ar, pi = ai;
#pragma unroll
        for (int s = 0; s < 7; ++s) { float tr, ti; cmul(pr, pi, pr, pi, tr, ti); pr = tr; pi = ti; }
        *(f32x4*)(ABAR + ((size_t)g * 64 + lane) * 4) = (f32x4){ar, ai, pr, pi};
    }
    {
        const int j = lane & 31, hi = lane >> 5;
#pragma unroll
        for (int half = 0; half < 2; ++half) {
            const int ch = j + 32 * half; float ar, ai, kr, ki; ssm_chan(lam_re, lam_im, delta, g, ch, ar, ai, kr, ki);
            float vr[8], vi[8];
#pragma unroll
            for (int i = 0; i < 8; ++i) { const int c = 8 * hi + i; const float br = b_re[((size_t)g * 64 + ch) * 16 + c], bi = b_im[((size_t)g * 64 + ch) * 16 + c]; cmul(kr, ki, br, bi, vr[i], vi[i]); }
            u32x4 wr_, wi_;
            wr_.x = cvt_pk_bf16(vr[0], vr[1]); wr_.y = cvt_pk_bf16(vr[2], vr[3]); wr_.z = cvt_pk_bf16(vr[4], vr[5]); wr_.w = cvt_pk_bf16(vr[6], vr[7]);
            wi_.x = cvt_pk_bf16(vi[0], vi[1]); wi_.y = cvt_pk_bf16(vi[2], vi[3]); wi_.z = cvt_pk_bf16(vi[4], vi[5]); wi_.w = cvt_pk_bf16(vi[6], vi[7]);
            *(u32x4*)(BB + (((size_t)g * 4 + half) * 64 + lane) * 8) = wr_;
            *(u32x4*)(BB + (((size_t)g * 4 + 2 + half) * 64 + lane) * 8) = wi_;
        }
    }
    {
        const int c = lane & 15, fq = lane >> 4;
#pragma unroll
        for (int ks = 0; ks < 4; ++ks) {
            float v[8];
#pragma unroll
            for (int i = 0; i < 8; ++i) { const int k = 32 * ks + 8 * fq + i, jj = k >> 2, sel = k & 3, ch = jj + 32 * (sel >> 1);
                v[i] = (sel & 1) ? -c_im[((size_t)g * 16 + c) * 64 + ch] : c_re[((size_t)g * 16 + c) * 64 + ch]; }
            u32x4 w; w.x = cvt_pk_bf16(v[0], v[1]); w.y = cvt_pk_bf16(v[2], v[3]); w.z = cvt_pk_bf16(v[4], v[5]); w.w = cvt_pk_bf16(v[6], v[7]);
            *(u32x4*)(CM + (((size_t)g * 4 + ks) * 64 + lane) * 8) = w;
        }
    }
}

constexpr int I_SQ = (D / 64) * (D / 32);
constexpr int I_POOL = 4 * (256 / 64) * (256 / 32);
constexpr int I_GLU = (1024 / 64) * (1024 / 32);
constexpr int I_FF = (D / 64) * (FF / 32);
constexpr int I_DN = (FF / 64) * (D / 32);
constexpr int NITEMS = 6 * I_SQ + I_POOL + I_GLU + 2 * I_FF + I_DN, NEARLY = 3 * I_SQ, NP9 = 2560;
__device__ __forceinline__ CvItem cv_decode(const Args& A, int r) {
    unsigned char* ws = A.ws; CvItem it; it.gk = nullptr; it.sc = 1.f;
    const float* W; bf16_t* WT; int N, ldt, k0, n0, row0; const float* gkb = nullptr;
    if (r < 6 * I_SQ) {
        const int mtx = r / I_SQ; r -= mtx * I_SQ; const int kb = r / (D / 32), nb = r % (D / 32);
        N = D; ldt = D; k0 = 64 * kb; n0 = 32 * nb; row0 = n0;
        switch (mtx) {
            case 0: W = A.in[I_WIN]; WT = (bf16_t*)(ws + O_WIN); break;
            case 1: W = A.in[I_WK]; WT = (bf16_t*)(ws + O_WKV); break;
            case 2: W = A.in[I_WV]; WT = (bf16_t*)(ws + O_WKV); row0 += D; break;
            case 3: W = A.in[I_WOUT]; WT = (bf16_t*)(ws + O_WOUT); break;
            case 4: W = A.in[I_WQ]; WT = (bf16_t*)(ws + O_WQ); gkb = A.in[I_GCROSS]; it.sc = 0.04419417382415922f; break;
            default: W = A.in[I_WO]; WT = (bf16_t*)(ws + O_WO); break;
        }
    } else if ((r -= 6 * I_SQ) < I_POOL) {
        const int gg = r / 32, q = r % 32, kb = q / 8, nb = q % 8;
        W = A.in[I_WPOOL] + (size_t)gg * 65536; WT = (bf16_t*)(ws + O_WPOOL); N = 256; ldt = 256; k0 = 64 * kb; n0 = 32 * nb; row0 = gg * 256 + n0;
    } else if ((r -= I_POOL) < I_GLU) {
        const int kb = r / 32, nb = r % 32; W = A.in[I_WGLU]; WT = (bf16_t*)(ws + O_WGLU); N = 1024; ldt = 1024; k0 = 64 * kb; n0 = 32 * nb; row0 = n0;
    } else if ((r -= I_GLU) < 2 * I_FF) {
        const int up = r / I_FF; r -= up * I_FF; const int kb = r / (FF / 32), nb = r % (FF / 32);
        W = up ? A.in[I_WUP] : A.in[I_WGATE]; WT = (bf16_t*)(ws + O_WGU); N = FF; ldt = D; k0 = 64 * kb; n0 = 32 * nb; row0 = (n0 >> 7) * 256 + up * 128 + (n0 & 127); gkb = A.in[I_GFFN];
    } else {
        r -= 2 * I_FF; const int kb = r / (D / 32), nb = r % (D / 32);
        W = A.in[I_WDOWN]; WT = (bf16_t*)(ws + O_WDN); N = D; ldt = FF; k0 = 64 * kb; n0 = 32 * nb; row0 = n0;
    }
    it.src = W + (size_t)k0 * N + n0; it.dst = WT + (size_t)row0 * ldt + k0; it.gk = gkb ? gkb + k0 : nullptr; it.N = N; it.ldt = ldt;
    return it;
}
__device__ __forceinline__ void convert_weights(const Args& A, LAS unsigned char* lds, int lo, int hi, int gw, int NGW, const int wv) {
    const int tid = opaque_tid(wv), lane = tid & 63, wave = __builtin_amdgcn_readfirstlane(tid >> 6);
    LAS float* scr = (LAS float*)(lds + wave * 16384);
    if (gw < 0) return;
    int it = lo + gw; if (it >= hi) return;
    CvItem cur = cv_decode(A, it); f32x4 va[8]; float ga[8]; cv_load(cur, va, ga, lane);
    for (;;) {
        const int nit = it + NGW; const bool hn = nit < hi;
        CvItem nx = cur; f32x4 vb[8]; float gb[8];
        if (hn) { nx = cv_decode(A, nit); cv_load(nx, vb, gb, lane); }
        cv_finish(cur, va, ga, scr, lane);
        if (!hn) break;
        cur = nx; it = nit;
#pragma unroll
        for (int i = 0; i < 8; ++i) { va[i] = vb[i]; ga[i] = gb[i]; }
    }
}
__device__ __forceinline__ const float* p0_src(const Args& A, int m) { return m < MP ? A.in[I_XP] + (size_t)m * D : (m < M ? A.in[I_XS] + (size_t)(m - MP) * D : A.in[I_MEM] + (size_t)(m - M) * D); }
__device__ __forceinline__ void phase0_rest(const Args& A, int G, const int wv) {
    const int tid = opaque_tid(wv), lane = tid & 63, wave = __builtin_amdgcn_readfirstlane(tid >> 6);
    const int gw = blockIdx.x * 8 + wave, NGW = G * 8;
    unsigned char* ws = A.ws;
    {
        int m = gw;
        if (m < M + 1024) {
            f32x4 v[8];
            { const f32x4* xr = (const f32x4*)p0_src(A, m) + lane;
#pragma unroll
              for (int jj = 0; jj < 8; ++jj) v[jj] = xr[64 * jj]; }
            for (;;) {
                const int nm = m + NGW; const bool hn = nm < M + 1024;
                f32x4 nv[8];
                if (hn) { const f32x4* xr = (const f32x4*)p0_src(A, nm) + lane;
#pragma unroll
                    for (int jj = 0; jj < 8; ++jj) nv[jj] = xr[64 * jj]; }
                float sq = 0.f;
#pragma unroll
                for (int jj = 0; jj < 8; ++jj) sq += (v[jj][0] * v[jj][0] + v[jj][1] * v[jj][1]) + (v[jj][2] * v[jj][2] + v[jj][3] * v[jj][3]);
                const float rstd = rsqrtf(wave_sum(sq) * (1.0f / D) + EPS);
                const f32x4* gr = (const f32x4*)(m < M ? A.in[I_GMIX] : A.in[I_GMEM]) + lane;
                u32x2* o8 = (u32x2*)(m < M ? (bf16_t*)(ws + O_HMIX) + (size_t)m * D : (bf16_t*)(ws + O_MN) + (size_t)(m - M) * D) + lane;
#pragma unroll
                for (int jj = 0; jj < 8; ++jj) { const f32x4 gg = gr[64 * jj]; u32x2 wq; wq.x = cvt_pk_bf16(v[jj][0] * rstd * gg[0], v[jj][1] * rstd * gg[1]); wq.y = cvt_pk_bf16(v[jj][2] * rstd * gg[2], v[jj][3] * rstd * gg[3]); o8[64 * jj] = wq; }
                if (!hn) break;
#pragma unroll
                for (int jj = 0; jj < 8; ++jj) v[jj] = nv[jj];
                m = nm;
            }
        }
    }
    for (int g = gw; g < NG; g += NGW) ssm_tables(A, g, lane);
    {
        const f32x4* src = (const f32x4*)A.in[I_PBUF]; f32x4* dst = (f32x4*)(A.out + OUT_PBS);
        const int total = DB * 11 * (PW / 4);
        for (int i = blockIdx.x * 512 + tid; i < total; i += G * 512) { const int b = i / (11 * 256), r = i % (11 * 256); dst[(size_t)b * (15 * 256) + r] = src[(size_t)b * (15 * 256) + 4 * 256 + r]; }
    }
}

__device__ __forceinline__ void acc8(float (&s)[8], u32x4 w) {
    s[0] += bf_lo(w.x); s[1] += bf_hi(w.x); s[2] += bf_lo(w.y); s[3] += bf_hi(w.y); s[4] += bf_lo(w.z); s[5] += bf_hi(w.z); s[6] += bf_lo(w.w); s[7] += bf_hi(w.w);
}
template <int W>
__device__ __forceinline__ void pooled_prompt_item(const bf16_t* P, bf16_t* PO, int row0, int col) {
    const int t0 = row0 & (SEQ - 1);
    u32x4 z[W + 7];
#pragma unroll
    for (int i = 0; i < W + 7; ++i) {
        const int t = t0 - (W - 1) + i;
        z[i] = (u32x4){0u, 0u, 0u, 0u};
        if (t >= 0) z[i] = *(const u32x4*)(P + (size_t)(row0 - (W - 1) + i) * D + col);
    }
    float s[8] = {0.f, 0.f, 0.f, 0.f, 0.f, 0.f, 0.f, 0.f};
#pragma unroll
    for (int i = 0; i < W - 1; ++i) acc8(s, z[i]);
#pragma unroll
    for (int o = 0; o < 8; ++o) {
        const u32x4 uw = z[o + W - 1];
        acc8(s, uw);
        const int n = (t0 + o + 1 < W) ? t0 + o + 1 : W; const float ic = 1.0f / (float)n;
        u32x4 ow;
        ow.x = cvt_pk_bf16(s[0] * ic - bf_lo(uw.x), s[1] * ic - bf_hi(uw.x)); ow.y = cvt_pk_bf16(s[2] * ic - bf_lo(uw.y), s[3] * ic - bf_hi(uw.y));
        ow.z = cvt_pk_bf16(s[4] * ic - bf_lo(uw.z), s[5] * ic - bf_hi(uw.z)); ow.w = cvt_pk_bf16(s[6] * ic - bf_lo(uw.w), s[7] * ic - bf_hi(uw.w));
        *(u32x4*)(PO + (size_t)(row0 + o) * 1024 + col) = ow;
        const u32x4 zo = z[o];
        s[0] -= bf_lo(zo.x); s[1] -= bf_hi(zo.x); s[2] -= bf_lo(zo.y); s[3] -= bf_hi(zo.y); s[4] -= bf_lo(zo.z); s[5] -= bf_hi(zo.z); s[6] -= bf_lo(zo.w); s[7] -= bf_hi(zo.w);
    }
}
template <int W>
__device__ __forceinline__ void pooled_sample_item(const bf16_t* P, bf16_t* PO, const float* sbuf, int b, int col) {
    float h[W - 1][8];
#pragma unroll
    for (int i = 0; i < W - 1; ++i) { const float* q = sbuf + ((size_t)b * PBUF + (PBUF - (W - 1) + i)) * PW + col; const f32x4 a = *(const f32x4*)q, c = *(const f32x4*)(q + 4);
        h[i][0] = a[0]; h[i][1] = a[1]; h[i][2] = a[2]; h[i][3] = a[3]; h[i][4] = c[0]; h[i][5] = c[1]; h[i][6] = c[2]; h[i][7] = c[3]; }
    u32x4 z[4];
#pragma unroll
    for (int t = 0; t < 4; ++t) z[t] = *(const u32x4*)(P + ((size_t)MP + b * 4 + t) * D + col);
    float s[8] = {0.f, 0.f, 0.f, 0.f, 0.f, 0.f, 0.f, 0.f};
#pragma unroll
    for (int i = 0; i < W - 1; ++i)
#pragma unroll
        for (int j = 0; j < 8; ++j) s[j] += h[i][j];
    const float ic = 1.0f / (float)W;
#pragma unroll
    for (int t = 0; t < 4; ++t) {
        const u32x4 uw = z[t];
        acc8(s, uw);
        u32x4 o;
        o.x = cvt_pk_bf16(s[0] * ic - bf_lo(uw.x), s[1] * ic - bf_hi(uw.x)); o.y = cvt_pk_bf16(s[2] * ic - bf_lo(uw.y), s[3] * ic - bf_hi(uw.y));
        o.z = cvt_pk_bf16(s[4] * ic - bf_lo(uw.z), s[5] * ic - bf_hi(uw.z)); o.w = cvt_pk_bf16(s[6] * ic - bf_lo(uw.w), s[7] * ic - bf_hi(uw.w));
        *(u32x4*)(PO + ((size_t)MP + b * 4 + t) * 1024 + col) = o;
        if (t < W - 1) {
#pragma unroll
            for (int j = 0; j < 8; ++j) s[j] -= h[t < W - 1 ? t : 0][j];
        } else {
            const u32x4 zo = z[t - (W - 1) >= 0 ? t - (W - 1) : 0];
            s[0] -= bf_lo(zo.x); s[1] -= bf_hi(zo.x); s[2] -= bf_lo(zo.y); s[3] -= bf_hi(zo.y); s[4] -= bf_lo(zo.z); s[5] -= bf_hi(zo.z); s[6] -= bf_lo(zo.w); s[7] -= bf_hi(zo.w);
        }
    }
}
__device__ __forceinline__ void pooled_phase(const Args& A, int G, const int wv) {
    const bf16_t* P = (const bf16_t*)(A.ws + O_P); bf16_t* PO = (bf16_t*)(A.ws + O_POOLED); const float* sbuf = A.in[I_PBUF];
    const int tid0 = blockIdx.x * 512 + opaque_tid(wv);
    for (int it = tid0; it < 4 * 1024 * 32; it += G * 512) {
        const int g = it >> 15, rb = (it >> 5) & 1023, col = g * 256 + (it & 31) * 8, row0 = rb * 8;
        if (g == 0) pooled_prompt_item<2>(P, PO, row0, col); else if (g == 1) pooled_prompt_item<4>(P, PO, row0, col);
        else if (g == 2) pooled_prompt_item<8>(P, PO, row0, col); else pooled_prompt_item<16>(P, PO, row0, col);
    }
    for (int it = tid0; it < 4 * DB * 32; it += G * 512) {
        const int g = it >> 12, b = (it >> 5) & (DB - 1), col = g * 256 + (it & 31) * 8;
        if (g == 0) pooled_sample_item<2>(P, PO, sbuf, b, col); else if (g == 1) pooled_sample_item<4>(P, PO, sbuf, b, col);
        else if (g == 2) pooled_sample_item<8>(P, PO, sbuf, b, col); else pooled_sample_item<16>(P, PO, sbuf, b, col);
    }
}

struct SsmCtx {
    bf16x8 BB[4], CMf[4];
    float a[4];
    float dsk[4];
    float s[4];
};
template <int MODE>
__device__ __forceinline__ void ssm_sub(SsmCtx& cx, const bf16_t* P, bf16_t* Gout, int g, const bf16x8 af  ,
                                        const size_t (&yrow)[2]  , LAS unsigned char* tile, int lane,
                                        const float* h_re, const float* h_im, float* o_re, float* o_im, int sbatch0  ) {
    const int j = lane & 31, hi = lane >> 5, fr = lane & 15, fq = lane >> 4;
    u32x2 uwp[2] = {(u32x2){0u, 0u}, (u32x2){0u, 0u}};
    if (MODE != 0) { uwp[0] = *(const u32x2*)(P + yrow[0] * D + 1024 + 16 * g + 4 * fq); uwp[1] = *(const u32x2*)(P + yrow[1] * D + 1024 + 16 * g + 4 * fq); }
    float hs[4][4];
    if (MODE == 2) {
#pragma unroll
        for (int q = 0; q < 4; ++q) { const size_t o = ((size_t)(sbatch0 + q) * NG + g) * 64 + j; hs[q][0] = h_re[o]; hs[q][1] = h_im[o]; hs[q][2] = h_re[o + 32]; hs[q][3] = h_im[o + 32]; }
    }
    const f32x16 z = {0.f, 0.f, 0.f, 0.f, 0.f, 0.f, 0.f, 0.f, 0.f, 0.f, 0.f, 0.f, 0.f, 0.f, 0.f, 0.f};
    const f32x16 r0 = __builtin_amdgcn_mfma_f32_32x32x16_bf16(af, cx.BB[0], z, 0, 0, 0);
    const f32x16 r1 = __builtin_amdgcn_mfma_f32_32x32x16_bf16(af, cx.BB[1], z, 0, 0, 0);
    const f32x16 i0 = __builtin_amdgcn_mfma_f32_32x32x16_bf16(af, cx.BB[2], z, 0, 0, 0);
    const f32x16 i1 = __builtin_amdgcn_mfma_f32_32x32x16_bf16(af, cx.BB[3], z, 0, 0, 0);
    float sr0 = cx.s[0], si0 = cx.s[1], sr1 = cx.s[2], si1 = cx.s[3];
    const float ar0 = cx.a[0], ai0 = cx.a[1], ar1 = cx.a[2], ai1 = cx.a[3];
#pragma unroll
    for (int r = 0; r < 16; ++r) {
        if (MODE == 2 && (r & 3) == 0) { sr0 = hs[r >> 2][0]; si0 = hs[r >> 2][1]; sr1 = hs[r >> 2][2]; si1 = hs[r >> 2][3]; }
        const float nr0 = fmaf(ar0, sr0, fmaf(-ai0, si0, r0[r])), ni0 = fmaf(ar0, si0, fmaf(ai0, sr0, i0[r]));
        const float nr1 = fmaf(ar1, sr1, fmaf(-ai1, si1, r1[r])), ni1 = fmaf(ar1, si1, fmaf(ai1, sr1, i1[r]));
        sr0 = nr0; si0 = ni0; sr1 = nr1; si1 = ni1;
        if (MODE != 0) { u32x2 w; w.x = cvt_pk_bf16(sr0, si0); w.y = cvt_pk_bf16(sr1, si1); *(LAS u32x2*)(tile + (16 * hi + r) * 272 + 8 * j) = w; }
        if (MODE == 2 && (r & 3) == 3) {
            const size_t o = ((size_t)(sbatch0 + (r >> 2)) * NG + g) * 64 + j;
            o_re[o] = sr0; o_im[o] = si0; o_re[o + 32] = sr1; o_im[o + 32] = si1;
        }
    }
    cx.s[0] = sr0; cx.s[1] = si0; cx.s[2] = sr1; cx.s[3] = si1;
    if (MODE != 0) {
        LDS_WAIT(); __builtin_amdgcn_wave_barrier();
#pragma unroll
        for (int tg = 0; tg < 2; ++tg) {
            f32x4 y = {0.f, 0.f, 0.f, 0.f};
#pragma unroll
            for (int ks = 0; ks < 4; ++ks) {
                const bf16x8 sf = *(const LAS bf16x8*)(tile + (16 * tg + fr) * 272 + (32 * ks + 8 * fq) * 2);
                y = __builtin_amdgcn_mfma_f32_16x16x32_bf16(cx.CMf[ks], sf, y, 0, 0, 0);
            }
            const u32x2 uw = uwp[tg];
            const float y0 = gelu_tanh(y[0] + cx.dsk[0] * bf_lo(uw.x)), y1 = gelu_tanh(y[1] + cx.dsk[1] * bf_hi(uw.x));
            const float y2 = gelu_tanh(y[2] + cx.dsk[2] * bf_lo(uw.y)), y3 = gelu_tanh(y[3] + cx.dsk[3] * bf_hi(uw.y));
            u32x2 o; o.x = cvt_pk_bf16(y0, y1); o.y = cvt_pk_bf16(y2, y3);
            *(u32x2*)(Gout + yrow[tg] * 1024 + 16 * g + 4 * fq) = o;
        }
    }
}

__device__ __forceinline__ void ssm_load_ctx(SsmCtx& cx, const Args& A, int g, int lane) {
    const bf16_t* BB = (const bf16_t*)(A.ws + O_BB); const bf16_t* CM = (const bf16_t*)(A.ws + O_CM); const float* ABAR = (const float*)(A.ws + O_ABAR);
    const int j = lane & 31, fq = lane >> 4;
#pragma unroll
    for (int i = 0; i < 4; ++i) { cx.BB[i] = *(const bf16x8*)(BB + (((size_t)g * 4 + i) * 64 + lane) * 8); cx.CMf[i] = *(const bf16x8*)(CM + (((size_t)g * 4 + i) * 64 + lane) * 8); }
    const f32x4 a0 = *(const f32x4*)(ABAR + ((size_t)g * 64 + j) * 4), a1 = *(const f32x4*)(ABAR + ((size_t)g * 64 + j + 32) * 4);
    cx.a[0] = a0[0]; cx.a[1] = a0[1]; cx.a[2] = a1[0]; cx.a[3] = a1[1];
    const f32x4 dv = *(const f32x4*)(A.in[I_SSMD] + 16 * g + 4 * fq);
    cx.dsk[0] = dv[0]; cx.dsk[1] = dv[1]; cx.dsk[2] = dv[2]; cx.dsk[3] = dv[3];
}

__device__ __forceinline__ void ssm_phase(const Args& A, LAS unsigned char* lds, int G, const int wv) {
    const int tid = opaque_tid(wv), lane = tid & 63, w = __builtin_amdgcn_readfirstlane(tid >> 6);
    const int j = lane & 31, hi = lane >> 5, fr = lane & 15;
    const bf16_t* P = (const bf16_t*)(A.ws + O_P); bf16_t* Gout = (bf16_t*)(A.ws + O_G);
    const float* ABAR = (const float*)(A.ws + O_ABAR);
    LAS unsigned char* tile = lds + w * 8704;
    LAS f32x4* EL = (LAS f32x4*)(lds + 8 * 8704);
    const int arow_i = lane & 31, own = (arow_i >> 2) & 1, rloc = 4 * (arow_i >> 3) + (arow_i & 3);
    for (int un = blockIdx.x; un < NB * NG; un += G) {
        const int b = un >> 6, g = un & 63;
        SsmCtx cx; ssm_load_ctx(cx, A, g, lane);
        const f32x4 p0 = *(const f32x4*)(ABAR + ((size_t)g * 64 + j) * 4), p1 = *(const f32x4*)(ABAR + ((size_t)g * 64 + j + 32) * 4);
        const size_t rowb = (size_t)b * SEQ;
        size_t yrow[2];
        cx.s[0] = cx.s[1] = cx.s[2] = cx.s[3] = 0.f;
        const bf16_t* abase = P + (rowb + (2 * w + own) * 128 + rloc) * D + 1024 + 16 * g + 8 * hi;
        bf16x8 af = *(const bf16x8*)abase;
        for (int k = 0; k < 8; ++k) {
            const bf16x8 afn = *(const bf16x8*)(abase + (size_t)(16 * ((k + 1) & 7)) * D);
            yrow[0] = 0; yrow[1] = 0;
            ssm_sub<0>(cx, P, Gout, g, af, yrow, tile, lane, nullptr, nullptr, nullptr, nullptr, 0);
            af = afn;
        }
        EL[(2 * w + hi) * 32 + j] = (f32x4){cx.s[0], cx.s[1], cx.s[2], cx.s[3]};
        LDS_WAIT(); __syncthreads();
        {
            float sr0 = 0.f, si0 = 0.f, sr1 = 0.f, si1 = 0.f; const int wk = 2 * w + hi;
            for (int q = 0; q < 15; ++q) {
                if (q < wk) { const f32x4 e = EL[q * 32 + j]; float tr, ti;
                    cmul(p0[2], p0[3], sr0, si0, tr, ti); sr0 = tr + e[0]; si0 = ti + e[1];
                    cmul(p1[2], p1[3], sr1, si1, tr, ti); sr1 = tr + e[2]; si1 = ti + e[3]; }
            }
            cx.s[0] = sr0; cx.s[1] = si0; cx.s[2] = sr1; cx.s[3] = si1;
        }
        for (int k = 0; k < 8; ++k) {
            const bf16x8 afn = *(const bf16x8*)(abase + (size_t)(16 * ((k + 1) & 7)) * D);
            yrow[0] = rowb + (2 * w) * 128 + 16 * k + fr; yrow[1] = rowb + (2 * w + 1) * 128 + 16 * k + fr;
            ssm_sub<1>(cx, P, Gout, g, af, yrow, tile, lane, nullptr, nullptr, nullptr, nullptr, 0);
            af = afn;
        }
        if (w == 7 && hi == 1) {
            const size_t o = ((size_t)b * NG + g) * 64 + j;
            A.out[OUT_REP + o] = cx.s[0]; A.out[OUT_IMP + o] = cx.s[1]; A.out[OUT_REP + o + 32] = cx.s[2]; A.out[OUT_IMP + o + 32] = cx.s[3];
        }
        LDS_WAIT(); __syncthreads();
    }
    for (int un = (G == 256) ? (int)blockIdx.x - 128 : (int)blockIdx.x; un < 2 * NG; un += G) {
        if (un < 0) continue;
        const int g = un >> 1, bh = un & 1;
        SsmCtx cx; ssm_load_ctx(cx, A, g, lane);
        cx.s[0] = cx.s[1] = cx.s[2] = cx.s[3] = 0.f;
        const int bbase = bh * 64 + w * 8;
        const size_t arow = (size_t)MP + (size_t)(bbase + own * 4 + (arow_i >> 3)) * 4 + (arow_i & 3);
        size_t yrow[2];
        yrow[0] = (size_t)MP + (size_t)(bbase + (fr >> 2)) * 4 + (fr & 3); yrow[1] = (size_t)MP + (size_t)(bbase + 4 + (fr >> 2)) * 4 + (fr & 3);
        const bf16x8 af = *(const bf16x8*)(P + arow * D + 1024 + 16 * g + 8 * hi);
        ssm_sub<2>(cx, P, Gout, g, af, yrow, tile, lane, A.in[I_SRE], A.in[I_SIM], A.out + OUT_RES, A.out + OUT_IMS, bbase + hi * 4);
    }
}

template <int WPU>
__device__ __forceinline__ void sample_attn_units(const Args& A, LAS unsigned char* lds, int su0, const int wv) {
    constexpr int KPW = 256 / WPU, NB = KPW / 8, NKG = KPW / 16;
    const int tid = opaque_tid(wv), lane = tid & 63, w = __builtin_amdgcn_readfirstlane(tid >> 6), fr = lane & 15, fq = lane >> 4;
    const int su = su0 + (WPU == 4 ? (w >> 2) : 0), b = su >> 2, h = su & 3, kq = (WPU == 4) ? (w & 3) : w;
    const bf16_t* Q = (const bf16_t*)(A.ws + O_Q); bf16_t* ATT = (bf16_t*)(A.ws + O_ATT);
    const float* Kc = A.in[I_CK] + (((size_t)b * NMEM + KPW * kq) * NH + h) * HD;
    const float* Vc = A.in[I_CV] + (((size_t)b * NMEM + KPW * kq) * NH + h) * HD;
    LAS bf16_t* QSw = (LAS bf16_t*)(lds + w * 4096);
    LAS float* PLw = (LAS float*)(lds + 32768 + w * 1024);
    LAS float* ML = (LAS float*)(lds + 40960);
    LAS float* RED = (LAS float*)(lds + 49152);
#pragma unroll
    for (int t = 0; t < 4; ++t) *(LAS u32x4*)(QSw + t * 512 + lane * 8) = *(const u32x4*)(Q + ((size_t)MP + b * 4 + t) * D + h * HD + lane * 8);
    f32x4 ra[16], rb[16];
#define KLOAD(dst, bi) do { const float* kp_ = Kc + (size_t)(16 * ((bi) >> 1) + fr) * (NH * HD) + 4 * fq + 256 * ((bi) & 1); \
        _Pragma("unroll") for (int i = 0; i < 8; ++i) { dst[2 * i] = *(const f32x4*)(kp_ + 32 * i); dst[2 * i + 1] = *(const f32x4*)(kp_ + 32 * i + 16); } } while (0)
#define KUSE(src, bi) do { _Pragma("unroll") for (int i = 0; i < 8; ++i) { const int kd = 8 * ((bi) & 1) + i; const f32x4 k0 = src[2 * i], k1 = src[2 * i + 1]; \
        u32x4 kw; kw.x = cvt_pk_bf16(k0[0], k0[1]); kw.y = cvt_pk_bf16(k0[2], k0[3]); kw.z = cvt_pk_bf16(k1[0], k1[1]); kw.w = cvt_pk_bf16(k1[2], k1[3]); \
        u32x4 qw = {0u, 0u, 0u, 0u}; \
        if (fr < 4) { const u32x2 qa = *(const LAS u32x2*)(QSw + fr * 512 + 32 * kd + 4 * fq), qb = *(const LAS u32x2*)(QSw + fr * 512 + 32 * kd + 16 + 4 * fq); qw.x = qa.x; qw.y = qa.y; qw.z = qb.x; qw.w = qb.y; } \
        sc[(bi) >> 1] = __builtin_amdgcn_mfma_f32_16x16x32_bf16(__builtin_bit_cast(bf16x8, kw), __builtin_bit_cast(bf16x8, qw), sc[(bi) >> 1], 0, 0, 0); } } while (0)
#define VLOAD(dst, vb) do { const float* vp_ = Vc + (size_t)(8 * (vb)) * (NH * HD) + 4 * lane; \
        _Pragma("unroll") for (int k = 0; k < 8; ++k) { dst[2 * k] = __builtin_nontemporal_load((const f32x4*)(vp_ + (size_t)k * (NH * HD))); dst[2 * k + 1] = __builtin_nontemporal_load((const f32x4*)(vp_ + (size_t)k * (NH * HD) + 256)); } } while (0)
#define VUSE(src, vb) do { _Pragma("unroll") for (int k = 0; k < 8; ++k) { const f32x4 p = *(const LAS f32x4*)(PLw + (8 * (vb) + k) * 4); \
        _Pragma("unroll") for (int t = 0; t < 4; ++t) { o[t][0] += src[2 * k] * p[t]; o[t][1] += src[2 * k + 1] * p[t]; } } } while (0)
#define SB() __builtin_amdgcn_sched_barrier(0)
    KLOAD(ra, 0); KLOAD(rb, 1);
    LDS_WAIT(); __builtin_amdgcn_wave_barrier();
    f32x4 sc[NKG];
#pragma unroll
    for (int i = 0; i < NKG; ++i) sc[i] = (f32x4){0.f, 0.f, 0.f, 0.f};
    SB(); KUSE(ra, 0); SB(); KLOAD(ra, 2); SB(); KUSE(rb, 1); SB(); KLOAD(rb, 3); SB();
    if constexpr (NB == 8) {
        KUSE(ra, 2); SB(); KLOAD(ra, 4); SB(); KUSE(rb, 3); SB(); KLOAD(rb, 5); SB();
        KUSE(ra, 4); SB(); KLOAD(ra, 6); SB(); KUSE(rb, 5); SB(); KLOAD(rb, 7); SB();
        KUSE(ra, 6); SB(); VLOAD(ra, 0); SB(); KUSE(rb, 7); SB(); VLOAD(rb, 1); SB();
    } else {
        KUSE(ra, 2); SB(); VLOAD(ra, 0); SB(); KUSE(rb, 3); SB(); VLOAD(rb, 1); SB();
    }
    float mt = -3.0e38f;
#pragma unroll
    for (int kg = 0; kg < NKG; ++kg) mt = fmaxf(mt, fmaxf(fmaxf(sc[kg][0], sc[kg][1]), fmaxf(sc[kg][2], sc[kg][3])));
    mt = fmaxf(mt, __shfl_xor(mt, 16)); mt = fmaxf(mt, __shfl_xor(mt, 32));
    float lt = 0.f;
#pragma unroll
    for (int kg = 0; kg < NKG; ++kg)
#pragma unroll
        for (int r = 0; r < 4; ++r) { const float e = __expf(sc[kg][r] - mt); lt += e; if (fr < 4) PLw[(16 * kg + 4 * fq + r) * 4 + fr] = e; }
    lt += __shfl_xor(lt, 16); lt += __shfl_xor(lt, 32);
    if (fr < 4 && fq == 0) { ML[(w * 4 + fr) * 2] = mt; ML[(w * 4 + fr) * 2 + 1] = lt; }
    LDS_WAIT(); __builtin_amdgcn_wave_barrier();
    f32x4 o[4][2];
#pragma unroll
    for (int t = 0; t < 4; ++t) { o[t][0] = (f32x4){0.f, 0.f, 0.f, 0.f}; o[t][1] = (f32x4){0.f, 0.f, 0.f, 0.f}; }
    SB(); VUSE(ra, 0); SB(); VLOAD(ra, 2); SB(); VUSE(rb, 1); SB(); VLOAD(rb, 3); SB();
    if constexpr (NB == 8) {
        VUSE(ra, 2); SB(); VLOAD(ra, 4); SB(); VUSE(rb, 3); SB(); VLOAD(rb, 5); SB();
        VUSE(ra, 4); SB(); VLOAD(ra, 6); SB(); VUSE(rb, 5); SB(); VLOAD(rb, 7); SB();
        VUSE(ra, 6); SB(); VUSE(rb, 7);
    } else {
        VUSE(ra, 2); SB(); VUSE(rb, 3);
    }
#undef KLOAD
#undef KUSE
#undef VLOAD
#undef VUSE
#undef SB
#pragma unroll
    for (int t = 0; t < 4; ++t) { *(LAS f32x4*)(RED + (w * 4 + t) * 512 + 4 * lane) = o[t][0]; *(LAS f32x4*)(RED + (w * 4 + t) * 512 + 256 + 4 * lane) = o[t][1]; }
    LDS_WAIT(); __syncthreads();
    if constexpr (WPU == 4) {
        const int uh = tid >> 8, t = (tid >> 6) & 3, c = (tid & 63) * 8;
        float m4[4], l4[4], Mx = -3.0e38f;
#pragma unroll
        for (int q = 0; q < 4; ++q) { m4[q] = ML[((uh * 4 + q) * 4 + t) * 2]; l4[q] = ML[((uh * 4 + q) * 4 + t) * 2 + 1]; Mx = fmaxf(Mx, m4[q]); }
        f32x4 s0 = {0.f, 0.f, 0.f, 0.f}, s1 = {0.f, 0.f, 0.f, 0.f}; float L = 0.f;
#pragma unroll
        for (int q = 0; q < 4; ++q) { const float f = __expf(m4[q] - Mx); L += l4[q] * f;
            s0 += *(const LAS f32x4*)(RED + ((uh * 4 + q) * 4 + t) * 512 + c) * f; s1 += *(const LAS f32x4*)(RED + ((uh * 4 + q) * 4 + t) * 512 + c + 4) * f; }
        const float iv = 1.0f / L; const int su2 = su0 + uh, b2 = su2 >> 2, h2 = su2 & 3;
        pg8::st_bf16x8(ATT + ((size_t)MP + b2 * 4 + t) * D + h2 * HD + c, s0 * iv, s1 * iv);
    } else {
        const int t = tid >> 7, c = (tid & 127) * 4;
        float m8[8], l8[8], Mx = -3.0e38f;
#pragma unroll
        for (int q = 0; q < 8; ++q) { m8[q] = ML[(q * 4 + t) * 2]; l8[q] = ML[(q * 4 + t) * 2 + 1]; Mx = fmaxf(Mx, m8[q]); }
        f32x4 s0 = {0.f, 0.f, 0.f, 0.f}; float L = 0.f;
#pragma unroll
        for (int q = 0; q < 8; ++q) { const float f = __expf(m8[q] - Mx); L += l8[q] * f; s0 += *(const LAS f32x4*)(RED + (q * 4 + t) * 512 + c) * f; }
        const float iv = 1.0f / L; const int b2 = su0 >> 2, h2 = su0 & 3;
        pg8::st_bf16x4(ATT + ((size_t)MP + b2 * 4 + t) * D + h2 * HD + c, s0 * iv);
    }
    LDS_WAIT(); __syncthreads();
}

constexpr int MTP = MP / 256;
struct SchedGrid {
    int G, c, nM, nN; const char* A; const char* B; size_t ta, tb; const char* Sb; size_t ts;
    __device__ __forceinline__ bool next(int i, Unit& u) const {
        const int L = i * G + c; if (L >= nM * nN) return false;
        u.pm = L % nM; u.pn = L / nM; u.job = 0; u.a = A + (size_t)u.pm * ta; u.b = B + (size_t)u.pn * tb; u.s = Sb + (size_t)u.pm * ts; u.srow = MP + 16 * u.pm; return true;
    }
};
struct Sched1 {
    int G, c; const char* hmix; const char* win; const char* mn; const char* wkv;
    __device__ __forceinline__ bool next(int i, Unit& u) const {
        int L = i * G + c; u.srow = -1;
        if (L < MTP * 8) { u.job = 0; u.pm = L % MTP; u.pn = L / MTP; u.a = hmix + (size_t)u.pm * 256 * D * 2; u.b = win + (size_t)u.pn * 256 * D * 2; u.s = u.a; return true; }
        L -= MTP * 8;
        if (L < 64) { u.job = 1; u.pm = L & 3; u.pn = L >> 2; u.a = mn + (size_t)u.pm * 256 * D * 2; u.b = wkv + (size_t)u.pn * 256 * D * 2; u.s = u.a; return true; }
        L -= 64;
        if (L < 16) { u.job = 0; u.pm = MTP + (L & 1); u.pn = L >> 1; u.a = hmix + (size_t)u.pm * 256 * D * 2; u.b = win + (size_t)u.pn * 256 * D * 2; u.s = u.a; return true; }
        return false;
    }
};
struct SchedGU {
    int G, c; const char* A; const char* B;
    __device__ __forceinline__ bool next(int i, Unit& u) const {
        const int L = i * G + c;
        if (L < MTP * 44) { u.pm = L % MTP; u.pn = L / MTP; }
        else if (L < (MTP + 2) * 44) { const int r = L - MTP * 44; u.pm = MTP + (r & 1); u.pn = r >> 1; }
        else return false;
        u.job = 0; u.a = A + (size_t)u.pm * 256 * D * 2; u.b = B + (size_t)u.pn * 256 * D * 2; u.s = u.a; u.srow = -1; return true;
    }
};
struct SchedPool {
    int G, c; const char* pooled; const char* wp;
    __device__ __forceinline__ bool next(int i, Unit& u) const {
        const int L = i * G + c; if (L >= MTP * 4) return false;
        u.job = 0; u.pm = L % MTP; u.pn = L / MTP; u.a = pooled + ((size_t)u.pm * 256 * 1024 + u.pn * 256) * 2; u.b = wp + (size_t)u.pn * 256 * 256 * 2;
        u.s = pooled + (((size_t)MP + 16 * u.pm) * 1024 + u.pn * 256) * 2; u.srow = MP + 16 * u.pm; return true;
    }
};
struct SchedScores {
    int c; const char* Q; const char* KB;
    __device__ __forceinline__ bool next(int i, Unit& u) const {
        if (i > 0 || c >= 128) return false;
        const int bh = c >> 3, qb = c & 7, b = bh >> 2, h = bh & 3;
        u.job = bh; u.pm = qb; u.pn = 0; u.a = Q + (((size_t)b * SEQ + qb * 256) * D + h * HD) * 2; u.b = KB + ((size_t)b * NMEM * D + h * HD) * 2; u.s = u.a; u.srow = -1; return true;
    }
};
struct SchedPVown {
    int c; const char* PR; const char* VT;
    __device__ __forceinline__ bool next(int i, Unit& u) const {
        if (i > 1 || c >= 128) return false;
        const int bh = c >> 3, qb = c & 7, pn = i, b = bh >> 2, h = bh & 3;
        u.job = 0; u.pm = b * 8 + qb; u.pn = h * 2 + pn;
        u.a = PR + ((size_t)bh * SEQ + qb * 256) * 256 * 2; u.b = VT + (((size_t)h * HD + pn * 256) * 1024 + b * 256) * 2; u.s = u.a; u.srow = -1; return true;
    }
};
struct SchedPV {
    int G, c; const char* PR; const char* VT;
    __device__ __forceinline__ bool next(int i, Unit& u) const {
        const int L = i * G + c; if (L >= 256) return false;
        const int bh = L >> 4, rem = L & 15, qb = rem >> 1, pn = rem & 1, b = bh >> 2, h = bh & 3;
        u.job = 0; u.pm = b * 8 + qb; u.pn = h * 2 + pn;
        u.a = PR + ((size_t)bh * SEQ + qb * 256) * 256 * 2; u.b = VT + (((size_t)h * HD + pn * 256) * 1024 + b * 256) * 2; u.s = u.a; u.srow = -1; return true;
    }
};


#define XB_TMO      128
#define XB_XCNT(j)  (256  + 64 * (j))
#define XB_XSUB(j)  (1280 + 64 * (j))
#define XB_XGEN(j)  (2304 + 64 * (j))
#define XB_TOP      3328
#define XB_TOPGEN   3392
#define XCD_BAR_WORDS 3456
#define XB_SPIN_CAP (1u << 18)
__device__ __forceinline__ unsigned xb_ld(unsigned* p)              { return __hip_atomic_load(p, __ATOMIC_RELAXED, __HIP_MEMORY_SCOPE_AGENT); }
__device__ __forceinline__ unsigned xb_add(unsigned* p, unsigned v) { return __hip_atomic_fetch_add(p, v, __ATOMIC_RELAXED, __HIP_MEMORY_SCOPE_AGENT); }
__device__ __forceinline__ unsigned xb_xcc_id() { return (unsigned)__builtin_amdgcn_s_getreg((3 << 11) | 20) & 0xFu; }
#define XB_SPIN(cond, bar) do { unsigned _sp = 0; while (cond) { __builtin_amdgcn_s_sleep(1); \
    if ((++_sp & 255u) == 0u) { if (xb_ld(&(bar)[XB_TMO])) break; if (_sp > XB_SPIN_CAP) { atomicAdd(&(bar)[XB_TMO], 1u); break; } } } } while (0)
struct XcdBarrier { unsigned* bar; unsigned x; volatile LAS unsigned* st; };
__device__ __forceinline__ XcdBarrier xcd_barrier_post(unsigned* bar, volatile LAS unsigned* st) {
    XcdBarrier b; b.bar = bar; b.x = xb_xcc_id(); b.st = st;
    if (threadIdx.x == 0) (void)xb_add(&bar[XB_XCNT(b.x)], 1u);
    return b;
}
__device__ __forceinline__ void xcd_barrier_complete(unsigned* bar, unsigned x, unsigned& nloc, unsigned& nx) {
    const unsigned G = gridDim.x * gridDim.y * gridDim.z;
    unsigned sum, cnt, mine, sp = 0u;
    for (;;) {
        sum = 0u; cnt = 0u; mine = 0u;
#pragma unroll
        for (unsigned j = 0; j < 16; ++j) { const unsigned c = xb_ld(&bar[XB_XCNT(j)]); sum += c; cnt += (c > 0u) ? 1u : 0u; mine = (j == x) ? c : mine; }
        if (sum == G) break;
        __builtin_amdgcn_s_sleep(1);
        if ((++sp & 255u) == 0u) { if (xb_ld(&bar[XB_TMO])) break; if (sp > XB_SPIN_CAP) { atomicAdd(&bar[XB_TMO], 1u); break; } }
    }
    nloc = mine > 0u ? mine : 1u; nx = cnt > 0u ? cnt : 1u;
}
__device__ __forceinline__ void xcd_barrier(const XcdBarrier& b, const int wv) {
    asm volatile("s_waitcnt vmcnt(0)" ::: "memory");
    __syncthreads();
    if (opaque_tid(wv) == 0) {
        unsigned* bar = b.bar;
        __builtin_amdgcn_s_waitcnt(0);
        unsigned nloc = b.st[0], nx = b.st[1];
        if (nloc == 0u) { xcd_barrier_complete(bar, b.x, nloc, nx); b.st[0] = nloc; b.st[1] = nx; }
        const unsigned old = xb_add(&bar[XB_XSUB(b.x)], 1u);
        const unsigned gen = old / nloc;
        if (old + 1u == (gen + 1u) * nloc) {
            __builtin_amdgcn_fence(__ATOMIC_RELEASE, "agent");
            asm volatile("s_waitcnt vmcnt(0)" ::: "memory");
            __builtin_amdgcn_fence(__ATOMIC_RELEASE, "agent");
            asm volatile("s_waitcnt vmcnt(0)" ::: "memory");
            const unsigned og = xb_add(&bar[XB_TOP], 1u);
            const unsigned tg = og / nx;
            if (og + 1u == (tg + 1u) * nx) xb_add(&bar[XB_TOPGEN], 1u);
            else XB_SPIN(xb_ld(&bar[XB_TOPGEN]) == tg, bar);
            __builtin_amdgcn_fence(__ATOMIC_ACQUIRE, "agent");
            xb_add(&bar[XB_XGEN(b.x)], 1u);
            asm volatile("s_waitcnt vmcnt(0)" ::: "memory");
        } else {
            XB_SPIN(xb_ld(&bar[XB_XGEN(b.x)]) == gen, bar);
            __builtin_amdgcn_fence(__ATOMIC_ACQUIRE, "agent");
            asm volatile("s_waitcnt vmcnt(0)" ::: "memory");
        }
    }
    __syncthreads();
}

#ifndef REP_PHASE
#define REP_PHASE -1
#endif
#define REPEAT(k) for (int rep_ = 0; rep_ < ((REP_PHASE == (k)) ? 2 : 1); ++rep_)
__global__ void __launch_bounds__(512, 2) hymba_fwd(Args A) {
    extern __shared__ __attribute__((aligned(16))) unsigned char lds_raw[];
    LAS unsigned char* lds = (LAS unsigned char*)lds_raw;
    cg::grid_group grid = cg::this_grid();
    const int G = gridDim.x, c = blockIdx.x, wv = __builtin_amdgcn_readfirstlane((int)threadIdx.x >> 6);
    unsigned char* ws = A.ws;
    float* SS1 = (float*)(ws + O_SS1); float* SS2 = (float*)(ws + O_SS2); float* SS3 = (float*)(ws + O_SS3); float* SSD = (float*)(ws + O_BAR + 16384);
    volatile LAS unsigned* bst = (volatile LAS unsigned*)(lds + RING_BYTES + 8192);
    if (threadIdx.x < 4) bst[threadIdx.x] = 0u;
    __syncthreads();
    const XcdBarrier xbar = xcd_barrier_post((unsigned*)(ws + O_BAR), bst);
#define SEAM() xcd_barrier(xbar, wv)

    REPEAT(0) {
    {
        convert_weights(A, lds, 0, NEARLY, c * 8 + wv, G * 8, wv);
        phase0_rest(A, G, wv);
    }
    if (A.ws == nullptr) grid.sync();
    SEAM();
    }
    REPEAT(1) {
    {
        Sched1 S{G, c, (const char*)(ws + O_HMIX), (const char*)(ws + O_WIN), (const char*)(ws + O_MN), (const char*)(ws + O_WKV)};
        pg8::EpiInKv E{(bf16_t*)(ws + O_P), A.out, (bf16_t*)(ws + O_KB), (bf16_t*)(ws + O_VT)};
        pg8::gemm_phase<pg8::EpiInKv, Sched1, true, false>(lds, pg8::Dims{D, D, D}, S, E, wv);
        __syncthreads();
        const int skip = (G == 256) ? 80 : 0;
        convert_weights(A, lds, NEARLY, NITEMS - NP9, (c >= skip) ? (c - skip) * 8 + wv : -1, (G - skip) * 8, wv);
    }
    SEAM();
    }
    REPEAT(2) {
    ssm_phase(A, lds, G, wv);
    pooled_phase(A, G, wv);
    SEAM();
    }
    REPEAT(3) {
    {
        SchedPool S{G, c, (const char*)(ws + O_POOLED), (const char*)(ws + O_WPOOL)};
        pg8::EpiPool E{(bf16_t*)(ws + O_MIX), A.in[I_PSCALE]};
        pg8::gemm_phase<pg8::EpiPool, SchedPool, true, true>(lds, pg8::Dims{1024, 256, 256}, S, E, wv);
        SchedGrid S2{G, G - 1 - c, MTP, 4, (const char*)(ws + O_G), (const char*)(ws + O_WGLU), (size_t)256 * 1024 * 2, (size_t)256 * 1024 * 2, (const char*)(ws + O_G) + (size_t)MP * 1024 * 2, (size_t)16 * 1024 * 2};
        pg8::EpiGlu E2{(bf16_t*)(ws + O_MIX), (const bf16_t*)(ws + O_G), A.in[I_BGLU]};
        pg8::gemm_phase<pg8::EpiGlu, SchedGrid, true, true>(lds, pg8::Dims{1024, 1024, 1024}, S2, E2, wv);
    }
    SEAM();
    }
    REPEAT(4) {
    {
        SchedGrid S{G, c, MTP, 8, (const char*)(ws + O_MIX), (const char*)(ws + O_WOUT), (size_t)256 * D * 2, (size_t)256 * D * 2, (const char*)(ws + O_MIX) + (size_t)MP * D * 2, (size_t)16 * D * 2};
        pg8::EpiRes<float> E{A.in[I_XP], A.in[I_XS], nullptr, (bf16_t*)(ws + O_XB), rep_ ? SSD : SS1};
        pg8::gemm_phase<pg8::EpiRes<float>, SchedGrid, true, true>(lds, pg8::Dims{D, D, D}, S, E, wv);
    }
    SEAM();
    }
    REPEAT(5) {
    {
        SchedGrid S{G, c, MTP, 8, (const char*)(ws + O_XB), (const char*)(ws + O_WQ), (size_t)256 * D * 2, (size_t)256 * D * 2, (const char*)(ws + O_XB) + (size_t)MP * D * 2, (size_t)16 * D * 2};
        pg8::EpiQ E{(bf16_t*)(ws + O_Q), SS1};
        pg8::gemm_phase<pg8::EpiQ, SchedGrid, true, true>(lds, pg8::Dims{D, D, D}, S, E, wv);
    }
    SEAM();
    }
    REPEAT(6) {
    {
        if (G == 256) {
            if (c < 128) {
                { SchedScores S{c, (const char*)(ws + O_Q), (const char*)(ws + O_KB)};
                  pg8::EpiSoftmax E{(bf16_t*)(ws + O_PR)};
                  pg8::gemm_phase<pg8::EpiSoftmax, SchedScores, false, false>(lds, pg8::Dims{D, D, HD}, S, E, wv); }
                asm volatile("s_waitcnt vmcnt(0)" ::: "memory"); __syncthreads();
                { SchedPVown S{c, (const char*)(ws + O_PR), (const char*)(ws + O_VT)};
                  pg8::EpiPV E{(bf16_t*)(ws + O_ATT)};
                  pg8::gemm_phase<pg8::EpiPV, SchedPVown, true, false>(lds, pg8::Dims{256, 1024, 256}, S, E, wv); }
                __syncthreads();
                sample_attn_units<8>(A, lds, c, wv);
            } else {
                sample_attn_units<4>(A, lds, 128 + 2 * (c - 128), wv);
                sample_attn_units<8>(A, lds, 384 + (c - 128), wv);
            }
        } else {
            for (int base = 0; base < 128; base += G) {
                SchedScores S{c + base, (const char*)(ws + O_Q), (const char*)(ws + O_KB)};
                pg8::EpiSoftmax E{(bf16_t*)(ws + O_PR)};
                pg8::gemm_phase<pg8::EpiSoftmax, SchedScores, false, false>(lds, pg8::Dims{D, D, HD}, S, E, wv);
            }
            __syncthreads();
            for (int du = c; du < 256; du += G) sample_attn_units<4>(A, lds, 2 * du, wv);
        }
    }
    SEAM();
    }
    if (G != 256) {
        SchedPV S{G, c, (const char*)(ws + O_PR), (const char*)(ws + O_VT)};
        pg8::EpiPV E{(bf16_t*)(ws + O_ATT)};
        pg8::gemm_phase<pg8::EpiPV, SchedPV, true, false>(lds, pg8::Dims{256, 1024, 256}, S, E, wv);
        SEAM();
    }
    REPEAT(8) {
    {
        SchedGrid S{G, c, MTP, 8, (const char*)(ws + O_ATT), (const char*)(ws + O_WO), (size_t)256 * D * 2, (size_t)256 * D * 2, (const char*)(ws + O_ATT) + (size_t)MP * D * 2, (size_t)16 * D * 2};
        pg8::EpiRes<bf16_t> E{(const bf16_t*)(ws + O_XB), (const bf16_t*)(ws + O_XB) + (size_t)MP * D, nullptr, (bf16_t*)(ws + O_XB), SS2};
        pg8::gemm_phase<pg8::EpiRes<bf16_t>, SchedGrid, true, true>(lds, pg8::Dims{D, D, D}, S, E, wv);
    }
    SEAM();
    }
    REPEAT(9) {
    {
        SchedGU S{G, c, (const char*)(ws + O_XB), (const char*)(ws + O_WGU)};
        pg8::EpiGateUp E{(bf16_t*)(ws + O_H), SS2};
        pg8::gemm_phase<pg8::EpiGateUp, SchedGU, true, false>(lds, pg8::Dims{D, D, D}, S, E, wv);
        __syncthreads();
        { const int nfull = ((MTP + 2) * 44) % G;
          if (nfull > 0) convert_weights(A, lds, NITEMS - NP9, NITEMS, (c >= nfull) ? (c - nfull) * 8 + wv : -1, (G - nfull) * 8, wv);
          else convert_weights(A, lds, NITEMS - NP9, NITEMS, c * 8 + wv, G * 8, wv); }
    }
    SEAM();
    }
    if (G == 256) {
        SchedGrid S{G, c, MTP, 8, (const char*)(ws + O_H), (const char*)(ws + O_WDN), (size_t)256 * FF * 2, (size_t)256 * FF * 2, (const char*)(ws + O_H) + (size_t)MP * FF * 2, (size_t)16 * FF * 2};
        pg8::EpiFinal E{(const bf16_t*)(ws + O_XB), A.out + OUT_Y, SS3, (unsigned*)(ws + O_PCNT), A.in[I_GFINAL]};
        pg8::gemm_phase<pg8::EpiFinal, SchedGrid, false, true>(lds, pg8::Dims{FF, FF, FF}, S, E, wv);
    } else {
        {
            SchedGrid S{G, c, MTP, 8, (const char*)(ws + O_H), (const char*)(ws + O_WDN), (size_t)256 * FF * 2, (size_t)256 * FF * 2, (const char*)(ws + O_H) + (size_t)MP * FF * 2, (size_t)16 * FF * 2};
            pg8::EpiRes<bf16_t> E{(const bf16_t*)(ws + O_XB), (const bf16_t*)(ws + O_XB) + (size_t)MP * D, A.out + OUT_Y, nullptr, SS3};
            pg8::gemm_phase<pg8::EpiRes<bf16_t>, SchedGrid, true, true>(lds, pg8::Dims{FF, FF, FF}, S, E, wv);
        }
        SEAM();
        const float* gf = A.in[I_GFINAL]; const int tid = opaque_tid(wv), lane = tid & 63, wave = wv;
        for (int m = c * 8 + wave; m < M; m += G * 8) {
            const float rs = rsqrtf(SS3[m] * (1.0f / D) + EPS);
            f32x4* row = (f32x4*)(A.out + OUT_Y + (size_t)m * D) + lane; const f32x4* gr = (const f32x4*)gf + lane;
#pragma unroll
            for (int jj = 0; jj < 8; ++jj) row[64 * jj] = row[64 * jj] * rs * gr[64 * jj];
        }
    }
}

extern "C" void kernel_launch(void* const* d_in, const int* in_sizes, int n_in, void* d_out, int out_size, void* d_ws, size_t ws_size, hipStream_t stream) {
    static int grid = 0;
    if (grid == 0) {
        if (n_in != 34 || ws_size < WS_END) { fprintf(stderr, "kernel_launch: unexpected inputs (n_in %d, ws %zu, need %zu)\n", n_in, ws_size, (size_t)WS_END); grid = -1; return; }
        int dev = 0, cus = 0, per_cu = 0;
        hipGetDevice(&dev);
        hipDeviceGetAttribute(&cus, hipDeviceAttributeMultiprocessorCount, dev);
        if (hipFuncSetAttribute((const void*)hymba_fwd, hipFuncAttributeMaxDynamicSharedMemorySize, LDS_BYTES) != hipSuccess) { fprintf(stderr, "kernel_launch: hipFuncSetAttribute failed\n"); grid = -1; return; }
        if (hipOccupancyMaxActiveBlocksPerMultiprocessor(&per_cu, (const void*)hymba_fwd, 512, LDS_BYTES) != hipSuccess || per_cu < 1) { fprintf(stderr, "kernel_launch: occupancy query failed (%d)\n", per_cu); per_cu = 1; }
        (void)hipGetLastError();
        grid = cus * per_cu;
    }
    if (grid < 0) return;
    hipMemsetAsync(d_ws, 0, CTL_BYTES, stream);
    Args a{};
    for (int i = 0; i < 34; ++i) a.in[i] = (const float*)d_in[i];
    a.out = (float*)d_out; a.ws = (unsigned char*)d_ws;
    void* args[] = {&a};
    hipError_t e = hipLaunchCooperativeKernel((const void*)hymba_fwd, dim3(grid), dim3(512), args, LDS_BYTES, stream);
    if (e != hipSuccess) fprintf(stderr, "cooperative launch failed: %s (grid %d)\n", hipGetErrorString(e), grid);
}
```
